# Optimizing an MI355X kernel written in HIP

```python
import jax
import jax.numpy as jnp
from jax import lax
import numpy as np

D_MODEL = 2048
BATCH = 2
SEQ = 16384
DEPTH = 4

HEAD_DIM = 128
ROPE_THETA = 10000.0
LN_EPS = 1e-5
Q_BLOCK = 128

NSA_HEADS = D_MODEL // (2 * HEAD_DIM)
NSA_KV_HEADS = 2
CMP_BLOCK = 32
CMP_STRIDE = 16
SEL_BLOCK = 64
N_SELECT = 16
NSA_WINDOW = 512
NSA_Q_BLOCK = 64

SWA_HEADS = D_MODEL // (2 * HEAD_DIM)
SWA_KV_HEADS = 2
SWA_WINDOW = 128

DIL_HEADS = D_MODEL // HEAD_DIM
DIL_PATTERNS = ((128, 1), (512, 4), (2048, 16))

D_FF = 4 * D_MODEL
DN_ALPHA = (2 * DEPTH) ** 0.25
DN_BETA = (8 * DEPTH) ** -0.25
N_EVEN = (DEPTH + 1) // 2
N_ODD = DEPTH // 2

NSA_Q = NSA_HEADS * HEAD_DIM
NSA_KV = NSA_KV_HEADS * HEAD_DIM
SWA_Q = SWA_HEADS * HEAD_DIM
SWA_KV = SWA_KV_HEADS * HEAD_DIM
EVEN_WIDTHS = (NSA_Q, 3 * NSA_KV, 3 * NSA_KV, 3 * NSA_HEADS, SWA_Q, SWA_KV, SWA_KV)
EVEN_IN = sum(EVEN_WIDTHS)
EVEN_OUT = NSA_Q + SWA_Q
DIL_QKV = 3 * DIL_HEADS * HEAD_DIM
ODD_IN = len(DIL_PATTERNS) * DIL_QKV
ODD_OUT = DIL_HEADS * HEAD_DIM

kernel_name = 'hybrid_nsa_swa_dilated_deepnorm'


def _layer_norm(x, g, b):
    xf = x.astype(jnp.float32)
    mu = jnp.mean(xf, axis=-1, keepdims=True)
    var = jnp.mean(jnp.square(xf - mu), axis=-1, keepdims=True)
    y = (xf - mu) * lax.rsqrt(var + LN_EPS) * g.astype(jnp.float32) + b.astype(jnp.float32)
    return y.astype(x.dtype)


def _rope_tables(positions):
    inv_freq = ROPE_THETA ** (-jnp.arange(0, HEAD_DIM, 2, dtype=jnp.float32) / HEAD_DIM)
    ang = positions.astype(jnp.float32)[..., None] * inv_freq
    return jnp.cos(ang)[:, :, None, :], jnp.sin(ang)[:, :, None, :]


def _rope(t, cos, sin):
    tf = t.astype(jnp.float32)
    t1, t2 = jnp.split(tf, 2, axis=-1)
    return jnp.concatenate([t1 * cos - t2 * sin, t2 * cos + t1 * sin], axis=-1).astype(t.dtype)


def _banded_attention(q, k, v, window, sinks=None):
    B, Hq, L, dh = q.shape
    Hkv = k.shape[1]
    grp = Hq // Hkv
    blk = Q_BLOCK
    nb = -(-L // blk)
    Lp = nb * blk
    span = window - 1 + blk
    qp = jnp.pad(q, ((0, 0), (0, 0), (0, Lp - L), (0, 0))).reshape(B, Hkv, grp, Lp, dh)
    kp = jnp.pad(k, ((0, 0), (0, 0), (window - 1, Lp - L), (0, 0)))
    vp = jnp.pad(v, ((0, 0), (0, 0), (window - 1, Lp - L), (0, 0)))
    rel = jnp.arange(span)[None, :] - jnp.arange(blk)[:, None] - (window - 1)
    band = (rel <= 0) & (rel > -window)
    sink = None if sinks is None else sinks.astype(jnp.float32).reshape(1, Hkv, grp, 1)
    scale = dh ** -0.5

    def step(b):
        start = b * blk
        qb = lax.dynamic_slice_in_dim(qp, start, blk, axis=3)
        kb = lax.dynamic_slice_in_dim(kp, start, span, axis=2)
        vb = lax.dynamic_slice_in_dim(vp, start, span, axis=2)
        kpos = start - (window - 1) + jnp.arange(span)
        mask = band & (kpos >= 0)[None, :]
        s = jnp.einsum('bkgqd,bksd->bkgqs', qb, kb).astype(jnp.float32) * scale
        s = jnp.where(mask, s, -jnp.inf)
        m = jnp.max(s, axis=-1)
        if sink is not None:
            m = jnp.maximum(m, sink)
        p = jnp.exp(s - m[..., None])
        l = jnp.sum(p, axis=-1)
        if sink is not None:
            l = l + jnp.exp(sink - m)
        o = jnp.einsum('bkgqs,bksd->bkgqd', p, vb.astype(jnp.float32)) / l[..., None]
        return o.astype(q.dtype), m + jnp.log(l)

    o, lse = lax.map(step, jnp.arange(nb))
    o = jnp.moveaxis(o, 0, 3).reshape(B, Hq, Lp, dh)[:, :, :L]
    lse = jnp.moveaxis(lse, 0, 3).reshape(B, Hq, Lp)[:, :, :L]
    return o, lse


def _compress(k, pe, w1, w2):
    n_cmp = (k.shape[2] - CMP_BLOCK) // CMP_STRIDE + 1
    idx = np.arange(n_cmp)[:, None] * CMP_STRIDE + np.arange(CMP_BLOCK)[None, :]
    blocks = k[:, :, idx] + pe
    flat = blocks.reshape(blocks.shape[:3] + (CMP_BLOCK * HEAD_DIM,))
    return jax.nn.gelu(flat @ w1) @ w2


def _cmp_to_sel(n_cmp, n_blk):
    pos = np.arange(n_cmp)[:, None] * CMP_STRIDE + np.arange(CMP_BLOCK)[None, :]
    owner = pos // SEL_BLOCK
    m = (owner[:, :, None] == np.arange(n_blk)[None, None, :]).sum(axis=1) / CMP_BLOCK
    return jnp.asarray(m, dtype=jnp.float32)


def _nsa(q, k_cmp, v_cmp, k_slc, v_slc, k_win, v_win, gates, pe_k, pe_v, ck_w1, ck_w2, cv_w1, cv_w2):
    B, H, T, dh = q.shape
    G = k_cmp.shape[1]
    grp = H // G
    kc = _compress(k_cmp, pe_k, ck_w1, ck_w2)
    vc = _compress(v_cmp, pe_v, cv_w1, cv_w2)
    n_cmp = kc.shape[2]
    n_blk = T // SEL_BLOCK
    n_sel = min(N_SELECT, n_blk)
    cmp_end = jnp.arange(n_cmp) * CMP_STRIDE + (CMP_BLOCK - 1)
    cmp_to_sel = _cmp_to_sel(n_cmp, n_blk)
    ks = k_slc.reshape(B, G, n_blk, SEL_BLOCK, dh)
    vs = v_slc.reshape(B, G, n_blk, SEL_BLOCK, dh)
    q5 = q.reshape(B, G, grp, T, dh)
    bi = jnp.arange(B)[:, None, None, None]
    gi = jnp.arange(G)[None, :, None, None]
    blk_id = jnp.arange(n_blk)
    in_blk = jnp.arange(SEL_BLOCK)
    scale = dh ** -0.5

    def step(b):
        q0 = b * NSA_Q_BLOCK
        qb = lax.dynamic_slice_in_dim(q5, q0, NSA_Q_BLOCK, axis=3)
        qpos = q0 + jnp.arange(NSA_Q_BLOCK)
        s = jnp.einsum('bghqd,bgcd->bghqc', qb, kc).astype(jnp.float32) * scale
        s = jnp.where(cmp_end[None, :] <= qpos[:, None], s, -jnp.inf)
        m = jnp.max(s, axis=-1, keepdims=True)
        m = jnp.where(jnp.isfinite(m), m, 0.0)
        p = jnp.exp(s - m)
        l = jnp.sum(p, axis=-1, keepdims=True)
        p = p / jnp.where(l > 0, l, 1.0)
        o_cmp = jnp.einsum('bghqc,bgcd->bghqd', p, vc.astype(jnp.float32))
        imp = jnp.einsum('bghqc,cn->bgqn', p, cmp_to_sel)
        cur = qpos // SEL_BLOCK
        valid = blk_id[None, :] * SEL_BLOCK <= qpos[:, None]
        forced = (blk_id[None, :] == 0) | (blk_id[None, :] == cur[:, None]) | (blk_id[None, :] == cur[:, None] - 1)
        score = jnp.where(forced, jnp.inf, jnp.where(valid, imp, -jnp.inf))
        _, idx = lax.top_k(score, n_sel)
        sk = ks[bi, gi, idx]
        sv = vs[bi, gi, idx]
        s2 = jnp.einsum('bghqd,bgqnld->bghqnl', qb, sk).astype(jnp.float32) * scale
        kpos = idx[..., None] * SEL_BLOCK + in_blk
        s2 = jnp.where((kpos <= qpos[None, None, :, None, None])[:, :, None], s2, -jnp.inf)
        p2 = jax.nn.softmax(s2.reshape(s2.shape[:4] + (n_sel * SEL_BLOCK,)), axis=-1).reshape(s2.shape)
        o_slc = jnp.einsum('bghqnl,bgqnld->bghqd', p2, sv.astype(jnp.float32))
        return o_cmp.astype(q.dtype), o_slc.astype(q.dtype)

    o_cmp, o_slc = lax.map(step, jnp.arange(T // NSA_Q_BLOCK))
    o_cmp = jnp.moveaxis(o_cmp, 0, 3).reshape(B, H, T, dh)
    o_slc = jnp.moveaxis(o_slc, 0, 3).reshape(B, H, T, dh)
    o_win, _ = _banded_attention(q, k_win, v_win, NSA_WINDOW)
    return gates[..., 0:1] * o_cmp + gates[..., 1:2] * o_slc + gates[..., 2:3] * o_win


def _even_mixer(x, cos, sin, w_in, w_o, pe_k, pe_v, ck_w1, ck_w2, cv_w1, cv_w2, sinks):
    B, T, _ = x.shape
    dh = HEAD_DIM
    G = NSA_KV_HEADS
    aq, ak, av, ag, bq, bk, bv = jnp.split(x @ w_in, np.cumsum(EVEN_WIDTHS)[:-1].tolist(), axis=-1)
    aq = _rope(aq.reshape(B, T, NSA_HEADS, dh), cos, sin).transpose(0, 2, 1, 3)
    ak = _rope(ak.reshape(B, T, 3 * G, dh), cos, sin).reshape(B, T, 3, G, dh).transpose(2, 0, 3, 1, 4)
    av = av.reshape(B, T, 3, G, dh).transpose(2, 0, 3, 1, 4)
    gates = jax.nn.sigmoid(ag.reshape(B, T, NSA_HEADS, 3).astype(jnp.float32)).transpose(0, 2, 1, 3).astype(x.dtype)
    o_a = _nsa(aq, ak[0], av[0], ak[1], av[1], ak[2], av[2], gates, pe_k, pe_v, ck_w1, ck_w2, cv_w1, cv_w2)
    bq = _rope(bq.reshape(B, T, SWA_HEADS, dh), cos, sin).transpose(0, 2, 1, 3)
    bk = _rope(bk.reshape(B, T, SWA_KV_HEADS, dh), cos, sin).transpose(0, 2, 1, 3)
    bv = bv.reshape(B, T, SWA_KV_HEADS, dh).transpose(0, 2, 1, 3)
    o_b, _ = _banded_attention(bq, bk, bv, SWA_WINDOW, sinks)
    o = jnp.concatenate([o_a, o_b], axis=1)
    return o.transpose(0, 2, 1, 3).reshape(B, T, EVEN_OUT) @ w_o


def _odd_mixer(x, cos, sin, w_in, w_o):
    B, T, _ = x.shape
    H, dh = DIL_HEADS, HEAD_DIM
    w_groups = w_in.reshape(w_in.shape[0], len(DIL_PATTERNS), DIL_QKV)
    outs, lses = [], []
    for g, (window, dil) in enumerate(DIL_PATTERNS):
        qkv = (x @ w_groups[:, g]).reshape(B, T, 3, H, dh)
        q = _rope(qkv[:, :, 0], cos, sin)
        k = _rope(qkv[:, :, 1], cos, sin)
        v = qkv[:, :, 2]
        u = T // dil
        dec = lambda t: t.reshape(B, u, dil, H, dh).transpose(0, 3, 2, 1, 4).reshape(B, H * dil, u, dh)
        o, lse = _banded_attention(dec(q), dec(k), dec(v), window // dil + 1)
        outs.append(o.reshape(B, H, dil, u, dh).transpose(0, 1, 3, 2, 4).reshape(B, H, T, dh))
        lses.append(lse.reshape(B, H, dil, u).transpose(0, 1, 3, 2).reshape(B, H, T))
    mix = jax.nn.softmax(jnp.stack(lses), axis=0)
    o = jnp.einsum('gbht,gbhtd->bhtd', mix, jnp.stack(outs).astype(jnp.float32)).astype(x.dtype)
    return o.transpose(0, 2, 1, 3).reshape(B, T, ODD_OUT) @ w_o


def _mlp(x, w1, w2):
    return jnp.square(jax.nn.relu(x @ w1)) @ w2


def setup_inputs(seed: int = 0) -> dict:
    key = jax.random.key(seed)
    ks = jax.random.split(key, 19)

    def nrm(k, shape, scale):
        return jax.random.normal(k, shape, dtype=jnp.float32) * scale

    beta = DN_BETA
    x = nrm(ks[0], (BATCH, SEQ, D_MODEL), 1.0)
    offset = jax.random.randint(ks[1], (BATCH, 1), 0, 4096, dtype=jnp.int32)
    positions = offset + jnp.arange(SEQ, dtype=jnp.int32)[None, :]
    e_col = np.concatenate([np.ones(NSA_Q), np.ones(3 * NSA_KV), np.full(3 * NSA_KV, beta), np.ones(3 * NSA_HEADS), np.ones(SWA_Q), np.ones(SWA_KV), np.full(SWA_KV, beta)]).astype(np.float32)
    o_col = np.tile(np.concatenate([np.ones(2 * DIL_HEADS * HEAD_DIM), np.full(DIL_HEADS * HEAD_DIM, beta)]), len(DIL_PATTERNS)).astype(np.float32)
    e_w_in = nrm(ks[2], (N_EVEN, D_MODEL, EVEN_IN), D_MODEL ** -0.5) * jnp.asarray(e_col)
    e_w_o = nrm(ks[3], (N_EVEN, EVEN_OUT, D_MODEL), EVEN_OUT ** -0.5 * beta)
    nsa_pe_k = nrm(ks[4], (N_EVEN, CMP_BLOCK, HEAD_DIM), 0.5)
    nsa_pe_v = nrm(ks[5], (N_EVEN, CMP_BLOCK, HEAD_DIM), 0.5)
    nsa_ck_w1 = nrm(ks[6], (N_EVEN, CMP_BLOCK * HEAD_DIM, HEAD_DIM), (CMP_BLOCK * HEAD_DIM) ** -0.5)
    nsa_ck_w2 = nrm(ks[7], (N_EVEN, HEAD_DIM, HEAD_DIM), HEAD_DIM ** -0.5)
    nsa_cv_w1 = nrm(ks[8], (N_EVEN, CMP_BLOCK * HEAD_DIM, HEAD_DIM), (CMP_BLOCK * HEAD_DIM) ** -0.5)
    nsa_cv_w2 = nrm(ks[9], (N_EVEN, HEAD_DIM, HEAD_DIM), HEAD_DIM ** -0.5)
    swa_sinks = nrm(ks[10], (N_EVEN, SWA_HEADS), 1.0)
    o_w_in = nrm(ks[11], (N_ODD, D_MODEL, ODD_IN), D_MODEL ** -0.5) * jnp.asarray(o_col)
    o_w_o = nrm(ks[12], (N_ODD, ODD_OUT, D_MODEL), ODD_OUT ** -0.5 * beta)
    ln1_g = 1.0 + nrm(ks[13], (DEPTH, D_MODEL), 0.02)
    ln1_b = nrm(ks[14], (DEPTH, D_MODEL), 0.02)
    mlp_w1 = nrm(ks[15], (DEPTH, D_MODEL, D_FF), D_MODEL ** -0.5 * beta)
    mlp_w2 = nrm(ks[16], (DEPTH, D_FF, D_MODEL), D_FF ** -0.5 * beta)
    ln2_g = 1.0 + nrm(ks[17], (DEPTH, D_MODEL), 0.02)
    ln2_b = nrm(ks[18], (DEPTH, D_MODEL), 0.02)
    return {'x': x, 'positions': positions, 'e_w_in': e_w_in, 'e_w_o': e_w_o,
            'nsa_pe_k': nsa_pe_k, 'nsa_pe_v': nsa_pe_v, 'nsa_ck_w1': nsa_ck_w1, 'nsa_ck_w2': nsa_ck_w2,
            'nsa_cv_w1': nsa_cv_w1, 'nsa_cv_w2': nsa_cv_w2, 'swa_sinks': swa_sinks,
            'o_w_in': o_w_in, 'o_w_o': o_w_o, 'ln1_g': ln1_g, 'ln1_b': ln1_b,
            'mlp_w1': mlp_w1, 'mlp_w2': mlp_w2, 'ln2_g': ln2_g, 'ln2_b': ln2_b}


def reference(x, positions, e_w_in, e_w_o, nsa_pe_k, nsa_pe_v, nsa_ck_w1, nsa_ck_w2, nsa_cv_w1, nsa_cv_w2, swa_sinks, o_w_in, o_w_o, ln1_g, ln1_b, mlp_w1, mlp_w2, ln2_g, ln2_b):
    cos, sin = _rope_tables(positions)
    for layer in range(DEPTH):
        i = layer // 2
        if layer % 2 == 0:
            y = _even_mixer(x, cos, sin, e_w_in[i], e_w_o[i], nsa_pe_k[i], nsa_pe_v[i], nsa_ck_w1[i], nsa_ck_w2[i], nsa_cv_w1[i], nsa_cv_w2[i], swa_sinks[i])
        else:
            y = _odd_mixer(x, cos, sin, o_w_in[i], o_w_o[i])
        x = _layer_norm(DN_ALPHA * x + y, ln1_g[layer], ln1_b[layer])
        x = _layer_norm(DN_ALPHA * x + _mlp(x, mlp_w1[layer], mlp_w2[layer]), ln2_g[layer], ln2_b[layer])
    return x
```

```cpp
#include <hip/hip_runtime.h>
#include <cstdio>
#include <cstdint>
#include <cmath>

constexpr int BATCH = 2, T = 16384, DM = 2048, DEPTH = 4, HD = 128, DFF = 8192;
constexpr int M = BATCH * T;
constexpr int EVEN_IN = 4120, EVEN_NPAD = 4352, ODD_IN = 18432, ODD_G = 6144;
constexpr float LN_EPS = 1e-5f;
constexpr float DN_ALPHA = 1.6817928305074290f;

constexpr size_t MiB = 1u << 20;
constexpr size_t WS_CTL = 0, CTL_ZERO_BYTES = 1 * MiB;
constexpr size_t WS_ROPEC = 1 * MiB, WS_ROPES = 9 * MiB;
constexpr size_t WS_GATES = 17 * MiB;
constexpr size_t WS_KC = 20 * MiB, WS_VC = 21 * MiB;
constexpr size_t WS_LSE = 22 * MiB;
constexpr size_t WS_CW = 24 * MiB;
constexpr size_t WS_W = 32 * MiB;
constexpr size_t W_WIN = 0, W_WO = (size_t)ODD_IN * DM * 2, W_W1 = W_WO + (size_t)DM * DM * 2, W_W2 = W_W1 + (size_t)DFF * DM * 2, W_END = W_W2 + (size_t)DM * DFF * 2;
constexpr size_t WS_XB = 248 * MiB;
constexpr size_t WS_R = 376 * MiB;
constexpr size_t WS_O = 760 * MiB;
constexpr size_t WS_OWIN = 888 * MiB;
constexpr size_t WS_END = 952 * MiB;
static_assert(WS_W + W_END <= WS_XB && WS_R + 384 * MiB == WS_O && WS_O + 128 * MiB == WS_OWIN, "d_ws map");
constexpr size_t R_QA = 0, R_KA = 64 * MiB, R_VA = 112 * MiB, R_QB = 160 * MiB, R_KB = 224 * MiB, R_VB = 240 * MiB;
constexpr size_t R_QG = 0, R_KG = 128 * MiB, R_VG = 256 * MiB;

namespace pg8 {
#define PG8_LAS __attribute__((address_space(3)))
typedef unsigned short bf16_t;
typedef short bf16x8 __attribute__((ext_vector_type(8)));
typedef float f32x4 __attribute__((ext_vector_type(4)));
typedef unsigned u32x4 __attribute__((ext_vector_type(4)));
constexpr int BM = 256, BK = 64, HALF = 128, HTB = HALF * BK * 2  , STAGE_BYTES = 8 * HTB, NXCD = 8, WGM = 8;

__host__ __device__ __forceinline__ int lds_byte(int r, int c) { const int st = (r >> 4) * 2 + (c >> 5), rr = r & 15, cc = c & 31, ob = rr * 64 + cc * 2; return st * 1024 + (ob ^ (((ob >> 9) & 1) << 5)); }
__host__ __device__ __forceinline__ void stage_rc(int b, int& R, int& C) { const int st = b / 1024, sb = b % 1024, swz = sb ^ (((sb >> 9) & 1) << 5); R = (st >> 1) * 16 + swz / 64; C = (st & 1) * 32 + (swz % 64) / 2; }
__host__ __device__ __forceinline__ int perm32(int rho) { const int n = rho >> 4, i = rho & 15; return 8 * (i >> 2) + 4 * n + (i & 3); }

struct Unit { int pm, pn; };
struct Gemm { const bf16_t* A; const bf16_t* Bt; int M, N, K; };

struct StaticOrder {
    int nM, nN, nwg, G, c;
    __host__ __device__ void init(int M, int N, int G_, int c_) { nM = M / BM; nN = N / BM; nwg = nM * nN; G = G_; c = c_; }
    __host__ __device__ bool next(int i, Unit& u) const {
        const long L = (long)i * G + c; if (L >= nwg) return false;
        int wgid = (int)L; { const int q = nwg / NXCD, r = nwg % NXCD, xcd = wgid % NXCD, off = wgid / NXCD; wgid = (xcd < r ? xcd * (q + 1) : r * (q + 1) + (xcd - r) * q) + off; }
        const int nig = WGM * nN, gid = wgid / nig, fm = gid * WGM, gsz = (nM - fm) < WGM ? (nM - fm) : WGM;
        u.pm = fm + ((wgid % nig) % gsz); u.pn = (wgid % nig) / gsz; return true;
    }
    __device__ __forceinline__ void a_ready(const Unit&) const {}
    __device__ __forceinline__ void done(const Unit&) const {}
};

__device__ __forceinline__ unsigned cvt_pk_bf16(float lo, float hi) { unsigned r; asm volatile("v_cvt_pk_bf16_f32 %0, %1, %2" : "=v"(r) : "v"(lo), "v"(hi)); return r; }
typedef float f32x2 __attribute__((ext_vector_type(2)));

typedef unsigned u32x2 __attribute__((ext_vector_type(2)));
__device__ __forceinline__ void rope_store(const f32x4 a0, const f32x4 a1, const f32x4 cs, const f32x4 sn, bool rope, bf16_t* p) {
    f32x4 o0 = a0, o1 = a1;
    if (rope) { o0 = a0 * cs - a1 * sn; o1 = a1 * cs + a0 * sn; }
    u32x2 w0, w1; w0.x = cvt_pk_bf16(o0[0], o0[1]); w0.y = cvt_pk_bf16(o0[2], o0[3]); w1.x = cvt_pk_bf16(o1[0], o1[1]); w1.y = cvt_pk_bf16(o1[2], o1[3]);
    *(u32x2*)p = w0; *(u32x2*)(p + 64) = w1;
}
struct EpiEven {
    static constexpr bool PERM = false, AFTER_DRAIN = false;
    unsigned char* ws;
    __device__ __forceinline__ void operator()(const f32x4 (&acc)[2][2][4][2], const Unit& u, int wr, int wc, int fr, int fq) const {
        bf16_t* const QA = (bf16_t*)(ws + WS_R + R_QA); bf16_t* const KA = (bf16_t*)(ws + WS_R + R_KA); bf16_t* const VA = (bf16_t*)(ws + WS_R + R_VA);
        bf16_t* const QB = (bf16_t*)(ws + WS_R + R_QB); bf16_t* const KB = (bf16_t*)(ws + WS_R + R_KB); bf16_t* const VB = (bf16_t*)(ws + WS_R + R_VB);
        float* const gates = (float*)(ws + WS_GATES); const float* const ropec = (const float*)(ws + WS_ROPEC); const float* const ropes = (const float*)(ws + WS_ROPES);
        int tl_ = threadIdx.x; asm volatile("" : "+v"(tl_));
        wr = (tl_ >> 8) & 1; wc = (tl_ >> 6) & 3; fr = tl_ & 15; fq = (tl_ >> 4) & 3;
        const int loff = (wr * 64 + fr) * 128 + 16 * wc + 4 * fq, roff = (wr * 64 + fr) * 64 + 16 * wc + 4 * fq, goff = (wr * 64 + fr) * 24 + 4 * fq;
        const int b = u.pm >> 6, tb = (u.pm & 63) * 256;
        if (u.pn == 16) {
            if (wc == 0) { float* g0 = gates + (size_t)u.pm * 256 * 24 + goff;
#pragma unroll
                for (int ai = 0; ai < 2; ++ai)
#pragma unroll
                    for (int m = 0; m < 4; ++m) { float* gp = g0 + (ai * 128 + m * 16) * 24;
#pragma unroll
                        for (int n = 0; n < 2; ++n) if (n == 0 || fq < 2) { f32x4 v = acc[ai][0][m][n], o;
#pragma unroll
                            for (int j = 0; j < 4; ++j) o[j] = 1.0f / (1.0f + __expf(-v[j]));
                            *(f32x4*)(gp + 16 * n) = o; } }
            }
            return;
        }
        bf16_t* dst[2]; bool rope = true;
#pragma unroll
        for (int bj = 0; bj < 2; ++bj) { const int cb = 2 * u.pn + bj; bf16_t* base; int nH, hh;
            if (cb < 8) { base = QA; nH = 8; hh = cb; } else if (cb < 14) { base = KA; nH = 6; hh = cb - 8; } else if (cb < 20) { base = VA; nH = 6; hh = cb - 14; rope = false; }
            else if (cb < 28) { base = QB; nH = 8; hh = cb - 20; } else if (cb < 30) { base = KB; nH = 2; hh = cb - 28; } else { base = VB; nH = 2; hh = cb - 30; rope = false; }
            dst[bj] = base + ((size_t)(b * nH + hh) * T + tb) * 128 + loff; }
        const float* rc = ropec + (size_t)u.pm * 256 * 64 + roff; const float* rs = ropes + (size_t)u.pm * 256 * 64 + roff;
#pragma unroll
        for (int ai = 0; ai < 2; ++ai)
#pragma unroll
            for (int m = 0; m < 4; ++m) { const int ro = ai * 128 + m * 16; f32x4 cs = {1.f, 1.f, 1.f, 1.f}, sn = {0.f, 0.f, 0.f, 0.f};
                if (rope) { cs = *(const f32x4*)(rc + ro * 64); sn = *(const f32x4*)(rs + ro * 64); }
#pragma unroll
                for (int bj = 0; bj < 2; ++bj) rope_store(acc[ai][bj][m][0], acc[ai][bj][m][1], cs, sn, rope, dst[bj] + (size_t)ro * 128);
                asm volatile("" ::: "memory"); }
    }
};
struct EpiOdd {
    static constexpr bool PERM = false, AFTER_DRAIN = false;
    unsigned char* ws; int dsh;
    __device__ __forceinline__ void operator()(const f32x4 (&acc)[2][2][4][2], const Unit& u, int wr, int wc, int fr, int fq) const {
        bf16_t* const Qg = (bf16_t*)(ws + WS_R + R_QG); bf16_t* const Kg = (bf16_t*)(ws + WS_R + R_KG); bf16_t* const Vg = (bf16_t*)(ws + WS_R + R_VG);
        const float* const ropec = (const float*)(ws + WS_ROPEC); const float* const ropes = (const float*)(ws + WS_ROPES);
        int tl_ = threadIdx.x; asm volatile("" : "+v"(tl_));
        wr = (tl_ >> 8) & 1; wc = (tl_ >> 6) & 3; fr = tl_ & 15; fq = (tl_ >> 4) & 3;
        const int coff = 16 * wc + 4 * fq, roff = (wr * 64 + fr) * 64 + 16 * wc + 4 * fq, tl = wr * 64 + fr;
        const int b = u.pm >> 6, tb = (u.pm & 63) * 256 + tl;
        const bool rope = u.pn < 16; const int lsh = 14 - dsh, dmask = (1 << dsh) - 1;
        bf16_t* dst[2];
#pragma unroll
        for (int bj = 0; bj < 2; ++bj) { const int cb = 2 * u.pn + bj, which = cb >> 4, h = cb & 15; bf16_t* base = which == 0 ? Qg : (which == 1 ? Kg : Vg);
            dst[bj] = base + (size_t)(b * 16 + h) * T * 128 + coff; }
        const float* rc = ropec + (size_t)u.pm * 256 * 64 + roff; const float* rs = ropes + (size_t)u.pm * 256 * 64 + roff;
#pragma unroll
        for (int ai = 0; ai < 2; ++ai)
#pragma unroll
            for (int m = 0; m < 4; ++m) { const int ro = ai * 128 + m * 16, t = tb + ro, row = ((t & dmask) << lsh) + (t >> dsh); f32x4 cs = {1.f, 1.f, 1.f, 1.f}, sn = {0.f, 0.f, 0.f, 0.f};
                if (rope) { cs = *(const f32x4*)(rc + ro * 64); sn = *(const f32x4*)(rs + ro * 64); }
#pragma unroll
                for (int bj = 0; bj < 2; ++bj) rope_store(acc[ai][bj][m][0], acc[ai][bj][m][1], cs, sn, rope, dst[bj] + (size_t)row * 128);
                asm volatile("" ::: "memory"); }
    }
};
struct EpiResid {
    static constexpr bool PERM = false, AFTER_DRAIN = false;
    const float* base; float* out; int ldc; float alpha;
    __device__ __forceinline__ void operator()(const f32x4 (&acc)[2][2][4][2], const Unit& u, int wr, int wc, int fr, int fq) const {
        const int row0 = u.pm * BM + wr * 64 + fr, col0 = u.pn * BM + wc * 32 + 4 * fq;
#pragma unroll
        for (int ai = 0; ai < 2; ++ai)
#pragma unroll
            for (int mp = 0; mp < 2; ++mp) {
                f32x4 bs[2][2][2];
#pragma unroll
                for (int mm = 0; mm < 2; ++mm) { const size_t off = (size_t)(row0 + ai * HALF + (2 * mp + mm) * 16) * ldc + col0;
#pragma unroll
                    for (int bj = 0; bj < 2; ++bj)
#pragma unroll
                        for (int n = 0; n < 2; ++n) bs[mm][bj][n] = *(const f32x4*)(base + off + bj * HALF + n * 16); }
#pragma unroll
                for (int mm = 0; mm < 2; ++mm) { const size_t off = (size_t)(row0 + ai * HALF + (2 * mp + mm) * 16) * ldc + col0;
#pragma unroll
                    for (int bj = 0; bj < 2; ++bj)
#pragma unroll
                        for (int n = 0; n < 2; ++n) *(f32x4*)(out + off + bj * HALF + n * 16) = bs[mm][bj][n] * alpha + acc[ai][bj][2 * mp + mm][n]; }
            }
    }
};
struct EpiRelu2 {
    static constexpr bool PERM = true, AFTER_DRAIN = false;
    bf16_t* O; int ldc;
    __device__ __forceinline__ void operator()(const f32x4 (&acc)[2][2][4][2], const Unit& u, int wr, int wc, int fr, int fq) const {
        const int row0 = u.pm * BM + wr * 64 + fr, col0 = u.pn * BM + wc * 32 + 8 * fq;
#pragma unroll
        for (int ai = 0; ai < 2; ++ai)
#pragma unroll
            for (int m = 0; m < 4; ++m) { bf16_t* rowp = O + (size_t)(row0 + ai * HALF + m * 16) * ldc + col0;
#pragma unroll
                for (int bj = 0; bj < 2; ++bj) { f32x4 v0 = acc[ai][bj][m][0], v1 = acc[ai][bj][m][1];
#pragma unroll
                    for (int j = 0; j < 4; ++j) { const float a = fmaxf(v0[j], 0.f), c = fmaxf(v1[j], 0.f); v0[j] = a * a; v1[j] = c * c; }
                    u32x4 w; w.x = cvt_pk_bf16(v0[0], v0[1]); w.y = cvt_pk_bf16(v0[2], v0[3]); w.z = cvt_pk_bf16(v1[0], v1[1]); w.w = cvt_pk_bf16(v1[2], v1[3]);
                    *(u32x4*)(rowp + bj * HALF) = w; } }
    }
};

template <class Epi, class Sched, bool ALIGN_EPI = false, bool SP2 = false>
__device__ __forceinline__ void gemm_phase(PG8_LAS unsigned char* lds, const Gemm g, const Sched& S, const Epi& E) {
    int tid_ = threadIdx.x; asm volatile("" : "+v"(tid_));
    const int tid = tid_, wid = __builtin_amdgcn_readfirstlane(tid >> 6), lane = tid & 63, wr = wid >> 2, wc = wid & 3, fr = lane & 15, fq = lane >> 4;
    const int K = g.K, nt = K / BK;
    unsigned voffA[2], voffB[2];
#pragma unroll
    for (int i = 0; i < 2; ++i) { int R, C; stage_rc(tid * 16 + i * 8192, R, C); const int Rb = Epi::PERM ? ((R & ~31) + perm32(R & 31)) : R;
        voffA[i] = (unsigned)(R * K + C) * 2u; voffB[i] = (unsigned)(Rb * K + C) * 2u; }
    const size_t kstep = (size_t)(BK * 2);
    const size_t hstep = (size_t)HALF * K * 2;
    const size_t tstep = 2 * hstep;
    const unsigned ldsw = (unsigned)wid * 1024u;
    const int aoff = lds_byte(wr * 64 + fr, fq * 8), boff = lds_byte(wc * 32 + fr, fq * 8);
#define PG8_SA(b, h) (((b) * 2 + (h)) * HTB)
#define PG8_SB(b, h) ((4 + (b) * 2 + (h)) * HTB)
#define PG8_STAGE(bufoff, gbase, voff) do { _Pragma("unroll") for (int _i = 0; _i < 2; ++_i) \
        __builtin_amdgcn_global_load_lds((const unsigned*)((const char*)(gbase) + (voff)[_i]), (PG8_LAS unsigned*)(lds + (bufoff) + ldsw + _i * 8192), 16, 0, 0); } while (0)
#define PG8_LDA(dst, b, h) do { _Pragma("unroll") for (int m = 0; m < 4; ++m) _Pragma("unroll") for (int k = 0; k < 2; ++k) dst[m][k] = *(const PG8_LAS bf16x8*)(lds + PG8_SA(b, h) + aoff + m * 2048 + k * 1024); } while (0)
#define PG8_LDB(dst, b, h) do { _Pragma("unroll") for (int n = 0; n < 2; ++n) _Pragma("unroll") for (int k = 0; k < 2; ++k) dst[n][k] = *(const PG8_LAS bf16x8*)(lds + PG8_SB(b, h) + boff + n * 2048 + k * 1024); } while (0)
#define PG8_MMA(ai, bj, At, Bt) do { __builtin_amdgcn_s_setprio(1); _Pragma("unroll") for (int m = 0; m < 4; ++m) _Pragma("unroll") for (int n = 0; n < 2; ++n) _Pragma("unroll") for (int k = 0; k < 2; ++k) \
        acc[ai][bj][m][n] = __builtin_amdgcn_mfma_f32_16x16x32_bf16(Bt[n][k], At[m][k], acc[ai][bj][m][n], 0, 0, 0); __builtin_amdgcn_s_setprio(0); } while (0)
#define PG8_WAIT_V(n) asm volatile("s_waitcnt vmcnt(" #n ")" ::: "memory")
#define PG8_WAIT_L(n) asm volatile("s_waitcnt lgkmcnt(" #n ")" ::: "memory")
#define PG8_BAR __builtin_amdgcn_s_barrier()
#define PG8_SCHED __builtin_amdgcn_sched_barrier(0)
    Unit cur, nxt; int ui = 0;
    if (!S.next(0, cur)) return;
    f32x4 acc[2][2][4][2];
#pragma unroll
    for (int a = 0; a < 2; ++a)
#pragma unroll
        for (int b = 0; b < 2; ++b)
#pragma unroll
            for (int m = 0; m < 4; ++m)
#pragma unroll
                for (int n = 0; n < 2; ++n) acc[a][b][m][n] = (f32x4){0.f, 0.f, 0.f, 0.f};
    bf16x8 At[4][2], B0[2][2], B1[2][2];
    const char* cA = (const char*)g.A + (size_t)cur.pm * tstep; const char* cB = (const char*)g.Bt + (size_t)cur.pn * tstep;
    S.a_ready(cur);
    if constexpr (SP2) {
        PG8_STAGE(PG8_SB(0, 0), cB, voffB); PG8_STAGE(PG8_SB(0, 1), cB + hstep, voffB); PG8_STAGE(PG8_SA(0, 0), cA, voffA); PG8_STAGE(PG8_SA(0, 1), cA + hstep, voffA);
        if (wr == 1) PG8_BAR;
        PG8_WAIT_V(2); PG8_BAR;
        PG8_STAGE(PG8_SB(1, 0), cB + kstep, voffB); PG8_STAGE(PG8_SA(1, 0), cA + kstep, voffA); PG8_STAGE(PG8_SB(1, 1), cB + hstep + kstep, voffB);
        PG8_WAIT_V(6); PG8_BAR;
    } else {
        PG8_STAGE(PG8_SB(0, 0), cB, voffB); PG8_STAGE(PG8_SA(0, 0), cA, voffA); PG8_STAGE(PG8_SB(0, 1), cB + hstep, voffB); PG8_STAGE(PG8_SA(0, 1), cA + hstep, voffA);
        if (wr == 1) PG8_BAR;
        PG8_WAIT_V(4); PG8_BAR;
        PG8_STAGE(PG8_SB(1, 0), cB + kstep, voffB); PG8_STAGE(PG8_SA(1, 0), cA + kstep, voffA); PG8_STAGE(PG8_SB(1, 1), cB + hstep + kstep, voffB);
        PG8_WAIT_V(6); PG8_BAR;
    }
    for (;;) {
        const bool has_next = S.next(ui + 1, nxt);
        const char* nA = has_next ? (const char*)g.A + (size_t)nxt.pm * tstep : cA; const char* nB = has_next ? (const char*)g.Bt + (size_t)nxt.pn * tstep : cB;
        for (int t = 0; t < nt; t += 2) {
            const bool last = (t == nt - 2);
            const char* a1 = cA + (size_t)(t + 1) * kstep;
            const char* a2 = last ? nA : cA + (size_t)(t + 2) * kstep; const char* b2 = last ? nB : cB + (size_t)(t + 2) * kstep;
            const char* a3 = a2 + kstep; const char* b3 = b2 + kstep;
            if (last && has_next) S.a_ready(nxt);
            if constexpr (SP2) {
            PG8_LDB(B0, 0, 0); PG8_LDB(B1, 0, 1); PG8_SCHED; PG8_LDA(At, 0, 0); PG8_STAGE(PG8_SA(1, 1), a1 + hstep, voffA);
            PG8_WAIT_V(8); PG8_WAIT_L(0); PG8_BAR; PG8_MMA(0, 0, At, B0); PG8_MMA(0, 1, At, B1); PG8_BAR; PG8_SCHED;
            PG8_LDA(At, 0, 1); PG8_STAGE(PG8_SB(0, 0), b2, voffB); PG8_STAGE(PG8_SB(0, 1), b2 + hstep, voffB); PG8_STAGE(PG8_SA(0, 0), a2, voffA);
            PG8_WAIT_V(8); PG8_WAIT_L(0); PG8_BAR; PG8_MMA(1, 0, At, B0); PG8_MMA(1, 1, At, B1); PG8_BAR; PG8_SCHED;
            PG8_LDB(B0, 1, 0); PG8_LDB(B1, 1, 1); PG8_SCHED; PG8_LDA(At, 1, 0); PG8_STAGE(PG8_SA(0, 1), a2 + hstep, voffA);
            PG8_WAIT_V(8); PG8_WAIT_L(0); PG8_BAR; PG8_MMA(0, 0, At, B0); PG8_MMA(0, 1, At, B1); PG8_BAR; PG8_SCHED;
            PG8_LDA(At, 1, 1); PG8_STAGE(PG8_SB(1, 0), b3, voffB); PG8_STAGE(PG8_SB(1, 1), b3 + hstep, voffB); PG8_STAGE(PG8_SA(1, 0), a3, voffA);
            PG8_WAIT_V(8); PG8_WAIT_L(0); PG8_BAR; PG8_MMA(1, 0, At, B0); PG8_MMA(1, 1, At, B1); PG8_BAR; PG8_SCHED;
            } else {
            PG8_LDB(B0, 0, 0); PG8_SCHED; PG8_LDA(At, 0, 0); PG8_STAGE(PG8_SA(1, 1), a1 + hstep, voffA);
            PG8_WAIT_L(8); PG8_BAR; PG8_WAIT_L(0); PG8_MMA(0, 0, At, B0); PG8_BAR; PG8_SCHED;
            PG8_LDB(B1, 0, 1); PG8_STAGE(PG8_SB(0, 0), b2, voffB);
            PG8_BAR; PG8_WAIT_L(0); PG8_MMA(0, 1, At, B1); PG8_BAR;
            PG8_LDA(At, 0, 1); PG8_STAGE(PG8_SA(0, 0), a2, voffA);
            PG8_BAR; PG8_WAIT_L(0); PG8_MMA(1, 0, At, B0); PG8_BAR; PG8_SCHED;
            PG8_STAGE(PG8_SB(0, 1), b2 + hstep, voffB);
            PG8_WAIT_V(6); PG8_BAR; PG8_MMA(1, 1, At, B1); PG8_BAR;
            PG8_LDB(B0, 1, 0); PG8_SCHED; PG8_LDA(At, 1, 0); PG8_STAGE(PG8_SA(0, 1), a2 + hstep, voffA);
            PG8_WAIT_L(8); PG8_BAR; PG8_WAIT_L(0); PG8_MMA(0, 0, At, B0); PG8_BAR; PG8_SCHED;
            PG8_LDB(B1, 1, 1); PG8_STAGE(PG8_SB(1, 0), b3, voffB);
            PG8_BAR; PG8_WAIT_L(0); PG8_MMA(0, 1, At, B1); PG8_BAR;
            PG8_LDA(At, 1, 1); PG8_STAGE(PG8_SA(1, 0), a3, voffA);
            PG8_BAR; PG8_WAIT_L(0); PG8_MMA(1, 0, At, B0); PG8_BAR; PG8_SCHED;
            PG8_STAGE(PG8_SB(1, 1), b3 + hstep, voffB);
            PG8_WAIT_V(6); PG8_BAR; PG8_MMA(1, 1, At, B1); PG8_BAR;
            }
        }
        if constexpr (ALIGN_EPI) { if (wr == 0) PG8_BAR; }
        if constexpr (!Epi::AFTER_DRAIN) { E(acc, cur, wr, wc, fr, fq); S.done(cur); }
        if (!has_next) break;
#pragma unroll
        for (int a = 0; a < 2; ++a)
#pragma unroll
            for (int b = 0; b < 2; ++b)
#pragma unroll
                for (int m = 0; m < 4; ++m)
#pragma unroll
                    for (int n = 0; n < 2; ++n) acc[a][b][m][n] = (f32x4){0.f, 0.f, 0.f, 0.f};
        cur = nxt; cA = nA; cB = nB; ++ui;
        if constexpr (ALIGN_EPI) { if (wr == 1) PG8_BAR; }
    }
    PG8_WAIT_V(0);
    if constexpr (!ALIGN_EPI) { if (wr == 0) PG8_BAR; }
    PG8_BAR;
    if constexpr (Epi::AFTER_DRAIN) { E.fused(acc, cur, wr, wc, fr, fq, lds, wid, lane); S.done(cur); }
#undef PG8_SA
#undef PG8_SB
#undef PG8_STAGE
#undef PG8_LDA
#undef PG8_LDB
#undef PG8_MMA
#undef PG8_WAIT_V
#undef PG8_WAIT_L
#undef PG8_BAR
#undef PG8_SCHED
}
}
#define GAS __attribute__((address_space(1)))
#define LAS __attribute__((address_space(3)))
typedef unsigned short bf16;
typedef unsigned v4u __attribute__((ext_vector_type(4)));
typedef float f32x4 __attribute__((ext_vector_type(4)));
typedef short bf16x8 __attribute__((ext_vector_type(8)));
typedef GAS unsigned gu32;
typedef GAS unsigned long long gu64;
#define RLX_AGENT __ATOMIC_RELAXED, __HIP_MEMORY_SCOPE_AGENT
#define LDS_WAIT() asm volatile("s_waitcnt lgkmcnt(0)" ::: "memory")
#define VM_WAIT() asm volatile("s_waitcnt vmcnt(0)" ::: "memory")
__device__ __forceinline__ unsigned long long rt() { return __builtin_amdgcn_s_memrealtime(); }
__device__ __forceinline__ unsigned f2bf(float f) { unsigned u = __builtin_bit_cast(unsigned, f); return (u + 0x7fffu + ((u >> 16) & 1u)) >> 16; }
__device__ __forceinline__ unsigned pk2(float lo, float hi) { return f2bf(lo) | (f2bf(hi) << 16); }

#define XB_TMO      128
#define XB_XCNT(j)  (256  + 64 * (j))
#define XB_XSUB(j)  (1280 + 64 * (j))
#define XB_XGEN(j)  (2304 + 64 * (j))
#define XB_TOP      3328
#define XB_TOPGEN   3392
#define XCD_BAR_WORDS 3456
#define XB_SPIN_CAP (1u << 18)

__device__ __forceinline__ unsigned xb_ld(unsigned* p)              { return __hip_atomic_load(p, __ATOMIC_RELAXED, __HIP_MEMORY_SCOPE_AGENT); }
__device__ __forceinline__ unsigned xb_add(unsigned* p, unsigned v) { return __hip_atomic_fetch_add(p, v, __ATOMIC_RELAXED, __HIP_MEMORY_SCOPE_AGENT); }
__device__ __forceinline__ unsigned xb_xcc_id() { return (unsigned)__builtin_amdgcn_s_getreg((3 << 11) | 20) & 0xFu; }
#define XB_SPIN(cond, bar) do { unsigned _sp = 0; while (cond) { __builtin_amdgcn_s_sleep(1); \
    if ((++_sp & 255u) == 0u) { if (xb_ld(&(bar)[XB_TMO])) break; if (_sp > XB_SPIN_CAP) { atomicAdd(&(bar)[XB_TMO], 1u); break; } } } } while (0)

struct XcdBarrier {
    unsigned* bar; unsigned x;
    volatile LAS unsigned* st;
};

__device__ __forceinline__ XcdBarrier xcd_barrier_post(unsigned* bar, volatile LAS unsigned* st) {
    XcdBarrier b; b.bar = bar; b.x = xb_xcc_id(); b.st = st;
    if (threadIdx.x == 0) (void)xb_add(&bar[XB_XCNT(b.x)], 1u);
    return b;
}
__device__ __forceinline__ void xcd_barrier_complete(unsigned* bar, unsigned x, unsigned& nloc, unsigned& nx) {
    const unsigned G = gridDim.x * gridDim.y * gridDim.z;
    unsigned sum, cnt, mine, sp = 0u;
    for (;;) {
        sum = 0u; cnt = 0u; mine = 0u;
#pragma unroll
        for (unsigned j = 0; j < 16; ++j) { const unsigned c = xb_ld(&bar[XB_XCNT(j)]); sum += c; cnt += (c > 0u) ? 1u : 0u; mine = (j == x) ? c : mine; }
        if (sum == G) break;
        __builtin_amdgcn_s_sleep(1);
        if ((++sp & 255u) == 0u) { if (xb_ld(&bar[XB_TMO])) break; if (sp > XB_SPIN_CAP) { atomicAdd(&bar[XB_TMO], 1u); break; } }
    }
    nloc = mine > 0u ? mine : 1u; nx = cnt > 0u ? cnt : 1u;
}

__device__ __forceinline__ void xcd_barrier(const XcdBarrier& b) {
    asm volatile("s_waitcnt vmcnt(0)" ::: "memory");
    __syncthreads();
    if (threadIdx.x == 0) {
        unsigned* bar = b.bar;
        __builtin_amdgcn_s_waitcnt(0);
        unsigned nloc = b.st[0], nx = b.st[1];
        if (nloc == 0u) { xcd_barrier_complete(bar, b.x, nloc, nx); b.st[0] = nloc; b.st[1] = nx; }
        const unsigned old = xb_add(&bar[XB_XSUB(b.x)], 1u);
        const unsigned gen = old / nloc;
        if (old + 1u == (gen + 1u) * nloc) {
            __builtin_amdgcn_fence(__ATOMIC_RELEASE, "agent");
            asm volatile("s_waitcnt vmcnt(0)" ::: "memory");
            const unsigned og = xb_add(&bar[XB_TOP], 1u);
            const unsigned tg = og / nx;
            if (og + 1u == (tg + 1u) * nx) xb_add(&bar[XB_TOPGEN], 1u);
            else XB_SPIN(xb_ld(&bar[XB_TOPGEN]) == tg, bar);
            __builtin_amdgcn_fence(__ATOMIC_ACQUIRE, "agent");
            xb_add(&bar[XB_XGEN(b.x)], 1u);
            asm volatile("s_waitcnt vmcnt(0)" ::: "memory");
        } else {
            XB_SPIN(xb_ld(&bar[XB_XGEN(b.x)]) == gen, bar);
            __builtin_amdgcn_fence(__ATOMIC_ACQUIRE, "agent");
            asm volatile("s_waitcnt vmcnt(0)" ::: "memory");
        }
    }
    __syncthreads();
}

namespace fa {
#define FA_LAS __attribute__((address_space(3)))
typedef unsigned short bf16;
typedef short bf16x8 __attribute__((ext_vector_type(8)));
typedef short s16x4 __attribute__((ext_vector_type(4)));
typedef float f32x16 __attribute__((ext_vector_type(16)));
typedef float f32x4 __attribute__((ext_vector_type(4)));
typedef unsigned u32x4 __attribute__((ext_vector_type(4)));
constexpr int D = 128, KVBLK = 64, SHM_V = KVBLK * D * 2, SHM_K = KVBLK * D * 2;
constexpr int OFF_V = 0, OFF_K = 2 * SHM_V, OFF_WS = 2 * SHM_V + 2 * SHM_K, WS_PER_WAVE = 512, ENGINE_BYTES = OFF_WS + 8 * WS_PER_WAVE;
constexpr float SCALE = 0.08838834764831845f;
constexpr float THR = 8.f;
constexpr float C2 = 1.4426950408889634f * SCALE;
#define KSWZ(row, colB) ((row) * 256 + ((colB) ^ (((row) & 7) << 4)))
#define SBAR() __builtin_amdgcn_sched_barrier(0)
__device__ __forceinline__ int v_st(int k, int c) { const int kk = (k & ~0xC) | ((k & 4) << 1) | ((k & 8) >> 1); return ((kk >> 3) * 4 + (c >> 5)) * 512 + ((kk & 7) * 32 + (c & 31)) * 2; }
__device__ __forceinline__ int v_rd_base(int lane) { return ((lane & 3) << 3) | (((lane >> 2) & 3) << 6) | (((lane >> 4) & 1) << 5) | (((lane >> 5) & 1) << 8); }
constexpr int v_rd_off(int d0, int ks, int half) { return d0 * 512 + ks * 4096 + half * 2048; }
__device__ __forceinline__ int crow(int r, int hi) { return (r & 3) + 8 * (r >> 2) + 4 * hi; }
__device__ __forceinline__ unsigned cvtpk(float lo, float hi) { unsigned r; asm volatile("v_cvt_pk_bf16_f32 %0, %1, %2" : "=v"(r) : "v"(lo), "v"(hi)); return r; }
__device__ __forceinline__ float bf2f(unsigned short b) { return __uint_as_float(((unsigned)b) << 16); }
__device__ __forceinline__ void mask_tile(f32x16& p0, f32x16& p1, int dq, unsigned W) {
    const float NEG = -__builtin_inff();
#pragma unroll
    for (int r = 0; r < 16; ++r) { const int c = (r & 3) + 8 * (r >> 2);
        if ((unsigned)(dq - c) >= W) p0[r] = NEG;
        if ((unsigned)(dq - c - 32) >= W) p1[r] = NEG; }
}
__device__ __forceinline__ void mask_gt(f32x16& p0, f32x16& p1, int lim, int hi) {
    const float NEG = -__builtin_inff();
#pragma unroll
    for (int r = 0; r < 16; ++r) { const int c = (r & 3) + 8 * (r >> 2) + 4 * hi;
        if (c > lim) p0[r] = NEG;
        if (c + 32 > lim) p1[r] = NEG; }
}
__device__ __forceinline__ void partialSM(f32x16& p0, f32x16& p1, float& m_reg, float& mn, float& alpha) {
    float pmax = p0[0];
#pragma unroll
    for (int r = 1; r < 16; ++r) pmax = fmaxf(pmax, p0[r]);
#pragma unroll
    for (int r = 0; r < 16; ++r) pmax = fmaxf(pmax, p1[r]);
    { auto rr = __builtin_amdgcn_permlane32_swap(__float_as_uint(pmax), __float_as_uint(pmax), false, false);
      pmax = fmaxf(__uint_as_float(rr[0]), __uint_as_float(rr[1])); }
    if (__builtin_expect(__all((pmax - m_reg) * SCALE <= THR), 1)) { mn = m_reg; alpha = 1.f; }
    else { mn = fmaxf(m_reg, pmax); alpha = __builtin_amdgcn_exp2f((m_reg - mn) * C2); m_reg = mn; }
    const float mnL = -mn * C2;
#pragma unroll
    for (int r = 0; r < 16; ++r) p0[r] = fmaf(p0[r], C2, mnL);
#pragma unroll
    for (int r = 0; r < 16; ++r) p1[r] = fmaf(p1[r], C2, mnL);
#pragma unroll
    for (int r = 0; r < 16; ++r) p0[r] = __builtin_amdgcn_exp2f(p0[r]);
}
#define FA_PK4(P, B_, OUT) do { unsigned a0 = cvtpk(P[B_+0], P[B_+1]), a1 = cvtpk(P[B_+2], P[B_+3]);                          \
        unsigned b0 = cvtpk(P[B_+4], P[B_+5]), b1 = cvtpk(P[B_+6], P[B_+7]);                                             \
        auto r0 = __builtin_amdgcn_permlane32_swap(a0, b0, false, false); auto r1 = __builtin_amdgcn_permlane32_swap(a1, b1, false, false); \
        u32x4 w = {r0[0], r1[0], r0[1], r1[1]}; OUT = *reinterpret_cast<bf16x8*>(&w); } while (0)
__device__ __forceinline__ void packP(const f32x16& p0, const f32x16& p1, bf16x8& pa0, bf16x8& pa1, bf16x8& pa2, bf16x8& pa3) {
    FA_PK4(p0, 0, pa0); FA_PK4(p0, 8, pa1); FA_PK4(p1, 0, pa2); FA_PK4(p1, 8, pa3);
}
__device__ __forceinline__ void finishSM(f32x16& p0, f32x16& p1, float alpha, float& l_reg, bf16x8& pa0, bf16x8& pa1, bf16x8& pa2, bf16x8& pa3) {
#pragma unroll
    for (int r = 0; r < 16; ++r) p1[r] = __builtin_amdgcn_exp2f(p1[r]);
    float ps = 0;
#pragma unroll
    for (int r = 0; r < 16; ++r) ps += p0[r];
#pragma unroll
    for (int r = 0; r < 16; ++r) ps += p1[r];
    { auto rr = __builtin_amdgcn_permlane32_swap(__float_as_uint(ps), __float_as_uint(ps), false, false);
      ps = __uint_as_float(rr[0]) + __uint_as_float(rr[1]); }
    l_reg = l_reg * alpha + ps;
    packP(p0, p1, pa0, pa1, pa2, pa3);
}
__device__ __forceinline__ void qkt(f32x16& p0, f32x16& p1, const FA_LAS char* Kt, int r32, int hi, const bf16x8* qr) {
    p0 = f32x16{}; p1 = f32x16{};
    const FA_LAS char* kb[4];
#pragma unroll
    for (int dd = 0; dd < 4; ++dd) kb[dd] = Kt + KSWZ(r32, (dd * 16 + hi * 8) * 2);
#pragma unroll
    for (int d0 = 0; d0 < 8; ++d0) { const FA_LAS char* a = kb[d0 & 3] + (d0 >> 2) * 128;
        bf16x8 b0 = *reinterpret_cast<const FA_LAS bf16x8*>(a);
        bf16x8 b1 = *reinterpret_cast<const FA_LAS bf16x8*>(a + 32 * 256);
        p0 = __builtin_amdgcn_mfma_f32_32x32x16_bf16(b0, qr[d0], p0, 0, 0, 0);
        p1 = __builtin_amdgcn_mfma_f32_32x32x16_bf16(b1, qr[d0], p1, 0, 0, 0); }
}
__device__ __forceinline__ void pv_tile(f32x16* o, int vb0, bf16x8 pa0, bf16x8 pa1, bf16x8 pa2, bf16x8 pa3) {
#define TRRD(dst, off) asm volatile("ds_read_b64_tr_b16 %0, %1 offset:%2" : "=&v"(dst) : "v"(vb0), "i"(off) : "memory")
#define PV_D0(d0) do { s16x4 l0, l1, l2, l3, h0, h1, h2, h3; constexpr int b_ = v_rd_off(d0, 0, 0); \
        TRRD(l0, b_); TRRD(h0, b_ + 2048); TRRD(l1, b_ + 4096); TRRD(h1, b_ + 6144); TRRD(l2, b_ + 8192); TRRD(h2, b_ + 10240); TRRD(l3, b_ + 12288); TRRD(h3, b_ + 14336); \
        asm volatile("s_waitcnt lgkmcnt(0)" ::: "memory"); SBAR();   \
        o[d0] = __builtin_amdgcn_mfma_f32_32x32x16_bf16(pa0, (bf16x8){l0[0], l0[1], l0[2], l0[3], h0[0], h0[1], h0[2], h0[3]}, o[d0], 0, 0, 0);   \
        o[d0] = __builtin_amdgcn_mfma_f32_32x32x16_bf16(pa1, (bf16x8){l1[0], l1[1], l1[2], l1[3], h1[0], h1[1], h1[2], h1[3]}, o[d0], 0, 0, 0);   \
        o[d0] = __builtin_amdgcn_mfma_f32_32x32x16_bf16(pa2, (bf16x8){l2[0], l2[1], l2[2], l2[3], h2[0], h2[1], h2[2], h2[3]}, o[d0], 0, 0, 0);   \
        o[d0] = __builtin_amdgcn_mfma_f32_32x32x16_bf16(pa3, (bf16x8){l3[0], l3[1], l3[2], l3[3], h3[0], h3[1], h3[2], h3[3]}, o[d0], 0, 0, 0); } while (0)
    PV_D0(0); PV_D0(1); PV_D0(2); PV_D0(3);
#undef PV_D0
#undef TRRD
}
struct Stg { bf16x8 k0, k1, v0, v1; };
__device__ __forceinline__ void rescale_o(f32x16* o, float alpha, FA_LAS float* al_l, int r32, int hi) {
    if (__any(alpha < 1.f)) { if (hi == 0) al_l[r32] = alpha; asm volatile("s_waitcnt lgkmcnt(0)" ::: "memory");
#pragma unroll
        for (int d_ = 0; d_ < 4; ++d_)
#pragma unroll
            for (int r = 0; r < 16; ++r) o[d_][r] *= al_l[crow(r, hi)];
        asm volatile("s_waitcnt lgkmcnt(0)" ::: "memory"); }
}

struct BandArgs { const bf16* Q; const bf16* K; const bf16* V; bf16* O; size_t o_stride; float* lse; size_t lse_stride; int P0, W, mode; float sink; };
__device__ __forceinline__ void banded_unit(FA_LAS char* lds, const BandArgs& a) {
    int tid_ = threadIdx.x; asm volatile("" : "+v"(tid_));
    const int tid = tid_, wid = __builtin_amdgcn_readfirstlane(tid >> 6), lane = tid & 63, r32 = lane & 31, hi = lane >> 5;
    const int P0 = a.P0, W = a.W;
    const int lowk = P0 - W + 1, j_lo = lowk > 0 ? (lowk >> 6) : 0, j_hi = (P0 >> 6) + 4, NT = j_hi - j_lo;
    const int qlo = P0 + wid * 32, qm = qlo + r32 - 4 * hi;
    const FA_LAS char* V_lds = lds + OFF_V; const FA_LAS char* K_lds = lds + OFF_K;
    FA_LAS float* ws = (FA_LAS float*)(lds + OFF_WS + wid * WS_PER_WAVE); FA_LAS float* li_l = ws; FA_LAS float* al_l = ws + 32; FA_LAS float* co_l = ws + 64;
    const int sr = tid >> 4, sc = (tid & 15) * 8, vst0 = v_st(sr, sc), vst1 = v_st(32 + sr, sc), kws = KSWZ(sr, sc * 2);
    const int vb0 = (int)(unsigned)(uintptr_t)V_lds + v_rd_base(lane);
    bf16x8 qr[8];
#pragma unroll
    for (int d0 = 0; d0 < 8; ++d0) qr[d0] = *(const bf16x8*)(a.Q + (size_t)(qlo + r32) * D + d0 * 16 + hi * 8);
    float m_reg = -1e30f, l_reg = 0.f; f32x16 o[4] = {};
    Stg S;
#define FA_GLOAD(kb0) do { S.k0 = *(const bf16x8*)(a.K + (size_t)((kb0) + sr) * D + sc); S.k1 = *(const bf16x8*)(a.K + (size_t)((kb0) + 32 + sr) * D + sc); \
                           S.v0 = *(const bf16x8*)(a.V + (size_t)((kb0) + sr) * D + sc); S.v1 = *(const bf16x8*)(a.V + (size_t)((kb0) + 32 + sr) * D + sc); } while (0)
#define FA_LWRITE(bf) do { *(FA_LAS bf16x8*)(lds + OFF_K + (bf) * SHM_K + kws) = S.k0; *(FA_LAS bf16x8*)(lds + OFF_K + (bf) * SHM_K + kws + 32 * 256) = S.k1; \
                           *(FA_LAS bf16x8*)(lds + OFF_V + (bf) * SHM_V + vst0) = S.v0; *(FA_LAS bf16x8*)(lds + OFF_V + (bf) * SHM_V + vst1) = S.v1; } while (0)
    FA_GLOAD(j_lo * 64); FA_LWRITE(0);
    __syncthreads();
    for (int t = 0; t < NT; ++t) {
        const int buf = t & 1, kb = (j_lo + t) * 64;
        if (t + 1 < NT) FA_GLOAD(kb + 64);
        const bool act = (kb <= qlo + 31) && (kb + 63 >= qlo - W + 1);
        if (act) {
            f32x16 p0, p1; float mn, alpha; bf16x8 pa0, pa1, pa2, pa3;
            qkt(p0, p1, K_lds + buf * SHM_K, r32, hi, qr);
            if (kb + 63 > qlo || kb <= qlo + 31 - W) mask_tile(p0, p1, qm - kb, (unsigned)W);
            partialSM(p0, p1, m_reg, mn, alpha);
            rescale_o(o, alpha, al_l, r32, hi);
            finishSM(p0, p1, alpha, l_reg, pa0, pa1, pa2, pa3);
            pv_tile(o, vb0 + buf * SHM_V, pa0, pa1, pa2, pa3);
        }
        if (t + 1 < NT) FA_LWRITE(buf ^ 1);
        __syncthreads();
    }
#undef FA_GLOAD
#undef FA_LWRITE
    const int mode = a.mode; float coef, cold = 0.f;
    const size_t urow = (size_t)(qlo + r32);
    if (mode == 1) { coef = 1.0f / (l_reg + __builtin_amdgcn_exp2f(a.sink * 1.4426950408889634f - m_reg * C2)); }
    else if (mode == 2) { coef = 1.0f / l_reg; if (hi == 0) a.lse[urow * a.lse_stride] = m_reg * SCALE + __logf(l_reg); }
    else if (mode == 3) { const float lg = m_reg * SCALE + __logf(l_reg), lo_ = a.lse[urow * a.lse_stride], mx = fmaxf(lg, lo_), e0 = __expf(lo_ - mx), e1 = __expf(lg - mx), inv = 1.0f / (e0 + e1);
        cold = e0 * inv; coef = e1 * inv / l_reg; if (hi == 0) a.lse[urow * a.lse_stride] = mx + __logf(e0 + e1); }
    else coef = 1.0f / l_reg;
    if (hi == 0) { li_l[r32] = coef; co_l[r32] = cold; }
    asm volatile("s_waitcnt lgkmcnt(0)" ::: "memory");
#pragma unroll
    for (int r = 0; r < 16; ++r) { const int orow = crow(r, hi); const float cf = li_l[orow], co = co_l[orow];
        bf16* Ow = a.O + (size_t)(qlo + orow) * a.o_stride;
#pragma unroll
        for (int d0 = 0; d0 < 4; ++d0) { const float v = o[d0][r] * cf, vn = __shfl_xor(v, 1);
            if ((r32 & 1) == 0) { unsigned* p = (unsigned*)(Ow + d0 * 32 + r32); float x0 = v, x1 = vn;
                if (mode == 3) { const unsigned old = *p; x0 += co * __uint_as_float(old << 16); x1 += co * __uint_as_float(old & 0xffff0000u); }
                *p = cvtpk(x0, x1); } } }
    asm volatile("s_waitcnt lgkmcnt(0)" ::: "memory");
    __syncthreads();
}

constexpr int NSA_OFF_IMP = ENGINE_BYTES;
constexpr int NSA_OFF_SEL = NSA_OFF_IMP + 65536;
constexpr int NSA_OFF_UNI = NSA_OFF_SEL + 2048;
constexpr int NSA_OFF_LIST = NSA_OFF_UNI + 64;
constexpr int NSA_BYTES = NSA_OFF_LIST + 1024;
struct NsaArgs { const bf16* QA; const bf16* KA; const bf16* VA; const bf16* kc; const bf16* vc; const float* gates; const bf16* owin; bf16* ocat; int b, g, t0; };
__device__ __forceinline__ void nsa_unit(FA_LAS char* lds, const NsaArgs& a) {
    int tid_ = threadIdx.x; asm volatile("" : "+v"(tid_));
    const int tid = tid_, wid = __builtin_amdgcn_readfirstlane(tid >> 6), lane = tid & 63, r32 = lane & 31, hi = lane >> 5;
    const int b = a.b, g = a.g, t0 = a.t0, bg = b * 2 + g;
    const int hq = r32 >> 3, qq = r32 & 7, tq = t0 + 8 * wid + qq, head = g * 4 + hq;
    const int cur = t0 >> 6;
    const FA_LAS char* V_lds = lds + OFF_V; const FA_LAS char* K_lds = lds + OFF_K;
    FA_LAS float* ws = (FA_LAS float*)(lds + OFF_WS + wid * WS_PER_WAVE); FA_LAS float* li_l = ws; FA_LAS float* al_l = ws + 32; FA_LAS float* g1_l = ws + 64; FA_LAS float* g2_l = ws + 96;
    FA_LAS float* impw = (FA_LAS float*)(lds + NSA_OFF_IMP + wid * 8192);
    FA_LAS unsigned* selw = (FA_LAS unsigned*)(lds + NSA_OFF_SEL + wid * 256);
    FA_LAS unsigned* uni = (FA_LAS unsigned*)(lds + NSA_OFF_UNI);
    FA_LAS int* blist = (FA_LAS int*)(lds + NSA_OFF_LIST);
    const int sr = tid >> 4, sc = (tid & 15) * 8, vst0 = v_st(sr, sc), vst1 = v_st(32 + sr, sc), kws = KSWZ(sr, sc * 2);
    const int vb0 = (int)(unsigned)(uintptr_t)V_lds + v_rd_base(lane);
    bf16x8 qr[8];
#pragma unroll
    for (int d0 = 0; d0 < 8; ++d0) qr[d0] = *(const bf16x8*)(a.QA + ((size_t)(b * 8 + head) * T + tq) * D + d0 * 16 + hi * 8);
    if (tid < 16) uni[tid] = 0u;
    const bf16* Kc = a.kc + (size_t)bg * 1024 * D; const bf16* Vc = a.vc + (size_t)bg * 1024 * D;
    const int n_ct = ((t0 + 32) >> 10) + 1;
    const int cvis = tq >= 31 ? ((tq - 31) >> 4) : -1;
    Stg S;
#define FA_LWRITE_K(bf) do { *(FA_LAS bf16x8*)(lds + OFF_K + (bf) * SHM_K + kws) = S.k0; *(FA_LAS bf16x8*)(lds + OFF_K + (bf) * SHM_K + kws + 32 * 256) = S.k1; } while (0)
#define FA_LWRITE_V(bf) do { *(FA_LAS bf16x8*)(lds + OFF_V + (bf) * SHM_V + vst0) = S.v0; *(FA_LAS bf16x8*)(lds + OFF_V + (bf) * SHM_V + vst1) = S.v1; } while (0)
#define FA_GLOAD_K(P, kb0) do { S.k0 = *(const bf16x8*)((P) + (size_t)((kb0) + sr) * D + sc); S.k1 = *(const bf16x8*)((P) + (size_t)((kb0) + 32 + sr) * D + sc); } while (0)
#define FA_GLOAD_V(P, kb0) do { S.v0 = *(const bf16x8*)((P) + (size_t)((kb0) + sr) * D + sc); S.v1 = *(const bf16x8*)((P) + (size_t)((kb0) + 32 + sr) * D + sc); } while (0)
    float m_reg = -1e30f, l_reg = 0.f;
    FA_GLOAD_K(Kc, 0); FA_LWRITE_K(0);
    __syncthreads();
    for (int j = 0; j < n_ct; ++j) {
        const int buf = j & 1;
        if (j + 1 < n_ct) FA_GLOAD_K(Kc, (j + 1) * 64);
        { f32x16 p0, p1; float mn, alpha; bf16x8 pa0, pa1, pa2, pa3;
          qkt(p0, p1, K_lds + buf * SHM_K, r32, hi, qr);
          mask_gt(p0, p1, cvis - j * 64, hi);
          partialSM(p0, p1, m_reg, mn, alpha);
          finishSM(p0, p1, alpha, l_reg, pa0, pa1, pa2, pa3); }
        if (j + 1 < n_ct) FA_LWRITE_K(buf ^ 1);
        __syncthreads();
    }
    const float inv_l = l_reg > 0.f ? 1.0f / l_reg : 0.f, mnL = -m_reg * C2;
    f32x16 o[4] = {};
    float carry = 0.f;
    FA_GLOAD_K(Kc, 0); FA_GLOAD_V(Vc, 0); FA_LWRITE_K(0); FA_LWRITE_V(0);
    __syncthreads();
    for (int j = 0; j < n_ct; ++j) {
        const int buf = j & 1;
        if (j + 1 < n_ct) { FA_GLOAD_K(Kc, (j + 1) * 64); FA_GLOAD_V(Vc, (j + 1) * 64); }
        { f32x16 p0, p1; bf16x8 pa0, pa1, pa2, pa3;
          qkt(p0, p1, K_lds + buf * SHM_K, r32, hi, qr);
          mask_gt(p0, p1, cvis - j * 64, hi);
#pragma unroll
          for (int r = 0; r < 16; ++r) { p0[r] = __builtin_amdgcn_exp2f(fmaf(p0[r], C2, mnL)) * inv_l; p1[r] = __builtin_amdgcn_exp2f(fmaf(p1[r], C2, mnL)) * inv_l; }
          float Av[8], Xv[8];
#pragma unroll
          for (int i = 0; i < 4; ++i) { Av[i] = (p0[4 * i] + p0[4 * i + 1]) + (p0[4 * i + 2] + 0.5f * p0[4 * i + 3]); Xv[i] = 0.5f * p0[4 * i + 3];
                                        Av[4 + i] = (p1[4 * i] + p1[4 * i + 1]) + (p1[4 * i + 2] + 0.5f * p1[4 * i + 3]); Xv[4 + i] = 0.5f * p1[4 * i + 3]; }
#pragma unroll
          for (int i = 0; i < 8; ++i) Xv[i] = __shfl_xor(Xv[i], 32);
#pragma unroll
          for (int i = 0; i < 8; ++i) { float v = Av[i] + (hi ? Xv[i] : (i > 0 ? Xv[i - 1] : carry));
              v += __shfl_xor(v, 8); v += __shfl_xor(v, 16);
              if (r32 < 8) impw[r32 * 256 + 16 * j + 2 * i + hi] = v; }
          carry = Xv[7];
          packP(p0, p1, pa0, pa1, pa2, pa3);
          pv_tile(o, vb0 + buf * SHM_V, pa0, pa1, pa2, pa3); }
        if (j + 1 < n_ct) { FA_LWRITE_K(buf ^ 1); FA_LWRITE_V(buf ^ 1); }
        __syncthreads();
    }
    { const float* gp = a.gates + ((size_t)(b * T + tq)) * 24 + head * 3; if (hi == 0) { li_l[r32] = gp[0]; g1_l[r32] = gp[1]; g2_l[r32] = gp[2]; } }
    asm volatile("s_waitcnt lgkmcnt(0)" ::: "memory");
#pragma unroll
    for (int r = 0; r < 16; ++r) { const int rho = crow(r, hi); const float gc = li_l[rho];
        bf16* Ow = a.ocat + ((size_t)(b * T + t0 + 8 * wid + (rho & 7))) * 2048 + (g * 4 + (rho >> 3)) * 128;
#pragma unroll
        for (int d0 = 0; d0 < 4; ++d0) { const float v = o[d0][r] * gc, vn = __shfl_xor(v, 1);
            if ((r32 & 1) == 0) *(unsigned*)(Ow + d0 * 32 + r32) = cvtpk(v, vn); } }
    asm volatile("s_waitcnt lgkmcnt(0)" ::: "memory");
    unsigned selbits = 0u;
    { const int qq8 = lane >> 3, sub = lane & 7;
      if (cur + 1 <= 16) { selbits = (sub == 0) ? ((cur + 1 >= 32) ? 0xffffffffu : ((1u << (cur + 1)) - 1u)) : 0u; }
      else {
        float v[32];
#pragma unroll
        for (int i4 = 0; i4 < 8; ++i4) { const f32x4 x = *(const FA_LAS f32x4*)(impw + qq8 * 256 + sub * 32 + i4 * 4); v[4 * i4] = x[0]; v[4 * i4 + 1] = x[1]; v[4 * i4 + 2] = x[2]; v[4 * i4 + 3] = x[3]; }
#pragma unroll
        for (int i = 0; i < 32; ++i) { const int n = sub * 32 + i; v[i] = (n == 0 || n == cur || n == cur - 1) ? __builtin_inff() : (n <= cur ? v[i] : -__builtin_inff()); }
        for (int round = 0; round < 16; ++round) {
            float bv = -__builtin_inff(); int bn = sub * 32;
#pragma unroll
            for (int i = 0; i < 32; ++i) { const bool take = (((selbits >> i) & 1u) == 0u) && (v[i] > bv); bv = take ? v[i] : bv; bn = take ? sub * 32 + i : bn; }
#pragma unroll
            for (int s = 1; s < 8; s <<= 1) { const float ov = __shfl_xor(bv, s); const int on = __shfl_xor(bn, s); const bool better = (ov > bv) || (ov == bv && on < bn); bv = better ? ov : bv; bn = better ? on : bn; }
            if ((bn >> 5) == sub) selbits |= 1u << (bn & 31);
        }
      }
      selw[qq8 * 8 + sub] = selbits; }
    unsigned wuni = selbits; wuni |= __shfl_xor(wuni, 8); wuni |= __shfl_xor(wuni, 16); wuni |= __shfl_xor(wuni, 32);
    if (lane < 8) __hip_atomic_fetch_or(uni + lane, wuni, __ATOMIC_RELAXED, __HIP_MEMORY_SCOPE_WORKGROUP);
    __syncthreads();
    { unsigned w8[8]; int tot = 0;
#pragma unroll
      for (int k = 0; k < 8; ++k) w8[k] = uni[k];
      if (tid < 256) { const int n = tid; int pos = 0; unsigned mine = 0;
#pragma unroll
          for (int k = 0; k < 8; ++k) { if (k < (n >> 5)) pos += __popc(w8[k]); if (k == (n >> 5)) mine = w8[k]; }
          if ((mine >> (n & 31)) & 1u) { pos += __popc(mine & ((1u << (n & 31)) - 1u)); blist[pos] = n; } }
#pragma unroll
      for (int k = 0; k < 8; ++k) tot += __popc(w8[k]);
      if (tid == 0) uni[8] = (unsigned)tot; }
    __syncthreads();
    const int nblk = __builtin_amdgcn_readfirstlane((int)uni[8]);
    const bf16* Ks = a.KA + (size_t)(b * 6 + 2 + g) * T * D; const bf16* Vs = a.VA + (size_t)(b * 6 + 2 + g) * T * D;
    m_reg = -1e30f; l_reg = 0.f;
#pragma unroll
    for (int d0 = 0; d0 < 4; ++d0) o[d0] = f32x16{};
    int n_cur = __builtin_amdgcn_readfirstlane(blist[0]);
    FA_GLOAD_K(Ks, n_cur * 64); FA_GLOAD_V(Vs, n_cur * 64); FA_LWRITE_K(0); FA_LWRITE_V(0);
    __syncthreads();
    for (int i = 0; i < nblk; ++i) {
        const int buf = i & 1; int n_nxt = 0;
        if (i + 1 < nblk) { n_nxt = __builtin_amdgcn_readfirstlane(blist[i + 1]); FA_GLOAD_K(Ks, n_nxt * 64); FA_GLOAD_V(Vs, n_nxt * 64); }
        const unsigned wword = (unsigned)__builtin_amdgcn_readlane((int)wuni, n_cur >> 5);
        if ((wword >> (n_cur & 31)) & 1u) {
            f32x16 p0, p1; float mn, alpha; bf16x8 pa0, pa1, pa2, pa3;
            qkt(p0, p1, K_lds + buf * SHM_K, r32, hi, qr);
            const unsigned myw = selw[qq * 8 + (n_cur >> 5)];
            int lim = ((myw >> (n_cur & 31)) & 1u) ? 63 : -1;
            if (n_cur == cur) lim = lim < (tq & 63) ? lim : (tq & 63);
            if (lim < 63) mask_gt(p0, p1, lim, hi);
            partialSM(p0, p1, m_reg, mn, alpha);
            rescale_o(o, alpha, al_l, r32, hi);
            finishSM(p0, p1, alpha, l_reg, pa0, pa1, pa2, pa3);
            pv_tile(o, vb0 + buf * SHM_V, pa0, pa1, pa2, pa3);
        }
        if (i + 1 < nblk) { FA_LWRITE_K(buf ^ 1); FA_LWRITE_V(buf ^ 1); }
        n_cur = n_nxt;
        __syncthreads();
    }
#undef FA_LWRITE_K
#undef FA_LWRITE_V
#undef FA_GLOAD_K
#undef FA_GLOAD_V
    if (hi == 0) li_l[r32] = l_reg > 0.f ? g1_l[r32] / l_reg : 0.f;
    asm volatile("s_waitcnt lgkmcnt(0)" ::: "memory");
#pragma unroll
    for (int r = 0; r < 16; ++r) { const int rho = crow(r, hi); const float cs = li_l[rho], gw = g2_l[rho];
        const size_t trow = (size_t)(b * T + t0 + 8 * wid + (rho & 7)); const int hh = g * 4 + (rho >> 3);
        bf16* Ow = a.ocat + trow * 2048 + hh * 128; const bf16* Wn = a.owin + trow * 1024 + hh * 128;
#pragma unroll
        for (int d0 = 0; d0 < 4; ++d0) { const float v = o[d0][r] * cs, vn = __shfl_xor(v, 1);
            if ((r32 & 1) == 0) { unsigned* p = (unsigned*)(Ow + d0 * 32 + r32); const unsigned old = *p, wv = *(const unsigned*)(Wn + d0 * 32 + r32);
                const float x0 = v + __uint_as_float(old << 16) + gw * __uint_as_float(wv << 16), x1 = vn + __uint_as_float(old & 0xffff0000u) + gw * __uint_as_float(wv & 0xffff0000u);
                *p = cvtpk(x0, x1); } } }
    asm volatile("s_waitcnt lgkmcnt(0)" ::: "memory");
    __syncthreads();
}

__device__ __forceinline__ void compress_task(FA_LAS char* lds, const bf16* src  , const float* pe, const bf16* w1t  , const bf16* w2t  , bf16* dst  , int rb) {
    int tid_ = threadIdx.x; asm volatile("" : "+v"(tid_));
    const int tid = tid_, wid = __builtin_amdgcn_readfirstlane(tid >> 6), lane = tid & 63, r32 = lane & 31, hi = lane >> 5;
    const int m0 = rb * 32, bg = m0 >> 10, c0 = m0 & 1023, b = bg >> 1, g = bg & 1;
    const bf16* arow = src + (size_t)(b * 6 + g) * T * D + (size_t)(c0 + r32) * 2048;
    f32x16 acc[4] = {};
    const int kbeg = wid * 512;
#pragma unroll 4
    for (int ks = 0; ks < 32; ++ks) { const int k = kbeg + ks * 16 + hi * 8;
        const bf16x8 raw = *(const bf16x8*)(arow + k); const f32x4 pe0 = *(const f32x4*)(pe + k), pe1 = *(const f32x4*)(pe + k + 4);
        u32x4 w; w.x = cvtpk(bf2f((unsigned short)raw[0]) + pe0[0], bf2f((unsigned short)raw[1]) + pe0[1]); w.y = cvtpk(bf2f((unsigned short)raw[2]) + pe0[2], bf2f((unsigned short)raw[3]) + pe0[3]);
        w.z = cvtpk(bf2f((unsigned short)raw[4]) + pe1[0], bf2f((unsigned short)raw[5]) + pe1[1]); w.w = cvtpk(bf2f((unsigned short)raw[6]) + pe1[2], bf2f((unsigned short)raw[7]) + pe1[3]);
        const bf16x8 af = *reinterpret_cast<bf16x8*>(&w);
#pragma unroll
        for (int nt = 0; nt < 4; ++nt) { const bf16x8 bfr = *(const bf16x8*)(w1t + (size_t)(nt * 32 + r32) * 4096 + k); acc[nt] = __builtin_amdgcn_mfma_f32_32x32x16_bf16(af, bfr, acc[nt], 0, 0, 0); } }
    FA_LAS float* part = (FA_LAS float*)lds;
#pragma unroll
    for (int nt = 0; nt < 4; ++nt)
#pragma unroll
        for (int r = 0; r < 16; ++r) part[wid * 4096 + crow(r, hi) * 128 + nt * 32 + r32] = acc[nt][r];
    __syncthreads();
    FA_LAS bf16* G = (FA_LAS bf16*)(lds + 131072);
    { const int e = tid * 8, m = e >> 7, n = e & 127; f32x4 s0 = {0.f, 0.f, 0.f, 0.f}, s1 = {0.f, 0.f, 0.f, 0.f};
#pragma unroll
      for (int w = 0; w < 8; ++w) { s0 += *(const FA_LAS f32x4*)(part + w * 4096 + e); s1 += *(const FA_LAS f32x4*)(part + w * 4096 + e + 4); }
      float x[8] = {s0[0], s0[1], s0[2], s0[3], s1[0], s1[1], s1[2], s1[3]};
#pragma unroll
      for (int j = 0; j < 8; ++j) { const float u = 0.7978845608028654f * (x[j] + 0.044715f * x[j] * x[j] * x[j]); const float th = 1.0f - 2.0f / (__expf(2.0f * u) + 1.0f); x[j] = 0.5f * x[j] * (1.0f + th); }
      u32x4 w; w.x = cvtpk(x[0], x[1]); w.y = cvtpk(x[2], x[3]); w.z = cvtpk(x[4], x[5]); w.w = cvtpk(x[6], x[7]);
      *(FA_LAS u32x4*)(G + m * 136 + n) = w; }
    __syncthreads();
    if (wid < 4) { f32x16 c = {};
#pragma unroll
        for (int ks = 0; ks < 8; ++ks) { const bf16x8 af = *(const FA_LAS bf16x8*)(G + r32 * 136 + ks * 16 + hi * 8); const bf16x8 bfr = *(const bf16x8*)(w2t + (size_t)(wid * 32 + r32) * 128 + ks * 16 + hi * 8);
            c = __builtin_amdgcn_mfma_f32_32x32x16_bf16(af, bfr, c, 0, 0, 0); }
#pragma unroll
        for (int r = 0; r < 16; ++r) { const float v = c[r], vn = __shfl_xor(v, 1);
            if ((r32 & 1) == 0) *(unsigned*)(dst + (size_t)(m0 + crow(r, hi)) * 128 + wid * 32 + r32) = cvtpk(v, vn); } }
    __syncthreads();
}
#undef FA_PK4
#undef KSWZ
#undef SBAR
}

constexpr int NWAVES = 8;
#ifndef MK_PER_PHASE
#define MK_PER_PHASE 0
#endif
constexpr int CW_BAR = 4096;
constexpr int LDS_BYTES = 147456, MISC_OFF = LDS_BYTES - 256;
static_assert(fa::NSA_BYTES <= MISC_OFF && 131072 + 32 * 136 * 2 <= MISC_OFF && pg8::STAGE_BYTES <= MISC_OFF, "LDS map");

struct Params {
    const float* x; const int* pos; const float* e_w_in; const float* e_w_o; const float* pe_k; const float* pe_v; const float* ck_w1; const float* ck_w2; const float* cv_w1; const float* cv_w2;
    const float* sinks; const float* o_w_in; const float* o_w_o; const float* ln1_g; const float* ln1_b; const float* w1; const float* w2; const float* ln2_g; const float* ln2_b;
    float* out; unsigned char* ws; int ph_lo, ph_hi; float inv_freq[64];
};

__device__ __forceinline__ float wave_sum(float v) {
#pragma unroll
    for (int o = 1; o < 64; o <<= 1) v += __shfl_xor(v, o);
    return v;
}
__device__ __forceinline__ int cphys(int d) { return 32 * ((d >> 4) & 3) + 16 * (d >> 6) + (d & 15); }
__device__ __forceinline__ int dst_row(int kind, int n) {
    if (kind == 0) return n;
    if (kind == 1) return (n & ~127) + cphys(n & 127);
    if (n < 2560) return (n & ~127) + cphys(n & 127);
    if (n < 2584) return 32 * 128 + (n - 2560);
    const int s = n - 2584; return (20 + (s >> 7)) * 128 + cphys(s & 127);
}
__device__ __forceinline__ void transpose_item(const float* W, int K, int N, unsigned short* WT, int kind, LAS float* scr, int item, int lane) {
    const int nblk = (N + 31) / 32, kb = item / nblk, nb = item % nblk, k0 = 64 * kb, n0 = 32 * nb;
    const bool okc = (n0 + (lane & 31)) < N;
#pragma unroll 8
    for (int i = 0; i < 32; ++i) { const int kk = 2 * i + (lane >> 5); scr[kk * 33 + (lane & 31)] = okc ? W[(size_t)(k0 + kk) * N + n0 + (lane & 31)] : 0.f; }
    asm volatile("s_waitcnt lgkmcnt(0)" ::: "memory");
    const int c = lane & 7;
#pragma unroll
    for (int j = 0; j < 4; ++j) { const int n = (lane >> 3) + 8 * j; const LAS float* s = scr + (8 * c) * 33 + n;
        v4u o; o.x = pk2(s[0 * 33], s[1 * 33]); o.y = pk2(s[2 * 33], s[3 * 33]); o.z = pk2(s[4 * 33], s[5 * 33]); o.w = pk2(s[6 * 33], s[7 * 33]);
        if (n0 + n < N) *(v4u*)(WT + (size_t)dst_row(kind, n0 + n) * K + k0 + 8 * c) = o; }
    asm volatile("s_waitcnt lgkmcnt(0)" ::: "memory");
}
__device__ __forceinline__ void convert_matrix(const float* W, int K, int N, unsigned short* WT, int kind, LAS float* scr, int gw, int ngw, int lane) {
    const int nitems = (K / 64) * ((N + 31) / 32);
    for (int it = gw; it < nitems; it += ngw) transpose_item(W, K, N, WT, kind, scr, it, lane);
}
__device__ __forceinline__ void ln_row(float* zrow, unsigned short* brow, const float* gam, const float* bet, int lane) {
    f32x4* xr = (f32x4*)zrow + lane; f32x4 v[8]; float s = 0.f;
#pragma unroll
    for (int j = 0; j < 8; ++j) { v[j] = xr[64 * j]; s += (v[j].x + v[j].y) + (v[j].z + v[j].w); }
    const float mean = wave_sum(s) * (1.f / DM); float s2 = 0.f;
#pragma unroll
    for (int j = 0; j < 8; ++j) { v[j] = v[j] - mean; s2 += (v[j].x * v[j].x + v[j].y * v[j].y) + (v[j].z * v[j].z + v[j].w * v[j].w); }
    const float rstd = 1.f / sqrtf(wave_sum(s2) * (1.f / DM) + LN_EPS);
    unsigned long long* o8 = (unsigned long long*)brow + lane;
#pragma unroll
    for (int j = 0; j < 8; ++j) { const f32x4 gm = ((const f32x4*)gam)[lane + 64 * j], bt = ((const f32x4*)bet)[lane + 64 * j]; const f32x4 y = v[j] * rstd * gm + bt;
        xr[64 * j] = y; o8[64 * j] = (unsigned long long)pk2(y.x, y.y) | ((unsigned long long)pk2(y.z, y.w) << 32); }
}
__device__ __forceinline__ void cvt_row(const float* xrow, unsigned short* brow, int lane) {
    const f32x4* xr = (const f32x4*)xrow + lane; unsigned long long* o8 = (unsigned long long*)brow + lane;
#pragma unroll
    for (int j = 0; j < 8; ++j) { const f32x4 y = xr[64 * j]; o8[64 * j] = (unsigned long long)pk2(y.x, y.y) | ((unsigned long long)pk2(y.z, y.w) << 32); }
}
__device__ __forceinline__ void rope_entry(float ang, float& c, float& s) {
    const double a = (double)ang; const double q = rint(a * 0.63661977236758134308); const double y = fma(-q, 1.57079632679489655800, a) - q * 6.12323399573676603587e-17;
    const double y2 = y * y;
    const double sn = y * (1.0 + y2 * (-1.0 / 6 + y2 * (1.0 / 120 + y2 * (-1.0 / 5040 + y2 * (1.0 / 362880 + y2 * (-1.0 / 39916800))))));
    const double cs = 1.0 + y2 * (-0.5 + y2 * (1.0 / 24 + y2 * (-1.0 / 720 + y2 * (1.0 / 40320 + y2 * (-1.0 / 3628800 + y2 * (1.0 / 479001600))))));
    const int qi = ((int)q) & 3;
    const double cc = (qi == 0) ? cs : (qi == 1) ? -sn : (qi == 2) ? -cs : sn;
    const double ss = (qi == 0) ? sn : (qi == 1) ? cs : (qi == 2) ? -sn : -cs;
    c = (float)cc; s = (float)ss;
}

template <class Tp> __device__ __forceinline__ Tp* as_global(Tp* p) { return (Tp*)(GAS Tp*)p; }
#define CAS __attribute__((address_space(4)))
typedef const CAS Params* ParamsPtr;
__device__ __forceinline__ ParamsPtr params_ptr(ParamsPtr kp) { asm volatile("" : "+s"(kp)); return kp; }
__device__ __forceinline__ int opaque_bx() { int v = blockIdx.x; asm volatile("" : "+s"(v)); return v; }
__device__ __forceinline__ int opaque_g() { int v = gridDim.x; asm volatile("" : "+s"(v)); return v; }
#ifndef ONLY_PHASE
#define ONLY_PHASE -1
#endif
#define PHASE_ENABLED(k) (ONLY_PHASE < 0 || ONLY_PHASE == (k))

__device__ __forceinline__ void convert_layer(ParamsPtr pp, int L, LAS unsigned char* lds, int gw, int ngw, int lane, int wave) {
    unsigned char* ws = as_global(pp->ws); const int i_ = L >> 1; LAS float* scr = (LAS float*)(lds + wave * 16384);
    unsigned short* Win_t = (unsigned short*)(ws + WS_W + W_WIN); unsigned short* Wo_t = (unsigned short*)(ws + WS_W + W_WO);
    unsigned short* W1_t = (unsigned short*)(ws + WS_W + W_W1); unsigned short* W2_t = (unsigned short*)(ws + WS_W + W_W2);
    if ((L & 1) == 0) { unsigned short* cw = (unsigned short*)(ws + WS_CW);
        convert_matrix(as_global(pp->e_w_in) + (size_t)i_ * DM * EVEN_IN, DM, EVEN_IN, Win_t, 2, scr, gw, ngw, lane);
        convert_matrix(as_global(pp->e_w_o) + (size_t)i_ * DM * DM, DM, DM, Wo_t, 0, scr, gw, ngw, lane);
        convert_matrix(as_global(pp->ck_w1) + (size_t)i_ * 4096 * 128, 4096, 128, cw, 0, scr, gw, ngw, lane); convert_matrix(as_global(pp->cv_w1) + (size_t)i_ * 4096 * 128, 4096, 128, cw + 128 * 4096, 0, scr, gw, ngw, lane);
        convert_matrix(as_global(pp->ck_w2) + (size_t)i_ * 128 * 128, 128, 128, cw + 2 * 128 * 4096, 0, scr, gw, ngw, lane); convert_matrix(as_global(pp->cv_w2) + (size_t)i_ * 128 * 128, 128, 128, cw + 2 * 128 * 4096 + 128 * 128, 0, scr, gw, ngw, lane);
    } else {
        convert_matrix(as_global(pp->o_w_in) + (size_t)i_ * DM * ODD_IN, DM, ODD_IN, Win_t, 1, scr, gw, ngw, lane);
        convert_matrix(as_global(pp->o_w_o) + (size_t)i_ * DM * DM, DM, DM, Wo_t, 0, scr, gw, ngw, lane); }
    convert_matrix(as_global(pp->w1) + (size_t)L * DM * DFF, DM, DFF, W1_t, 0, scr, gw, ngw, lane);
    convert_matrix(as_global(pp->w2) + (size_t)L * DFF * DM, DFF, DM, W2_t, 0, scr, gw, ngw, lane);
}
__device__ __forceinline__ void phase_prologue(ParamsPtr pp, LAS unsigned char* lds) {
    int tid_ = threadIdx.x; asm volatile("" : "+v"(tid_));
    const int tid = tid_, lane = tid & 63, wave = __builtin_amdgcn_readfirstlane(tid >> 6), G = opaque_g(), bx = opaque_bx(), gw = bx * NWAVES + wave, ngw = G * NWAVES;
    unsigned char* ws = as_global(pp->ws); float* ropec = (float*)(ws + WS_ROPEC); float* ropes = (float*)(ws + WS_ROPES); const int* pos = as_global(pp->pos); const float* x = as_global(pp->x); unsigned short* XB = (unsigned short*)(ws + WS_XB);
    for (size_t e = (size_t)bx * 512 + tid; e < (size_t)M * 64; e += (size_t)G * 512) { const int row = (int)(e >> 6), i = (int)(e & 63);
        const float ang = (float)pos[row] * pp->inv_freq[i]; float c, s; rope_entry(ang, c, s); ropec[e] = c; ropes[e] = s; }
    for (int m = gw; m < M; m += ngw) cvt_row(x + (size_t)m * DM, XB + (size_t)m * DM, lane);
    convert_layer(pp, 0, lds, gw, ngw, lane, wave);
}
__device__ __forceinline__ void phase_e1(ParamsPtr pp, LAS unsigned char* lds) {
    unsigned char* ws = as_global(pp->ws);
    pg8::Gemm g{(const unsigned short*)(ws + WS_XB), (const unsigned short*)(ws + WS_W + W_WIN), M, EVEN_NPAD, DM}; pg8::StaticOrder S; S.init(M, EVEN_NPAD, opaque_g(), opaque_bx());
    pg8::EpiEven E{ws};
    pg8::gemm_phase<pg8::EpiEven, pg8::StaticOrder, true, true>(lds, g, S, E);
}
__device__ __forceinline__ void phase_e2(ParamsPtr pp, int li, LAS unsigned char* lds) {
    unsigned char* const ws0 = as_global(pp->ws); const int G = opaque_g(), bx = opaque_bx();
    for (int ct = bx; ct < 256; ct += G) { const int z = ct >> 7;
        GAS unsigned char* wsg = (GAS unsigned char*)ws0; asm volatile("" : "+s"(wsg)); unsigned char* ws = (unsigned char*)wsg; unsigned char* R = ws + WS_R; unsigned short* cw = (unsigned short*)(ws + WS_CW);
        fa::compress_task((FA_LAS char*)lds, (const unsigned short*)(R + (z ? R_VA : R_KA)), (z ? as_global(pp->pe_v) : as_global(pp->pe_k)) + (size_t)li * 4096, cw + (z ? 128 * 4096 : 0), cw + 2 * 128 * 4096 + (z ? 128 * 128 : 0),
                          (unsigned short*)(ws + (z ? WS_VC : WS_KC)), ct & 127); }
    for (int u = bx; u < 2048; u += G) { const int kind = u >> 10, r = u & 1023, bh = r >> 6, blk = r & 63, b = bh >> 3, h = bh & 7; fa::BandArgs a;
        GAS unsigned char* wsg = (GAS unsigned char*)ws0; asm volatile("" : "+s"(wsg)); unsigned char* ws = (unsigned char*)wsg; unsigned char* R = ws + WS_R;
        if (kind == 0) {
            a.Q = (const unsigned short*)(R + R_QA) + (size_t)(b * 8 + h) * T * 128; a.K = (const unsigned short*)(R + R_KA) + (size_t)(b * 6 + 4 + (h >> 2)) * T * 128; a.V = (const unsigned short*)(R + R_VA) + (size_t)(b * 6 + 4 + (h >> 2)) * T * 128;
            a.O = (unsigned short*)(ws + WS_OWIN) + (size_t)b * T * 1024 + h * 128; a.o_stride = 1024; a.lse = nullptr; a.lse_stride = 0; a.P0 = blk * 256; a.W = 512; a.mode = 0; a.sink = 0.f;
        } else {
            a.Q = (const unsigned short*)(R + R_QB) + (size_t)(b * 8 + h) * T * 128; a.K = (const unsigned short*)(R + R_KB) + (size_t)(b * 2 + (h >> 2)) * T * 128; a.V = (const unsigned short*)(R + R_VB) + (size_t)(b * 2 + (h >> 2)) * T * 128;
            a.O = (unsigned short*)(ws + WS_O) + (size_t)b * T * 2048 + (8 + h) * 128; a.o_stride = 2048; a.lse = nullptr; a.lse_stride = 0; a.P0 = blk * 256; a.W = 128; a.mode = 1; a.sink = as_global(pp->sinks)[li * 8 + h];
        }
        fa::banded_unit((FA_LAS char*)lds, a); }
}
__device__ __forceinline__ void phase_e3(ParamsPtr pp, LAS unsigned char* lds) {
    unsigned char* const ws0 = as_global(pp->ws); const int G = opaque_g(), bx = opaque_bx();
    for (int i = bx; i < 1024; i += G) { const int r = i >> 8, k = i & 255, bg = k & 3, idx = k >> 2;
        const int tile = (r == 0) ? idx : (r == 1) ? 255 - idx : (r == 2) ? 64 + idx : 191 - idx;
        GAS unsigned char* wsg = (GAS unsigned char*)ws0; asm volatile("" : "+s"(wsg)); unsigned char* ws = (unsigned char*)wsg; unsigned char* R = ws + WS_R;
        fa::NsaArgs a{(const unsigned short*)(R + R_QA), (const unsigned short*)(R + R_KA), (const unsigned short*)(R + R_VA), (const unsigned short*)(ws + WS_KC), (const unsigned short*)(ws + WS_VC),
                      (const float*)(ws + WS_GATES), (const unsigned short*)(ws + WS_OWIN), (unsigned short*)(ws + WS_O), bg >> 1, bg & 1, tile * 64};
        fa::nsa_unit((FA_LAS char*)lds, a); }
}
__device__ __forceinline__ void phase_o1(ParamsPtr pp, int grp, LAS unsigned char* lds) {
    unsigned char* ws = as_global(pp->ws);
    pg8::Gemm g{(const unsigned short*)(ws + WS_XB), (const unsigned short*)(ws + WS_W + W_WIN) + (size_t)grp * ODD_G * DM, M, ODD_G, DM}; pg8::StaticOrder S; S.init(M, ODD_G, opaque_g(), opaque_bx());
    pg8::EpiOdd E{ws, 2 * grp};
    pg8::gemm_phase<pg8::EpiOdd, pg8::StaticOrder, true, true>(lds, g, S, E);
}
__device__ __forceinline__ void phase_o2(ParamsPtr pp, int grp, LAS unsigned char* lds) {
    unsigned char* const ws0 = as_global(pp->ws); const int G = opaque_g(), bx = opaque_bx();
    const int dsh = 2 * grp, dil = 1 << dsh, Lq = T >> dsh, nblk = Lq >> 8;
    for (int u = bx; u < 2048; u += G) { const int seq = u / nblk, blk = u - seq * nblk, bh = seq >> dsh, c = seq & (dil - 1), b = bh >> 4, h = bh & 15; fa::BandArgs a;
        const size_t so = ((size_t)bh * T + (size_t)c * Lq) * 128;
        GAS unsigned char* wsg = (GAS unsigned char*)ws0; asm volatile("" : "+s"(wsg)); unsigned char* ws = (unsigned char*)wsg; unsigned char* R = ws + WS_R;
        a.Q = (const unsigned short*)(R + R_QG) + so; a.K = (const unsigned short*)(R + R_KG) + so; a.V = (const unsigned short*)(R + R_VG) + so;
        a.O = (unsigned short*)(ws + WS_O) + ((size_t)b * T + c) * 2048 + h * 128; a.o_stride = (size_t)dil * 2048; a.lse = (float*)(ws + WS_LSE) + ((size_t)b * T + c) * 16 + h; a.lse_stride = (size_t)dil * 16;
        a.P0 = blk * 256; a.W = 129; a.mode = grp == 0 ? 2 : 3; a.sink = 0.f;
        fa::banded_unit((FA_LAS char*)lds, a); }
}
__device__ __forceinline__ void phase_resid_gemm(ParamsPtr pp, int which  , int layer, LAS unsigned char* lds) {
    unsigned char* ws = as_global(pp->ws); float* out = as_global(pp->out);
    pg8::Gemm g{(const unsigned short*)(ws + (which ? WS_R : WS_O)), (const unsigned short*)(ws + WS_W + (which ? W_W2 : W_WO)), M, DM, which ? DFF : DM}; pg8::StaticOrder S; S.init(M, DM, opaque_g(), opaque_bx());
    pg8::EpiResid E{(which == 0 && layer == 0) ? as_global(pp->x) : out, out, DM, DN_ALPHA};
    pg8::gemm_phase<pg8::EpiResid, pg8::StaticOrder, true, true>(lds, g, S, E);
}
__device__ __forceinline__ void phase_ln(ParamsPtr pp, int which, int layer) {
    int tid_ = threadIdx.x; asm volatile("" : "+v"(tid_));
    const int tid = tid_, lane = tid & 63, wave = __builtin_amdgcn_readfirstlane(tid >> 6), gw = opaque_bx() * NWAVES + wave, ngw = opaque_g() * NWAVES;
    float* out = as_global(pp->out); unsigned short* XB = (unsigned short*)(as_global(pp->ws) + WS_XB); const float* gam = (which ? as_global(pp->ln2_g) : as_global(pp->ln1_g)) + layer * DM; const float* bet = (which ? as_global(pp->ln2_b) : as_global(pp->ln1_b)) + layer * DM;
    for (int m = gw; m < M; m += ngw) ln_row(out + (size_t)m * DM, XB + (size_t)m * DM, gam, bet, lane);
}
__device__ __forceinline__ void phase_up(ParamsPtr pp, LAS unsigned char* lds) {
    unsigned char* ws = as_global(pp->ws);
    pg8::Gemm g{(const unsigned short*)(ws + WS_XB), (const unsigned short*)(ws + WS_W + W_W1), M, DFF, DM}; pg8::StaticOrder S; S.init(M, DFF, opaque_g(), opaque_bx());
    pg8::EpiRelu2 E{(unsigned short*)(ws + WS_R), DFF};
    pg8::gemm_phase<pg8::EpiRelu2, pg8::StaticOrder, true, true>(lds, g, S, E);
}

__global__ void __launch_bounds__(NWAVES * 64, 2) fwd_kernel(Params P) {
    extern __shared__ __attribute__((aligned(16))) unsigned char lds_raw[];
    LAS unsigned char* lds = (LAS unsigned char*)lds_raw;
    volatile LAS unsigned* MISC = (volatile LAS unsigned*)(lds + MISC_OFF);
    ParamsPtr kp = (ParamsPtr)__builtin_amdgcn_kernarg_segment_ptr();
    if (threadIdx.x < 64) MISC[threadIdx.x] = 0u;
    __syncthreads();
    XcdBarrier bar = xcd_barrier_post((unsigned*)(as_global(P.ws) + WS_CTL) + CW_BAR, MISC + 8);
    const int lo = P.ph_lo, hi = P.ph_hi; int pc = 0;
#define PH_ON (pc >= lo && pc < hi)
#define SEAM() do { if (pc >= lo && pc + 1 < hi) { XcdBarrier b_ = bar; GAS unsigned* bg_ = (GAS unsigned*)b_.bar; asm volatile("" : "+s"(bg_)); b_.bar = (unsigned*)bg_; xcd_barrier(b_); } ++pc; } while (0)
    if (PH_ON && PHASE_ENABLED(0)) phase_prologue(params_ptr(kp), lds);
    SEAM();
    for (int layer = 0; layer < DEPTH; ++layer) {
        if ((layer & 1) == 0) {
            if (PH_ON && PHASE_ENABLED(1)) phase_e1(params_ptr(kp), lds);
            SEAM();
            if (PH_ON && PHASE_ENABLED(2)) phase_e2(params_ptr(kp), layer >> 1, lds);
            SEAM();
            if (PH_ON && PHASE_ENABLED(3)) phase_e3(params_ptr(kp), lds);
            SEAM();
        } else {
            for (int grp = 0; grp < 3; ++grp) {
                if (PH_ON && PHASE_ENABLED(4)) phase_o1(params_ptr(kp), grp, lds);
                SEAM();
                if (PH_ON && PHASE_ENABLED(5)) phase_o2(params_ptr(kp), grp, lds);
                SEAM();
            }
        }
        if (PH_ON && PHASE_ENABLED(6)) phase_resid_gemm(params_ptr(kp), 0, layer, lds);
        SEAM();
        if (PH_ON && PHASE_ENABLED(7)) phase_ln(params_ptr(kp), 0, layer);
        SEAM();
        if (PH_ON && PHASE_ENABLED(8)) phase_up(params_ptr(kp), lds);
        SEAM();
        if (PH_ON && PHASE_ENABLED(9)) phase_resid_gemm(params_ptr(kp), 1, layer, lds);
        SEAM();
        if (PH_ON && PHASE_ENABLED(10)) {
            phase_ln(params_ptr(kp), 1, layer);
            if (layer + 1 < DEPTH) { int tid = threadIdx.x; asm volatile("" : "+v"(tid)); const int wave = __builtin_amdgcn_readfirstlane(tid >> 6); convert_layer(params_ptr(kp), layer + 1, lds, opaque_bx() * NWAVES + wave, opaque_g() * NWAVES, tid & 63, wave); }
        }
        SEAM();
    }
#undef PH_ON
#undef SEAM
}
constexpr int N_PHASES = 1 + 2 * (3 + 5) + 2 * (6 + 5);

extern "C" void kernel_launch(void* const* d_in, const int* in_sizes, int n_in, void* d_out, int out_size, void* d_ws, size_t ws_size, hipStream_t stream) {
    static int grid = 0;
    if (grid == 0) {
        if (n_in != 19 || in_sizes[0] != M * DM || out_size != M * DM || ws_size < WS_END) { fprintf(stderr, "kernel_launch: unexpected problem (n_in %d, in0 %d, out %d, ws %zu < %zu); nothing launched\n", n_in, n_in > 0 ? in_sizes[0] : -1, out_size, ws_size, (size_t)WS_END); grid = -1; return; }
        int dev = 0, cus = 0, per_cu = 0;
        if (hipGetDevice(&dev) != hipSuccess || hipDeviceGetAttribute(&cus, hipDeviceAttributeMultiprocessorCount, dev) != hipSuccess) { grid = -1; return; }
        if (hipFuncSetAttribute((const void*)fwd_kernel, hipFuncAttributeMaxDynamicSharedMemorySize, LDS_BYTES) != hipSuccess) { fprintf(stderr, "kernel_launch: hipFuncSetAttribute failed\n"); grid = -1; return; }
        if (hipOccupancyMaxActiveBlocksPerMultiprocessor(&per_cu, (const void*)fwd_kernel, NWAVES * 64, LDS_BYTES) != hipSuccess || per_cu < 1) { fprintf(stderr, "kernel_launch: occupancy query reports %d workgroups per CU\n", per_cu); }
        (void)hipGetLastError();
        grid = cus;
    }
    if (grid < 0) return;
    if (hipMemsetAsync((char*)d_ws + WS_CTL, 0, CTL_ZERO_BYTES, stream) != hipSuccess) return;
    Params p{};
    p.x = (const float*)d_in[0]; p.pos = (const int*)d_in[1]; p.e_w_in = (const float*)d_in[2]; p.e_w_o = (const float*)d_in[3]; p.pe_k = (const float*)d_in[4]; p.pe_v = (const float*)d_in[5];
    p.ck_w1 = (const float*)d_in[6]; p.ck_w2 = (const float*)d_in[7]; p.cv_w1 = (const float*)d_in[8]; p.cv_w2 = (const float*)d_in[9]; p.sinks = (const float*)d_in[10];
    p.o_w_in = (const float*)d_in[11]; p.o_w_o = (const float*)d_in[12]; p.ln1_g = (const float*)d_in[13]; p.ln1_b = (const float*)d_in[14]; p.w1 = (const float*)d_in[15]; p.w2 = (const float*)d_in[16];
    p.ln2_g = (const float*)d_in[17]; p.ln2_b = (const float*)d_in[18]; p.out = (float*)d_out; p.ws = (unsigned char*)d_ws;
    for (int i = 0; i < 64; ++i) p.inv_freq[i] = (float)pow(10000.0, -(double)(2 * i) / 128.0);
#if MK_PER_PHASE
    for (int ph = 0; ph < N_PHASES; ++ph) { p.ph_lo = ph; p.ph_hi = ph + 1; hipLaunchKernelGGL(fwd_kernel, dim3(grid), dim3(NWAVES * 64), LDS_BYTES, stream, p); }
#else
    p.ph_lo = 0; p.ph_hi = N_PHASES;
    hipLaunchKernelGGL(fwd_kernel, dim3(grid), dim3(NWAVES * 64), LDS_BYTES, stream, p);
#endif
    const hipError_t le = hipPeekAtLastError();
    if (le != hipSuccess) fprintf(stderr, "kernel_launch: launch failed: %s\n", hipGetErrorName(le));
}
```

```cpp
#include <hip/hip_runtime.h>
#include <cstdio>
#include <cstdint>
#include <cmath>

constexpr int BATCH = 2, T = 16384, DM = 2048, DEPTH = 4, HD = 128, DFF = 8192;
constexpr int M = BATCH * T;
constexpr int EVEN_IN = 4120, EVEN_NPAD = 4352, ODD_IN = 18432, ODD_G = 6144;
constexpr float LN_EPS = 1e-5f;
constexpr float DN_ALPHA = 1.6817928305074290f;

constexpr size_t MiB = 1u << 20;
constexpr size_t WS_CTL = 0, CTL_ZERO_BYTES = 1 * MiB;
constexpr size_t WS_ROPEC = 1 * MiB, WS_ROPES = 9 * MiB;
constexpr size_t WS_GATES = 17 * MiB;
constexpr size_t WS_KC = 20 * MiB, WS_VC = 21 * MiB;
constexpr size_t WS_LSE = 22 * MiB;
constexpr size_t WS_STATS = 30 * MiB;
constexpr size_t WS_CW = 24 * MiB;
constexpr size_t WS_W = 32 * MiB;
constexpr size_t W_WIN = 0, W_WO = (size_t)ODD_IN * DM * 2, W_W1 = W_WO + (size_t)DM * DM * 2, W_W2 = W_W1 + (size_t)DFF * DM * 2, W_END = W_W2 + (size_t)DM * DFF * 2;
constexpr size_t WS_XB = 248 * MiB;
constexpr size_t WS_R = 376 * MiB;
constexpr size_t WS_O = 760 * MiB;
constexpr size_t WS_OWIN = 888 * MiB;
constexpr size_t WS_XB8 = 952 * MiB;
constexpr size_t WS_END = 1016 * MiB;
static_assert(WS_W + W_END <= WS_XB && WS_R + 384 * MiB == WS_O && WS_O + 128 * MiB == WS_OWIN, "d_ws map");
constexpr size_t R_QA = 0, R_KA = 64 * MiB, R_VA = 112 * MiB, R_QB = 160 * MiB, R_KB = 224 * MiB, R_VB = 240 * MiB;
constexpr size_t R_QG = 0, R_KG = 128 * MiB, R_VG = 256 * MiB;


template <int K> __device__ __forceinline__ unsigned xl_u(unsigned v) { return (unsigned)__builtin_amdgcn_ds_swizzle((int)v, (K << 10) | 0x1f); }
template <int K> __device__ __forceinline__ float xl_f(float v) { return __uint_as_float(xl_u<K>(__float_as_uint(v))); }
__device__ __forceinline__ unsigned x32_u(unsigned v, int hi) { auto rr = __builtin_amdgcn_permlane32_swap(v, v, false, false); return hi ? rr[0] : rr[1]; }
__device__ __forceinline__ float x32_sum(float v) { auto rr = __builtin_amdgcn_permlane32_swap(__float_as_uint(v), __float_as_uint(v), false, false); return __uint_as_float(rr[0]) + __uint_as_float(rr[1]); }
__device__ __forceinline__ unsigned x32_or(unsigned v) { auto rr = __builtin_amdgcn_permlane32_swap(v, v, false, false); return rr[0] | rr[1]; }
namespace pg8 {
#define PG8_LAS __attribute__((address_space(3)))
typedef unsigned short bf16_t;
typedef short bf16x8 __attribute__((ext_vector_type(8)));
typedef float f32x4 __attribute__((ext_vector_type(4)));
typedef unsigned u32x4 __attribute__((ext_vector_type(4)));
constexpr int BM = 256, BK = 64, HALF = 128, HTB = HALF * BK * 2  , STAGE_BYTES = 8 * HTB, NXCD = 8, WGM = 8;

__host__ __device__ __forceinline__ int lds_byte(int r, int c) { const int st = (r >> 4) * 2 + (c >> 5), rr = r & 15, cc = c & 31, ob = rr * 64 + cc * 2; return st * 1024 + (ob ^ (((ob >> 9) & 1) << 5)); }
__host__ __device__ __forceinline__ void stage_rc(int b, int& R, int& C) { const int st = b / 1024, sb = b % 1024, swz = sb ^ (((sb >> 9) & 1) << 5); R = (st >> 1) * 16 + swz / 64; C = (st & 1) * 32 + (swz % 64) / 2; }
__host__ __device__ __forceinline__ int perm32(int rho) { const int n = rho >> 4, i = rho & 15; return 8 * (i >> 2) + 4 * n + (i & 3); }

struct Unit { int pm, pn; };
struct Gemm { const bf16_t* A; const bf16_t* Bt; int M, N, K; };

struct StaticOrder {
    int nM, nN, nwg, G, c, wgm;
    __host__ __device__ void init(int M, int N, int G_, int c_, int wgm_ = WGM) { nM = M / BM; nN = N / BM; nwg = nM * nN; G = G_; c = c_; wgm = wgm_; }
    __host__ __device__ bool next(int i, Unit& u) const {
        const long L = (long)i * G + c; if (L >= nwg) return false;
        int wgid = (int)L; { const int q = nwg / NXCD, r = nwg % NXCD, xcd = wgid % NXCD, off = wgid / NXCD; wgid = (xcd < r ? xcd * (q + 1) : r * (q + 1) + (xcd - r) * q) + off; }
        const int nig = wgm * nN, gid = wgid / nig, fm = gid * wgm, gsz = (nM - fm) < wgm ? (nM - fm) : wgm;
        u.pm = fm + ((wgid % nig) % gsz); u.pn = (wgid % nig) / gsz; return true;
    }
    __device__ __forceinline__ void a_ready(const Unit&) const {}
    __device__ __forceinline__ void done(const Unit&) const {}
};

__device__ __forceinline__ unsigned cvt_pk_bf16(float lo, float hi) { unsigned r; asm volatile("v_cvt_pk_bf16_f32 %0, %1, %2" : "=v"(r) : "v"(lo), "v"(hi)); return r; }
typedef float f32x2 __attribute__((ext_vector_type(2)));

typedef unsigned u32x2 __attribute__((ext_vector_type(2)));
template <class V> __device__ __forceinline__ V ldg_(const void* sbase, unsigned boff) { return *(const V*)((const char*)sbase + boff); }
template <class V> __device__ __forceinline__ void stg_(void* sbase, unsigned boff, V v) { *(V*)((char*)sbase + boff) = v; }
__device__ __forceinline__ void rope_load(const void* sbase, unsigned boff, float dq, f32x4& cs, f32x4& sn) {
    const u32x4 w = ldg_<u32x4>(sbase, boff);
#pragma unroll
    for (int i = 0; i < 4; ++i) { cs[i] = (float)__builtin_bit_cast(_Float16, (unsigned short)(w[i] & 0xffffu)) * dq; sn[i] = (float)__builtin_bit_cast(_Float16, (unsigned short)(w[i] >> 16)) * dq; }
}
__device__ __forceinline__ void rope_store(const f32x4 a0, const f32x4 a1, const f32x4 cs, const f32x4 sn, void* sbase, unsigned boff) {
    const f32x4 o0 = a0 * cs - a1 * sn, o1 = a1 * cs + a0 * sn;
    u32x2 w0, w1; w0.x = cvt_pk_bf16(o0[0], o0[1]); w0.y = cvt_pk_bf16(o0[2], o0[3]); w1.x = cvt_pk_bf16(o1[0], o1[1]); w1.y = cvt_pk_bf16(o1[2], o1[3]);
    stg_<u32x2>(sbase, boff, w0); stg_<u32x2>(sbase, boff + 128, w1);
}
struct EpiNull { static constexpr bool PERM = false, AFTER_DRAIN = false;
    __device__ __forceinline__ void operator()(const f32x4 (&acc)[2][2][4][2], const Unit& u, int wr, int wc, int fr, int fq) const {
#pragma unroll
        for (int ai = 0; ai < 2; ++ai)
#pragma unroll
            for (int bj = 0; bj < 2; ++bj) asm volatile("" :: "v"(acc[ai][bj][0][0]), "v"(acc[ai][bj][0][1]), "v"(acc[ai][bj][1][0]), "v"(acc[ai][bj][1][1]), "v"(acc[ai][bj][2][0]), "v"(acc[ai][bj][2][1]), "v"(acc[ai][bj][3][0]), "v"(acc[ai][bj][3][1])); } };
__device__ __forceinline__ void rope_store16(const f32x4 a0, const f32x4 a1, const f32x4 cs, const f32x4 sn, void* sbase, unsigned boff) {
    const f32x4 o0 = a0 * cs - a1 * sn, o1 = a1 * cs + a0 * sn;
    u32x4 w; w.x = cvt_pk_bf16(o0[0], o0[1]); w.y = cvt_pk_bf16(o0[2], o0[3]); w.z = cvt_pk_bf16(o1[0], o1[1]); w.w = cvt_pk_bf16(o1[2], o1[3]);
    stg_<u32x4>(sbase, boff, w);
}
struct EpiEven {
    static constexpr bool PERM = false, AFTER_DRAIN = false;
    unsigned char* ws; float dq;
    __device__ __forceinline__ void operator()(const f32x4 (&acc)[2][2][4][2], const Unit& u, int wr, int wc, int fr, int fq) const {
        int tl_ = threadIdx.x; asm volatile("" : "+v"(tl_));
        wr = (tl_ >> 8) & 1; wc = (tl_ >> 6) & 3; fr = tl_ & 15; fq = (tl_ >> 4) & 3;
        const unsigned rl = (unsigned)(wr * 64 + fr);
        const int b = u.pm >> 6, tb = (u.pm & 63) * 256;
        unsigned char* dst[2]; bool rope = true;
#pragma unroll
        for (int bj = 0; bj < 2; ++bj) { const int cb = 2 * u.pn + bj; size_t base; int nH, hh;
            if (cb < 8) { base = R_QA; nH = 8; hh = cb; } else if (cb < 14) { base = R_KA; nH = 6; hh = cb - 8; } else if (cb < 20) { base = R_VA; nH = 6; hh = cb - 14; rope = false; }
            else if (cb < 28) { base = R_QB; nH = 8; hh = cb - 20; } else if (cb < 30) { base = R_KB; nH = 2; hh = cb - 28; } else { base = R_VB; nH = 2; hh = cb - 30; rope = false; }
            dst[bj] = ws + WS_R + base + ((size_t)(b * nH + hh) * T + tb) * 256; }
        const unsigned so = (rl * 128 + 16 * wc + 4 * fq) * 2, ro_ = (rl * 64 + 16 * wc + 4 * fq) * 4;
        const unsigned char* rc = ws + WS_ROPEC + (size_t)u.pm * 256 * 256;
#pragma unroll
        for (int ai = 0; ai < 2; ++ai) {
            f32x4 cs[4], sn[4];
#pragma unroll
            for (int m = 0; m < 4; ++m) { const int ro = ai * 128 + m * 16; cs[m] = (f32x4){dq, dq, dq, dq}; sn[m] = (f32x4){0.f, 0.f, 0.f, 0.f};
                if (rope) rope_load(rc, ro_ + ro * 256, dq, cs[m], sn[m]); }
#pragma unroll
            for (int m = 0; m < 4; ++m) { const int ro = ai * 128 + m * 16;
#pragma unroll
                for (int bj = 0; bj < 2; ++bj) rope_store(acc[ai][bj][m][0], acc[ai][bj][m][1], cs[m], sn[m], dst[bj], so + ro * 256); }
            asm volatile("" ::: "memory"); }
    }
};
struct EpiOdd {
    static constexpr bool PERM = false, AFTER_DRAIN = false;
    unsigned char* ws; int dsh;    float dq;    int norope;
    __device__ __forceinline__ void operator()(const f32x4 (&acc)[2][2][4][2], const Unit& u, int wr, int wc, int fr, int fq) const {
        int tl_ = threadIdx.x; asm volatile("" : "+v"(tl_));
        wr = (tl_ >> 8) & 1; wc = (tl_ >> 6) & 3; fr = tl_ & 15; fq = (tl_ >> 4) & 3;
        const unsigned rl = (unsigned)(wr * 64 + fr);
        const int b = u.pm >> 6, tb = (u.pm & 63) * 256;
        const bool rope = u.pn < 16 && norope != 1; const int lsh = 14 - dsh, dmask = (1 << dsh) - 1;
        unsigned char* dst[2];
#pragma unroll
        for (int bj = 0; bj < 2; ++bj) { const int cb = 2 * u.pn + bj, which = cb >> 4, h = cb & 15;
            dst[bj] = ws + WS_R + (which == 0 ? R_QG : (which == 1 ? R_KG : R_VG)) + (size_t)(b * 16 + h) * T * 256; }
        const unsigned co = (16 * wc + 4 * fq) * 2, ro_ = (rl * 64 + 16 * wc + 4 * fq) * 4;
        const unsigned char* rc = ws + WS_ROPEC + (size_t)u.pm * 256 * 256;
#pragma unroll
        for (int ai = 0; ai < 2; ++ai) {
            f32x4 cs[4], sn[4];
#pragma unroll
            for (int m = 0; m < 4; ++m) { const int ro = ai * 128 + m * 16; cs[m] = (f32x4){dq, dq, dq, dq}; sn[m] = (f32x4){0.f, 0.f, 0.f, 0.f};
                if (rope) rope_load(rc, ro_ + ro * 256, dq, cs[m], sn[m]); }
#pragma unroll
            for (int m = 0; m < 4; ++m) { const int ro = ai * 128 + m * 16; const unsigned t = (unsigned)tb + rl + ro, row = ((t & dmask) << lsh) + (t >> dsh);
#pragma unroll
                for (int bj = 0; bj < 2; ++bj) { if (norope == 2) rope_store16(acc[ai][bj][m][0], acc[ai][bj][m][1], cs[m], sn[m], dst[bj], row * 256 + 2 * co); else rope_store(acc[ai][bj][m][0], acc[ai][bj][m][1], cs[m], sn[m], dst[bj], row * 256 + co); } }
            asm volatile("" ::: "memory"); }
    }
};
struct EpiResid {
    static constexpr bool PERM = false, AFTER_DRAIN = false;
    const float* base; float* out; int ldc; float alpha; const float* stats; const float* gam; const float* bet;
    __device__ __forceinline__ void operator()(const f32x4 (&acc)[2][2][4][2], const Unit& u, int wr, int wc, int fr, int fq) const {
        int tl_ = threadIdx.x; asm volatile("" : "+v"(tl_));
        wr = (tl_ >> 8) & 1; wc = (tl_ >> 6) & 3; fr = tl_ & 15; fq = (tl_ >> 4) & 3;
        const size_t tile = ((size_t)u.pm * BM * ldc + (size_t)u.pn * BM) * 4;
        const unsigned lo_ = ((unsigned)(wr * 64 + fr) * (unsigned)ldc + wc * 32 + 4 * fq) * 4;
        unsigned char* op = (unsigned char*)out + tile; const bool ln = gam != nullptr;
        const unsigned char* bp = ln ? op : (const unsigned char*)base + tile;
        const unsigned char* sp = (const unsigned char*)stats + (size_t)u.pm * BM * 8; const unsigned so_ = (unsigned)(wr * 64 + fr) * 8;
        const unsigned char* gp = (const unsigned char*)gam + (size_t)u.pn * BM * 4; const unsigned char* tp = (const unsigned char*)bet + (size_t)u.pn * BM * 4; const unsigned co_ = (wc * 32 + 4 * fq) * 4;
#pragma unroll
        for (int ai = 0; ai < 2; ++ai)
#pragma unroll
            for (int mp = 0; mp < 2; ++mp) {
                f32x4 bs[2][2][2]; typedef float f32x2_ __attribute__((ext_vector_type(2))); f32x2_ st[2] = {{0.f, 1.f}, {0.f, 1.f}};
#pragma unroll
                for (int mm = 0; mm < 2; ++mm) { const int rg = ai * HALF + (2 * mp + mm) * 16; const unsigned ro = lo_ + (unsigned)rg * (unsigned)ldc * 4;
                    if (ln) st[mm] = ldg_<f32x2_>(sp, so_ + rg * 8);
#pragma unroll
                    for (int bj = 0; bj < 2; ++bj)
#pragma unroll
                        for (int n = 0; n < 2; ++n) bs[mm][bj][n] = ldg_<f32x4>(bp, ro + (bj * HALF + n * 16) * 4); }
#pragma unroll
                for (int bj = 0; bj < 2; ++bj)
#pragma unroll
                    for (int n = 0; n < 2; ++n) { f32x4 g4 = {1.f, 1.f, 1.f, 1.f}, b4 = {0.f, 0.f, 0.f, 0.f};
                        if (ln) { g4 = ldg_<f32x4>(gp, co_ + (bj * HALF + n * 16) * 4); b4 = ldg_<f32x4>(tp, co_ + (bj * HALF + n * 16) * 4); }
#pragma unroll
                        for (int mm = 0; mm < 2; ++mm) { const unsigned ro = lo_ + (unsigned)(ai * HALF + (2 * mp + mm) * 16) * (unsigned)ldc * 4;
                            const f32x4 x = ln ? (bs[mm][bj][n] - st[mm].x) * st[mm].y * g4 + b4 : bs[mm][bj][n];
                            stg_<f32x4>(op, ro + (bj * HALF + n * 16) * 4, x * alpha + acc[ai][bj][2 * mp + mm][n]); } }
                asm volatile("" ::: "memory");
            }
    }
};
struct EpiRelu2 {
    static constexpr bool PERM = true, AFTER_DRAIN = false;
    bf16_t* O; int ldc;
    __device__ __forceinline__ void operator()(const f32x4 (&acc)[2][2][4][2], const Unit& u, int wr, int wc, int fr, int fq) const {
        int tl_ = threadIdx.x; asm volatile("" : "+v"(tl_));
        wr = (tl_ >> 8) & 1; wc = (tl_ >> 6) & 3; fr = tl_ & 15; fq = (tl_ >> 4) & 3;
        unsigned char* op = (unsigned char*)O + ((size_t)u.pm * BM * ldc + (size_t)u.pn * BM) * 2;
        const unsigned lo_ = ((unsigned)(wr * 64 + fr) * (unsigned)ldc + wc * 32 + 8 * fq) * 2;
#pragma unroll
        for (int ai = 0; ai < 2; ++ai)
#pragma unroll
            for (int m = 0; m < 4; ++m) { const unsigned ro = lo_ + (unsigned)(ai * HALF + m * 16) * (unsigned)ldc * 2;
#pragma unroll
                for (int bj = 0; bj < 2; ++bj) { f32x4 v0 = acc[ai][bj][m][0], v1 = acc[ai][bj][m][1];
#pragma unroll
                    for (int j = 0; j < 4; ++j) { const float a = fmaxf(v0[j], 0.f), c = fmaxf(v1[j], 0.f); v0[j] = a * a; v1[j] = c * c; }
                    u32x4 w; w.x = cvt_pk_bf16(v0[0], v0[1]); w.y = cvt_pk_bf16(v0[2], v0[3]); w.z = cvt_pk_bf16(v1[0], v1[1]); w.w = cvt_pk_bf16(v1[2], v1[3]);
                    stg_<u32x4>(op, ro + bj * HALF * 2, w); } }
    }
};

template <class Epi, class Sched, bool ALIGN_EPI = false, bool SP2 = false, bool FP8 = false>
__device__ __forceinline__ void gemm_phase(PG8_LAS unsigned char* lds, const Gemm g, const Sched& S, const Epi& E) {
    int tid_ = threadIdx.x; asm volatile("" : "+v"(tid_));
    const int tid = tid_, wid = __builtin_amdgcn_readfirstlane(tid >> 6), lane = tid & 63, wr = wid >> 2, wc = wid & 3, fr = lane & 15, fq = lane >> 4;
    const int K = g.K, nt = K / BK;
    unsigned voffA[2], voffB[2];
#pragma unroll
    for (int i = 0; i < 2; ++i) { int R, C; stage_rc(tid * 16 + i * 8192, R, C); const int Rb = Epi::PERM ? ((R & ~31) + perm32(R & 31)) : R;
        voffA[i] = (unsigned)(R * K + C) * 2u; voffB[i] = (unsigned)(Rb * K + C) * 2u; }
    const size_t rstep64 = (size_t)64 * K * 2;
    const size_t kstep = (size_t)(BK * 2);
    const size_t hstep = (size_t)HALF * K * 2;
    const size_t tstep = 2 * hstep;
    const unsigned ldsw = (unsigned)wid * 1024u;
    const int aoff = lds_byte(wr * 64 + fr, fq * 8), boff = lds_byte(wc * 32 + fr, fq * 8);
#define PG8_SA(b, h) (((b) * 2 + (h)) * HTB)
#define PG8_SB(b, h) ((4 + (b) * 2 + (h)) * HTB)
#define PG8_STAGE(bufoff, gbase, voff) do { _Pragma("unroll") for (int _i = 0; _i < 2; ++_i)   \
        __builtin_amdgcn_global_load_lds((const unsigned*)((const char*)(gbase) + (size_t)_i * rstep64 + (voff)[0]), (PG8_LAS unsigned*)(lds + (bufoff) + ldsw + _i * 8192), 16, 0, 0); } while (0)
#define PG8_LDA(dst, b, h) do { _Pragma("unroll") for (int m = 0; m < 4; ++m) _Pragma("unroll") for (int k = 0; k < 2; ++k) dst[m][k] = *(const PG8_LAS bf16x8*)(lds + PG8_SA(b, h) + aoff + m * 2048 + k * 1024); } while (0)
#define PG8_LDB(dst, b, h) do { _Pragma("unroll") for (int n = 0; n < 2; ++n) _Pragma("unroll") for (int k = 0; k < 2; ++k) dst[n][k] = *(const PG8_LAS bf16x8*)(lds + PG8_SB(b, h) + boff + n * 2048 + k * 1024); } while (0)
#define PG8_MMA(ai, bj, At, Bt) do { __builtin_amdgcn_s_setprio(1); _Pragma("unroll") for (int m = 0; m < 4; ++m) _Pragma("unroll") for (int n = 0; n < 2; ++n) { \
        if constexpr (FP8) { typedef int v4i_ __attribute__((ext_vector_type(4))); typedef int v8i_ __attribute__((ext_vector_type(8))); \
            const v8i_ b8 = __builtin_shufflevector(__builtin_bit_cast(v4i_, Bt[n][0]), __builtin_bit_cast(v4i_, Bt[n][1]), 0, 1, 2, 3, 4, 5, 6, 7), a8 = __builtin_shufflevector(__builtin_bit_cast(v4i_, At[m][0]), __builtin_bit_cast(v4i_, At[m][1]), 0, 1, 2, 3, 4, 5, 6, 7); \
            acc[ai][bj][m][n] = __builtin_amdgcn_mfma_scale_f32_16x16x128_f8f6f4(b8, a8, acc[ai][bj][m][n], 0, 0, 0, 0, 0, 0); } \
        else { _Pragma("unroll") for (int k = 0; k < 2; ++k) acc[ai][bj][m][n] = __builtin_amdgcn_mfma_f32_16x16x32_bf16(Bt[n][k], At[m][k], acc[ai][bj][m][n], 0, 0, 0); } } __builtin_amdgcn_s_setprio(0); } while (0)
#define PG8_WAIT_V(n) asm volatile("s_waitcnt vmcnt(" #n ")" ::: "memory")
#define PG8_WAIT_L(n) asm volatile("s_waitcnt lgkmcnt(" #n ")" ::: "memory")
#define PG8_BAR __builtin_amdgcn_s_barrier()
#define PG8_SCHED __builtin_amdgcn_sched_barrier(0)
    Unit cur, nxt; int ui = 0;
    if (!S.next(0, cur)) return;
    f32x4 acc[2][2][4][2];
#pragma unroll
    for (int a = 0; a < 2; ++a)
#pragma unroll
        for (int b = 0; b < 2; ++b)
#pragma unroll
            for (int m = 0; m < 4; ++m)
#pragma unroll
                for (int n = 0; n < 2; ++n) acc[a][b][m][n] = (f32x4){0.f, 0.f, 0.f, 0.f};
    bf16x8 At[4][2], B0[2][2], B1[2][2];
    const char* cA = (const char*)g.A + (size_t)cur.pm * tstep; const char* cB = (const char*)g.Bt + (size_t)cur.pn * tstep;
    S.a_ready(cur);
    if constexpr (SP2) {
        PG8_STAGE(PG8_SB(0, 0), cB, voffB); PG8_STAGE(PG8_SB(0, 1), cB + hstep, voffB); PG8_STAGE(PG8_SA(0, 0), cA, voffA); PG8_STAGE(PG8_SA(0, 1), cA + hstep, voffA);
        if (wr == 1) PG8_BAR;
        PG8_WAIT_V(2); PG8_BAR;
        PG8_STAGE(PG8_SB(1, 0), cB + kstep, voffB); PG8_STAGE(PG8_SA(1, 0), cA + kstep, voffA); PG8_STAGE(PG8_SB(1, 1), cB + hstep + kstep, voffB);
        PG8_WAIT_V(6); PG8_BAR;
    } else {
        PG8_STAGE(PG8_SB(0, 0), cB, voffB); PG8_STAGE(PG8_SA(0, 0), cA, voffA); PG8_STAGE(PG8_SB(0, 1), cB + hstep, voffB); PG8_STAGE(PG8_SA(0, 1), cA + hstep, voffA);
        if (wr == 1) PG8_BAR;
        PG8_WAIT_V(4); PG8_BAR;
        PG8_STAGE(PG8_SB(1, 0), cB + kstep, voffB); PG8_STAGE(PG8_SA(1, 0), cA + kstep, voffA); PG8_STAGE(PG8_SB(1, 1), cB + hstep + kstep, voffB);
        PG8_WAIT_V(6); PG8_BAR;
    }
    for (;;) {
        const bool has_next = S.next(ui + 1, nxt);
        const char* nA = has_next ? (const char*)g.A + (size_t)nxt.pm * tstep : cA; const char* nB = has_next ? (const char*)g.Bt + (size_t)nxt.pn * tstep : cB;
        for (int t = 0; t < nt; t += 2) {
            const bool last = (t == nt - 2);
            const char* a1 = cA + (size_t)(t + 1) * kstep;
            const char* a2 = last ? nA : cA + (size_t)(t + 2) * kstep; const char* b2 = last ? nB : cB + (size_t)(t + 2) * kstep;
            const char* a3 = a2 + kstep; const char* b3 = b2 + kstep;
            if (last && has_next) S.a_ready(nxt);
            if constexpr (SP2) {
            PG8_LDB(B0, 0, 0); PG8_LDB(B1, 0, 1); PG8_SCHED; PG8_LDA(At, 0, 0); PG8_STAGE(PG8_SA(1, 1), a1 + hstep, voffA);
            PG8_WAIT_V(8); PG8_WAIT_L(0); PG8_BAR; PG8_MMA(0, 0, At, B0); PG8_MMA(0, 1, At, B1); PG8_BAR; PG8_SCHED;
            PG8_LDA(At, 0, 1); PG8_STAGE(PG8_SB(0, 0), b2, voffB); PG8_STAGE(PG8_SB(0, 1), b2 + hstep, voffB); PG8_STAGE(PG8_SA(0, 0), a2, voffA);
            PG8_WAIT_V(8); PG8_WAIT_L(0); PG8_BAR; PG8_MMA(1, 0, At, B0); PG8_MMA(1, 1, At, B1); PG8_BAR; PG8_SCHED;
            PG8_LDB(B0, 1, 0); PG8_LDB(B1, 1, 1); PG8_SCHED; PG8_LDA(At, 1, 0); PG8_STAGE(PG8_SA(0, 1), a2 + hstep, voffA);
            PG8_WAIT_V(8); PG8_WAIT_L(0); PG8_BAR; PG8_MMA(0, 0, At, B0); PG8_MMA(0, 1, At, B1); PG8_BAR; PG8_SCHED;
            PG8_LDA(At, 1, 1); PG8_STAGE(PG8_SB(1, 0), b3, voffB); PG8_STAGE(PG8_SB(1, 1), b3 + hstep, voffB); PG8_STAGE(PG8_SA(1, 0), a3, voffA);
            PG8_WAIT_V(8); PG8_WAIT_L(0); PG8_BAR; PG8_MMA(1, 0, At, B0); PG8_MMA(1, 1, At, B1); PG8_BAR; PG8_SCHED;
            } else {
            PG8_LDB(B0, 0, 0); PG8_SCHED; PG8_LDA(At, 0, 0); PG8_STAGE(PG8_SA(1, 1), a1 + hstep, voffA);
            PG8_WAIT_L(8); PG8_BAR; PG8_WAIT_L(0); PG8_MMA(0, 0, At, B0); PG8_BAR; PG8_SCHED;
            PG8_LDB(B1, 0, 1); PG8_STAGE(PG8_SB(0, 0), b2, voffB);
            PG8_BAR; PG8_WAIT_L(0); PG8_MMA(0, 1, At, B1); PG8_BAR;
            PG8_LDA(At, 0, 1); PG8_STAGE(PG8_SA(0, 0), a2, voffA);
            PG8_BAR; PG8_WAIT_L(0); PG8_MMA(1, 0, At, B0); PG8_BAR; PG8_SCHED;
            PG8_STAGE(PG8_SB(0, 1), b2 + hstep, voffB);
            PG8_WAIT_V(6); PG8_BAR; PG8_MMA(1, 1, At, B1); PG8_BAR;
            PG8_LDB(B0, 1, 0); PG8_SCHED; PG8_LDA(At, 1, 0); PG8_STAGE(PG8_SA(0, 1), a2 + hstep, voffA);
            PG8_WAIT_L(8); PG8_BAR; PG8_WAIT_L(0); PG8_MMA(0, 0, At, B0); PG8_BAR; PG8_SCHED;
            PG8_LDB(B1, 1, 1); PG8_STAGE(PG8_SB(1, 0), b3, voffB);
            PG8_BAR; PG8_WAIT_L(0); PG8_MMA(0, 1, At, B1); PG8_BAR;
            PG8_LDA(At, 1, 1); PG8_STAGE(PG8_SA(1, 0), a3, voffA);
            PG8_BAR; PG8_WAIT_L(0); PG8_MMA(1, 0, At, B0); PG8_BAR; PG8_SCHED;
            PG8_STAGE(PG8_SB(1, 1), b3 + hstep, voffB);
            PG8_WAIT_V(6); PG8_BAR; PG8_MMA(1, 1, At, B1); PG8_BAR;
            }
        }
        if constexpr (ALIGN_EPI) { if (wr == 0) PG8_BAR; }
        if constexpr (!Epi::AFTER_DRAIN) { E(acc, cur, wr, wc, fr, fq); S.done(cur); }
        if (!has_next) break;
#pragma unroll
        for (int a = 0; a < 2; ++a)
#pragma unroll
            for (int b = 0; b < 2; ++b)
#pragma unroll
                for (int m = 0; m < 4; ++m)
#pragma unroll
                    for (int n = 0; n < 2; ++n) acc[a][b][m][n] = (f32x4){0.f, 0.f, 0.f, 0.f};
        cur = nxt; cA = nA; cB = nB; ++ui;
        if constexpr (ALIGN_EPI) { if (wr == 1) PG8_BAR; }
    }
    PG8_WAIT_V(0);
    if constexpr (!ALIGN_EPI) { if (wr == 0) PG8_BAR; }
    PG8_BAR;
    if constexpr (Epi::AFTER_DRAIN) { E.fused(acc, cur, wr, wc, fr, fq, lds, wid, lane); S.done(cur); }
#undef PG8_SA
#undef PG8_SB
#undef PG8_STAGE
#undef PG8_LDA
#undef PG8_LDB
#undef PG8_MMA
#undef PG8_WAIT_V
#undef PG8_WAIT_L
#undef PG8_BAR
#undef PG8_SCHED
}
}
#define GAS __attribute__((address_space(1)))
#define LAS __attribute__((address_space(3)))
typedef unsigned short bf16;
typedef unsigned v4u __attribute__((ext_vector_type(4)));
typedef float f32x4 __attribute__((ext_vector_type(4)));
typedef short bf16x8 __attribute__((ext_vector_type(8)));
typedef GAS unsigned gu32;
typedef GAS unsigned long long gu64;
#define RLX_AGENT __ATOMIC_RELAXED, __HIP_MEMORY_SCOPE_AGENT
#define LDS_WAIT() asm volatile("s_waitcnt lgkmcnt(0)" ::: "memory")
#define VM_WAIT() asm volatile("s_waitcnt vmcnt(0)" ::: "memory")
__device__ __forceinline__ unsigned long long rt() { return __builtin_amdgcn_s_memrealtime(); }
__device__ __forceinline__ unsigned f2bf(float f) { unsigned u = __builtin_bit_cast(unsigned, f); return (u + 0x7fffu + ((u >> 16) & 1u)) >> 16; }
__device__ __forceinline__ unsigned pk2(float lo, float hi) { return f2bf(lo) | (f2bf(hi) << 16); }

#define XB_TMO      128
#define XB_XCNT(j)  (256  + 64 * (j))
#define XB_XSUB(j)  (1280 + 64 * (j))
#define XB_XGEN(j)  (2304 + 64 * (j))
#define XB_TOP      3328
#define XB_TOPGEN   3392
#define XCD_BAR_WORDS 3456
#define XB_SPIN_CAP (1u << 18)

__device__ __forceinline__ unsigned xb_ld(unsigned* p)              { return __hip_atomic_load(p, __ATOMIC_RELAXED, __HIP_MEMORY_SCOPE_AGENT); }
__device__ __forceinline__ unsigned xb_add(unsigned* p, unsigned v) { return __hip_atomic_fetch_add(p, v, __ATOMIC_RELAXED, __HIP_MEMORY_SCOPE_AGENT); }
__device__ __forceinline__ unsigned xb_xcc_id() { return (unsigned)__builtin_amdgcn_s_getreg((3 << 11) | 20) & 0xFu; }
#define XB_SPIN(cond, bar) do { unsigned _sp = 0; while (cond) { __builtin_amdgcn_s_sleep(1); \
    if ((++_sp & 255u) == 0u) { if (xb_ld(&(bar)[XB_TMO])) break; if (_sp > XB_SPIN_CAP) { atomicAdd(&(bar)[XB_TMO], 1u); break; } } } } while (0)

struct XcdBarrier {
    unsigned* bar; unsigned x;
    volatile LAS unsigned* st;
};

__device__ __forceinline__ XcdBarrier xcd_barrier_post(unsigned* bar, volatile LAS unsigned* st) {
    XcdBarrier b; b.bar = bar; b.x = xb_xcc_id(); b.st = st;
    if (threadIdx.x == 0) (void)xb_add(&bar[XB_XCNT(b.x)], 1u);
    return b;
}
__device__ __forceinline__ void xcd_barrier_complete(unsigned* bar, unsigned x, unsigned& nloc, unsigned& nx) {
    const unsigned G = gridDim.x * gridDim.y * gridDim.z;
    unsigned sum, cnt, mine, sp = 0u;
    for (;;) {
        sum = 0u; cnt = 0u; mine = 0u;
#pragma unroll
        for (unsigned j = 0; j < 16; ++j) { const unsigned c = xb_ld(&bar[XB_XCNT(j)]); sum += c; cnt += (c > 0u) ? 1u : 0u; mine = (j == x) ? c : mine; }
        if (sum == G) break;
        __builtin_amdgcn_s_sleep(1);
        if ((++sp & 255u) == 0u) { if (xb_ld(&bar[XB_TMO])) break; if (sp > XB_SPIN_CAP) { atomicAdd(&bar[XB_TMO], 1u); break; } }
    }
    nloc = mine > 0u ? mine : 1u; nx = cnt > 0u ? cnt : 1u;
}

__device__ __forceinline__ void xcd_barrier(const XcdBarrier& b) {
    asm volatile("s_waitcnt vmcnt(0)" ::: "memory");
    __syncthreads();
    if (threadIdx.x == 0) {
        unsigned* bar = b.bar;
        __builtin_amdgcn_s_waitcnt(0);
        unsigned nloc = b.st[0], nx = b.st[1];
        if (nloc == 0u) { xcd_barrier_complete(bar, b.x, nloc, nx); b.st[0] = nloc; b.st[1] = nx; }
        const unsigned old = xb_add(&bar[XB_XSUB(b.x)], 1u);
        const unsigned gen = old / nloc;
        if (old + 1u == (gen + 1u) * nloc) {
            __builtin_amdgcn_fence(__ATOMIC_RELEASE, "agent");
            asm volatile("s_waitcnt vmcnt(0)" ::: "memory");
            const unsigned og = xb_add(&bar[XB_TOP], 1u);
            const unsigned tg = og / nx;
            if (og + 1u == (tg + 1u) * nx) xb_add(&bar[XB_TOPGEN], 1u);
            else XB_SPIN(xb_ld(&bar[XB_TOPGEN]) == tg, bar);
            __builtin_amdgcn_fence(__ATOMIC_ACQUIRE, "agent");
            xb_add(&bar[XB_XGEN(b.x)], 1u);
            asm volatile("s_waitcnt vmcnt(0)" ::: "memory");
        } else {
            XB_SPIN(xb_ld(&bar[XB_XGEN(b.x)]) == gen, bar);
            __builtin_amdgcn_fence(__ATOMIC_ACQUIRE, "agent");
            asm volatile("s_waitcnt vmcnt(0)" ::: "memory");
        }
    }
    __syncthreads();
}

namespace fa {
#define FA_LAS __attribute__((address_space(3)))
typedef unsigned short bf16;
typedef short bf16x8 __attribute__((ext_vector_type(8)));
typedef short s16x4 __attribute__((ext_vector_type(4)));
typedef float f32x16 __attribute__((ext_vector_type(16)));
typedef float f32x4 __attribute__((ext_vector_type(4)));
typedef unsigned u32x4 __attribute__((ext_vector_type(4)));
constexpr int D = 128, KVBLK = 64, SHM_V = KVBLK * D * 2, SHM_K = KVBLK * D * 2;
constexpr int OFF_V = 0, OFF_K = 2 * SHM_V, SLOT = 2 * SHM_V + 2 * SHM_K, OFF_WS = 135168, WS_PER_WAVE = 512, ENGINE_BYTES = OFF_WS + 8 * WS_PER_WAVE;
constexpr float SCALE = 0.08838834764831845f;
constexpr float THR = 8.f;
constexpr float C2 = 1.4426950408889634f * SCALE;
#define KSWZ(row, colB) ((row) * 256 + ((colB) ^ (((row) & 7) << 4)))
#define SBAR() __builtin_amdgcn_sched_barrier(0)
__device__ __forceinline__ int v_st(int k, int c) { const int kk = (k & ~0xC) | ((k & 4) << 1) | ((k & 8) >> 1); return ((kk >> 3) * 4 + (c >> 5)) * 512 + ((kk & 7) * 32 + (c & 31)) * 2; }
__device__ __forceinline__ int v_rd_base(int lane) { return ((lane & 3) << 3) | (((lane >> 2) & 3) << 6) | (((lane >> 4) & 1) << 5) | (((lane >> 5) & 1) << 8); }
constexpr int v_rd_off(int d0, int ks, int half) { return d0 * 512 + ks * 4096 + half * 2048; }
__device__ __forceinline__ int crow(int r, int hi) { return (r & 3) + 8 * (r >> 2) + 4 * hi; }
typedef float f32x2_t __attribute__((ext_vector_type(2))); typedef __bf16 bf16x2_t __attribute__((ext_vector_type(2)));
__device__ __forceinline__ unsigned cvtpk(float lo, float hi) { f32x2_t v = {lo, hi}; bf16x2_t b = __builtin_convertvector(v, bf16x2_t); return __builtin_bit_cast(unsigned, b); }
__device__ __forceinline__ float bf2f(unsigned short b) { return __uint_as_float(((unsigned)b) << 16); }
__device__ __forceinline__ void mask_tile(f32x16& p0, f32x16& p1, int dq, unsigned W) {
    const float NEG = -__builtin_inff();
#pragma unroll
    for (int r = 0; r < 16; ++r) { const int c = (r & 3) + 8 * (r >> 2);
        if ((unsigned)(dq - c) >= W) p0[r] = NEG;
        if ((unsigned)(dq - c - 32) >= W) p1[r] = NEG; }
}
__device__ __forceinline__ void mask_gt(f32x16& p0, f32x16& p1, int lim, int hi) {
    const float NEG = -__builtin_inff();
#pragma unroll
    for (int r = 0; r < 16; ++r) { const int c = (r & 3) + 8 * (r >> 2) + 4 * hi;
        if (c > lim) p0[r] = NEG;
        if (c + 32 > lim) p1[r] = NEG; }
}
__device__ __forceinline__ void partialSM(f32x16& p0, f32x16& p1, float& m_reg, float& mn, float& alpha) {
    float pmax = p0[0];
#pragma unroll
    for (int r = 1; r < 16; ++r) pmax = fmaxf(pmax, p0[r]);
#pragma unroll
    for (int r = 0; r < 16; ++r) pmax = fmaxf(pmax, p1[r]);
    { auto rr = __builtin_amdgcn_permlane32_swap(__float_as_uint(pmax), __float_as_uint(pmax), false, false);
      pmax = fmaxf(__uint_as_float(rr[0]), __uint_as_float(rr[1])); }
    if (__builtin_expect(__all((pmax - m_reg) * SCALE <= THR), 1)) { mn = m_reg; alpha = 1.f; }
    else { mn = fmaxf(m_reg, pmax); alpha = __builtin_amdgcn_exp2f((m_reg - mn) * C2); m_reg = mn; }
    const float mnL = -mn * C2;
#pragma unroll
    for (int r = 0; r < 16; ++r) p0[r] = fmaf(p0[r], C2, mnL);
#pragma unroll
    for (int r = 0; r < 16; ++r) p1[r] = fmaf(p1[r], C2, mnL);
#pragma unroll
    for (int r = 0; r < 16; ++r) p0[r] = __builtin_amdgcn_exp2f(p0[r]);
}
__device__ __forceinline__ void partialSM_sel(f32x16& p0, f32x16& p1, float& m_reg, float& mn, float& alpha, bool rowsel) {
    float pmax = p0[0];
#pragma unroll
    for (int r = 1; r < 16; ++r) pmax = fmaxf(pmax, p0[r]);
#pragma unroll
    for (int r = 0; r < 16; ++r) pmax = fmaxf(pmax, p1[r]);
    { auto rr = __builtin_amdgcn_permlane32_swap(__float_as_uint(pmax), __float_as_uint(pmax), false, false);
      pmax = fmaxf(__uint_as_float(rr[0]), __uint_as_float(rr[1])); }
    if (__builtin_expect(__all((pmax - m_reg) * SCALE <= THR), 1)) { mn = m_reg; alpha = 1.f; }
    else { mn = fmaxf(m_reg, pmax); alpha = __builtin_amdgcn_exp2f((m_reg - mn) * C2); m_reg = mn; }
    const float mnL = rowsel ? -mn * C2 : -__builtin_inff();
#pragma unroll
    for (int r = 0; r < 16; ++r) p0[r] = fmaf(p0[r], C2, mnL);
#pragma unroll
    for (int r = 0; r < 16; ++r) p1[r] = fmaf(p1[r], C2, mnL);
#pragma unroll
    for (int r = 0; r < 16; ++r) p0[r] = __builtin_amdgcn_exp2f(p0[r]);
}
#define FA_PK4(P, B_, OUT) do { unsigned a0 = cvtpk(P[B_+0], P[B_+1]), a1 = cvtpk(P[B_+2], P[B_+3]);                          \
        unsigned b0 = cvtpk(P[B_+4], P[B_+5]), b1 = cvtpk(P[B_+6], P[B_+7]);                                             \
        auto r0 = __builtin_amdgcn_permlane32_swap(a0, b0, false, false); auto r1 = __builtin_amdgcn_permlane32_swap(a1, b1, false, false); \
        u32x4 w = {r0[0], r1[0], r0[1], r1[1]}; OUT = *reinterpret_cast<bf16x8*>(&w); } while (0)
__device__ __forceinline__ void packP(const f32x16& p0, const f32x16& p1, bf16x8& pa0, bf16x8& pa1, bf16x8& pa2, bf16x8& pa3) {
    FA_PK4(p0, 0, pa0); FA_PK4(p0, 8, pa1); FA_PK4(p1, 0, pa2); FA_PK4(p1, 8, pa3);
}
__device__ __forceinline__ void finishSM(f32x16& p0, f32x16& p1, float alpha, float& l_reg, bf16x8& pa0, bf16x8& pa1, bf16x8& pa2, bf16x8& pa3) {
#pragma unroll
    for (int r = 0; r < 16; ++r) p1[r] = __builtin_amdgcn_exp2f(p1[r]);
    float ps = 0;
#pragma unroll
    for (int r = 0; r < 16; ++r) ps += p0[r];
#pragma unroll
    for (int r = 0; r < 16; ++r) ps += p1[r];
    { auto rr = __builtin_amdgcn_permlane32_swap(__float_as_uint(ps), __float_as_uint(ps), false, false);
      ps = __uint_as_float(rr[0]) + __uint_as_float(rr[1]); }
    l_reg = l_reg * alpha + ps;
    packP(p0, p1, pa0, pa1, pa2, pa3);
}
#define FA_K4(F, B_, A0, A1, O0, O1) asm volatile("ds_read_b128 %0, %4 offset:" O0 "\n\tds_read_b128 %1, %4 offset:" O1 "\n\tds_read_b128 %2, %5 offset:" O0 "\n\tds_read_b128 %3, %5 offset:" O1 \
                                      : "=&v"(F[B_ + 0]), "=&v"(F[B_ + 1]), "=&v"(F[B_ + 2]), "=&v"(F[B_ + 3]) : "v"(A0), "v"(A1) : "memory")
#define FA_W4(F, B_, N_) asm volatile("s_waitcnt lgkmcnt(" #N_ ")" : "+v"(F[B_ + 0]), "+v"(F[B_ + 1]), "+v"(F[B_ + 2]), "+v"(F[B_ + 3]) :: "memory")
#define FA_W8(F, B_, N_) asm volatile("s_waitcnt lgkmcnt(" #N_ ")" : "+v"(F[B_ + 0]), "+v"(F[B_ + 1]), "+v"(F[B_ + 2]), "+v"(F[B_ + 3]), "+v"(F[B_ + 4]), "+v"(F[B_ + 5]), "+v"(F[B_ + 6]), "+v"(F[B_ + 7]) :: "memory")
#define FA_QK2(F, B_, d0) do { p0 = __builtin_amdgcn_mfma_f32_32x32x16_bf16(F[B_ + 0], qr[d0], p0, 0, 0, 0); p1 = __builtin_amdgcn_mfma_f32_32x32x16_bf16(F[B_ + 1], qr[d0], p1, 0, 0, 0); \
                               p0 = __builtin_amdgcn_mfma_f32_32x32x16_bf16(F[B_ + 2], qr[d0 + 1], p0, 0, 0, 0); p1 = __builtin_amdgcn_mfma_f32_32x32x16_bf16(F[B_ + 3], qr[d0 + 1], p1, 0, 0, 0); } while (0)
__device__ __forceinline__ void qkt(f32x16& p0, f32x16& p1, const FA_LAS char* Kt, int r32, int hi, const bf16x8* qr) {
    p0 = f32x16{}; p1 = f32x16{};
    int ka[4];
#pragma unroll
    for (int dd = 0; dd < 4; ++dd) ka[dd] = (int)(unsigned)(uintptr_t)(Kt + KSWZ(r32, (dd * 16 + hi * 8) * 2));
    bf16x8 f[16];
    FA_K4(f, 0, ka[0], ka[1], "0", "8192"); FA_K4(f, 4, ka[2], ka[3], "0", "8192"); FA_K4(f, 8, ka[0], ka[1], "128", "8320");
    FA_W4(f, 0, 8); FA_QK2(f, 0, 0);
    SBAR();
    FA_W4(f, 4, 4); FA_K4(f, 12, ka[2], ka[3], "128", "8320"); FA_QK2(f, 4, 2);
    SBAR();
    FA_W4(f, 8, 4); FA_QK2(f, 8, 4);
    SBAR();
    FA_W4(f, 12, 0); FA_QK2(f, 12, 6);
}
struct VPre { s16x4 v[16]; };
#define FA_V8(F, B_, d0) do { constexpr int b_ = v_rd_off(d0, 0, 0); \
        asm volatile("ds_read_b64_tr_b16 %0, %8 offset:%9\n\tds_read_b64_tr_b16 %1, %8 offset:%10\n\tds_read_b64_tr_b16 %2, %8 offset:%11\n\tds_read_b64_tr_b16 %3, %8 offset:%12\n\t" \
                     "ds_read_b64_tr_b16 %4, %8 offset:%13\n\tds_read_b64_tr_b16 %5, %8 offset:%14\n\tds_read_b64_tr_b16 %6, %8 offset:%15\n\tds_read_b64_tr_b16 %7, %8 offset:%16" \
                     : "=&v"(F[B_ + 0]), "=&v"(F[B_ + 1]), "=&v"(F[B_ + 2]), "=&v"(F[B_ + 3]), "=&v"(F[B_ + 4]), "=&v"(F[B_ + 5]), "=&v"(F[B_ + 6]), "=&v"(F[B_ + 7]) \
                     : "v"(vb0), "i"(b_), "i"(b_ + 2048), "i"(b_ + 4096), "i"(b_ + 6144), "i"(b_ + 8192), "i"(b_ + 10240), "i"(b_ + 12288), "i"(b_ + 14336) : "memory"); } while (0)
__device__ __forceinline__ void pv_issue(int vb0, VPre& f) { FA_V8(f.v, 0, 0); FA_V8(f.v, 8, 1); }
#define FA_PVM(d0, F, B_) do { \
        o[d0] = __builtin_amdgcn_mfma_f32_32x32x16_bf16(pa0, (bf16x8){F[B_+0][0], F[B_+0][1], F[B_+0][2], F[B_+0][3], F[B_+1][0], F[B_+1][1], F[B_+1][2], F[B_+1][3]}, o[d0], 0, 0, 0);   \
        o[d0] = __builtin_amdgcn_mfma_f32_32x32x16_bf16(pa1, (bf16x8){F[B_+2][0], F[B_+2][1], F[B_+2][2], F[B_+2][3], F[B_+3][0], F[B_+3][1], F[B_+3][2], F[B_+3][3]}, o[d0], 0, 0, 0);   \
        o[d0] = __builtin_amdgcn_mfma_f32_32x32x16_bf16(pa2, (bf16x8){F[B_+4][0], F[B_+4][1], F[B_+4][2], F[B_+4][3], F[B_+5][0], F[B_+5][1], F[B_+5][2], F[B_+5][3]}, o[d0], 0, 0, 0);   \
        o[d0] = __builtin_amdgcn_mfma_f32_32x32x16_bf16(pa3, (bf16x8){F[B_+6][0], F[B_+6][1], F[B_+6][2], F[B_+6][3], F[B_+7][0], F[B_+7][1], F[B_+7][2], F[B_+7][3]}, o[d0], 0, 0, 0); } while (0)
__device__ __forceinline__ void pv_tile(f32x16* o, int vb0, bf16x8 pa0, bf16x8 pa1, bf16x8 pa2, bf16x8 pa3, VPre& f) {
    s16x4 g[16];
    FA_W8(f.v, 0, 0); FA_W8(f.v, 8, 0);
    FA_V8(g, 0, 2);
    SBAR();
    FA_PVM(0, f.v, 0);
    SBAR();
    FA_V8(g, 8, 3);
    SBAR();
    FA_PVM(1, f.v, 8);
    SBAR();
    FA_W8(g, 0, 8); FA_PVM(2, g, 0);
    SBAR();
    FA_W8(g, 8, 0); FA_PVM(3, g, 8);
}
#define FA_K4S(F, B_, A, O0, O1, O2, O3) asm volatile("ds_read_b128 %0, %4 offset:" O0 "\n\tds_read_b128 %1, %4 offset:" O1 "\n\tds_read_b128 %2, %4 offset:" O2 "\n\tds_read_b128 %3, %4 offset:" O3 \
                                      : "=&v"(F[B_ + 0]), "=&v"(F[B_ + 1]), "=&v"(F[B_ + 2]), "=&v"(F[B_ + 3]) : "v"(A) : "memory")
#define FA_QK16(F, B_, ks) do { s[0] = __builtin_amdgcn_mfma_f32_16x16x32_bf16(F[B_ + 0], qh[ks], s[0], 0, 0, 0); s[1] = __builtin_amdgcn_mfma_f32_16x16x32_bf16(F[B_ + 1], qh[ks], s[1], 0, 0, 0); \
                                 s[2] = __builtin_amdgcn_mfma_f32_16x16x32_bf16(F[B_ + 2], qh[ks], s[2], 0, 0, 0); s[3] = __builtin_amdgcn_mfma_f32_16x16x32_bf16(F[B_ + 3], qh[ks], s[3], 0, 0, 0); } while (0)
__device__ __forceinline__ void qk16(f32x4* s, int a0, int a1, const bf16x8* qh) {
    s[0] = f32x4{0.f, 0.f, 0.f, 0.f}; s[1] = s[0]; s[2] = s[0]; s[3] = s[0];
    bf16x8 f[16];
    FA_K4S(f, 0, a0, "0", "4096", "8192", "12288"); FA_K4S(f, 4, a1, "0", "4096", "8192", "12288"); FA_K4S(f, 8, a0, "128", "4224", "8320", "12416");
    FA_W4(f, 0, 8); FA_QK16(f, 0, 0);
    SBAR();
    FA_W4(f, 4, 4); FA_K4S(f, 12, a1, "128", "4224", "8320", "12416"); FA_QK16(f, 4, 1);
    SBAR();
    FA_W4(f, 8, 4); FA_QK16(f, 8, 2);
    SBAR();
    FA_W4(f, 12, 0); FA_QK16(f, 12, 3);
}
__device__ __forceinline__ int v16_rd_base(int lane) { const int g4 = lane >> 4, q = (lane & 15) >> 2, p = lane & 3, k0 = 4 * g4 + q, kk0 = (k0 & ~0xC) | ((k0 & 4) << 1) | ((k0 & 8) >> 1); return ((kk0 >> 3) * 4) * 512 + ((kk0 & 7) * 32 + 4 * p) * 2; }
#define FA_V8H(F, B_, dbp) do { constexpr int b_ = (dbp) * 512; \
        asm volatile("ds_read_b64_tr_b16 %0, %8 offset:%9\n\tds_read_b64_tr_b16 %1, %8 offset:%10\n\tds_read_b64_tr_b16 %2, %8 offset:%11\n\tds_read_b64_tr_b16 %3, %8 offset:%12\n\t" \
                     "ds_read_b64_tr_b16 %4, %8 offset:%13\n\tds_read_b64_tr_b16 %5, %8 offset:%14\n\tds_read_b64_tr_b16 %6, %8 offset:%15\n\tds_read_b64_tr_b16 %7, %8 offset:%16" \
                     : "=&v"(F[B_ + 0]), "=&v"(F[B_ + 1]), "=&v"(F[B_ + 2]), "=&v"(F[B_ + 3]), "=&v"(F[B_ + 4]), "=&v"(F[B_ + 5]), "=&v"(F[B_ + 6]), "=&v"(F[B_ + 7]) \
                     : "v"(vb0), "i"(b_), "i"(b_ + 4096), "i"(b_ + 8192), "i"(b_ + 12288), "i"(b_ + 32), "i"(b_ + 32 + 4096), "i"(b_ + 32 + 8192), "i"(b_ + 32 + 12288) : "memory"); } while (0)
__device__ __forceinline__ void pv16_issue(int vb0, VPre& f) { FA_V8H(f.v, 0, 0); FA_V8H(f.v, 8, 1); }
#define FA_PVM16(db, F, B_) do { \
        o[db] = __builtin_amdgcn_mfma_f32_16x16x32_bf16(pa0, (bf16x8){F[B_+0][0], F[B_+0][1], F[B_+0][2], F[B_+0][3], F[B_+1][0], F[B_+1][1], F[B_+1][2], F[B_+1][3]}, o[db], 0, 0, 0);   \
        o[db] = __builtin_amdgcn_mfma_f32_16x16x32_bf16(pa1, (bf16x8){F[B_+2][0], F[B_+2][1], F[B_+2][2], F[B_+2][3], F[B_+3][0], F[B_+3][1], F[B_+3][2], F[B_+3][3]}, o[db], 0, 0, 0); } while (0)
__device__ __forceinline__ void pv16(f32x4* o, int vb0, bf16x8 pa0, bf16x8 pa1, VPre& f) {
    s16x4 g[16];
    FA_W8(f.v, 0, 0); FA_W8(f.v, 8, 0);
    FA_V8H(g, 0, 2); FA_V8H(g, 8, 3);
    SBAR();
    FA_PVM16(0, f.v, 0); FA_PVM16(1, f.v, 4); FA_PVM16(2, f.v, 8); FA_PVM16(3, f.v, 12);
    SBAR();
    FA_W8(g, 0, 8); FA_PVM16(4, g, 0); FA_PVM16(5, g, 4);
    SBAR();
    FA_W8(g, 8, 0); FA_PVM16(6, g, 8); FA_PVM16(7, g, 12);
}
__device__ __forceinline__ void sm16_max(const f32x4* s, float& m_reg, float& mn, float& alpha) {
    float pmax = fmaxf(fmaxf(s[0][0], s[0][1]), fmaxf(s[0][2], s[0][3]));
#pragma unroll
    for (int mb = 1; mb < 4; ++mb) pmax = fmaxf(pmax, fmaxf(fmaxf(s[mb][0], s[mb][1]), fmaxf(s[mb][2], s[mb][3])));
    pmax = fmaxf(pmax, xl_f<16>(pmax));
    { auto rr = __builtin_amdgcn_permlane32_swap(__float_as_uint(pmax), __float_as_uint(pmax), false, false); pmax = fmaxf(__uint_as_float(rr[0]), __uint_as_float(rr[1])); }
    if (__builtin_expect(__all((pmax - m_reg) * SCALE <= THR), 1)) { mn = m_reg; alpha = 1.f; }
    else { mn = fmaxf(m_reg, pmax); alpha = __builtin_amdgcn_exp2f((m_reg - mn) * C2); m_reg = mn; }
}
__device__ __forceinline__ void sm16_fin(f32x4* s, float mn, float alpha, bool rowsel, float& l_reg, bf16x8& pa0, bf16x8& pa1) {
    const float mnL = rowsel ? -mn * C2 : -__builtin_inff();
    float ps = 0.f;
#pragma unroll
    for (int mb = 0; mb < 4; ++mb)
#pragma unroll
        for (int j = 0; j < 4; ++j) { s[mb][j] = __builtin_amdgcn_exp2f(fmaf(s[mb][j], C2, mnL)); ps += s[mb][j]; }
    ps += xl_f<16>(ps); ps = x32_sum(ps);
    l_reg = l_reg * alpha + ps;
    { u32x4 w = {cvtpk(s[0][0], s[0][1]), cvtpk(s[0][2], s[0][3]), cvtpk(s[1][0], s[1][1]), cvtpk(s[1][2], s[1][3])}; pa0 = *reinterpret_cast<bf16x8*>(&w); }
    { u32x4 w = {cvtpk(s[2][0], s[2][1]), cvtpk(s[2][2], s[2][3]), cvtpk(s[3][0], s[3][1]), cvtpk(s[3][2], s[3][3])}; pa1 = *reinterpret_cast<bf16x8*>(&w); }
}
__device__ __forceinline__ void rescale16(f32x4* o, float alpha, float l_prev, volatile FA_LAS float* al16, int n16, int g4) {
    if (__any(alpha < 1.f && l_prev > 0.f)) { if (g4 == 0) al16[n16] = alpha; asm volatile("s_waitcnt lgkmcnt(0)" ::: "memory");
        const float a0 = al16[4 * g4], a1 = al16[4 * g4 + 1], a2 = al16[4 * g4 + 2], a3 = al16[4 * g4 + 3];
#pragma unroll
        for (int db = 0; db < 8; ++db) { o[db][0] *= a0; o[db][1] *= a1; o[db][2] *= a2; o[db][3] *= a3; }
        asm volatile("s_waitcnt lgkmcnt(0)" ::: "memory"); }
}
struct DmaOff { unsigned k0, k1, v0, v1; };
__device__ __forceinline__ DmaOff dma_offsets(int wid, int lane) {
    DmaOff d; unsigned ko[2], vo[2];
#pragma unroll
    for (int i = 0; i < 2; ++i) { const int q = (2 * wid + i) * 64 + lane;
        { const int row = q >> 4, c16 = (q & 15) ^ (row & 7); ko[i] = (unsigned)(row * 256 + c16 * 16); }
        { const int sub = q >> 5, kk = (sub >> 2) * 8 + ((q & 31) >> 2), c = (sub & 3) * 32 + (q & 3) * 8, k = (kk & ~0xC) | ((kk & 4) << 1) | ((kk & 8) >> 1); vo[i] = (unsigned)(k * 256 + c * 2); } }
    d.k0 = ko[0]; d.k1 = ko[1]; d.v0 = vo[0]; d.v1 = vo[1]; return d;
}
__device__ __forceinline__ void dma_k(const char* src_tile, FA_LAS char* img, int wid, const DmaOff& d) {
    __builtin_amdgcn_global_load_lds((const unsigned*)(src_tile + d.k0), (FA_LAS unsigned*)(img + (2 * wid) * 1024), 16, 0, 0);
    __builtin_amdgcn_global_load_lds((const unsigned*)(src_tile + d.k1), (FA_LAS unsigned*)(img + (2 * wid + 1) * 1024), 16, 0, 0);
}
__device__ __forceinline__ void dma_v(const char* src_tile, FA_LAS char* img, int wid, const DmaOff& d) {
    __builtin_amdgcn_global_load_lds((const unsigned*)(src_tile + d.v0), (FA_LAS unsigned*)(img + (2 * wid) * 1024), 16, 0, 0);
    __builtin_amdgcn_global_load_lds((const unsigned*)(src_tile + d.v1), (FA_LAS unsigned*)(img + (2 * wid + 1) * 1024), 16, 0, 0);
}
#define FA_DMA_SYNC() do { asm volatile("s_waitcnt vmcnt(0)" ::: "memory"); __syncthreads(); } while (0)
__device__ __forceinline__ void rescale_o(f32x16* o, float alpha, float l_prev, volatile FA_LAS float* al_l, int r32, int hi) {
    if (__any(alpha < 1.f && l_prev > 0.f)) { if (hi == 0) al_l[r32] = alpha; asm volatile("s_waitcnt lgkmcnt(0)" ::: "memory");
#pragma unroll
        for (int d_ = 0; d_ < 4; ++d_)
#pragma unroll
            for (int r = 0; r < 16; ++r) o[d_][r] *= al_l[crow(r, hi)];
        asm volatile("s_waitcnt lgkmcnt(0)" ::: "memory"); }
}

struct BandArgs { const bf16* Q; const bf16* K; const bf16* V; bf16* O; size_t o_stride; float* lse; size_t lse_stride; int P0, W, mode; float sink;
                  const bf16* nK; const bf16* nV; int nP0, nW, has_next, prefetched; const bf16* nQ; };
struct QCarry { bf16x8 q[8]; };
__device__ __forceinline__ void banded_unit(FA_LAS char* lds, const BandArgs& a, QCarry& qc) {
    int tid_ = threadIdx.x; asm volatile("" : "+v"(tid_));
    const int tid = tid_, wid = __builtin_amdgcn_readfirstlane(tid >> 6), lane = tid & 63, r32 = lane & 31, hi = lane >> 5;
    const int P0 = a.P0, W = a.W;
    const int lowk = P0 - W + 1, j_lo = lowk > 0 ? (lowk >> 6) : 0, j_hi = (P0 >> 6) + 4, NT = j_hi - j_lo;
    const int qlo = P0 + wid * 32, qm = qlo + r32 - 4 * hi;
    const FA_LAS char* V_lds = lds + OFF_V; const FA_LAS char* K_lds = lds + OFF_K;
    volatile FA_LAS float* ws = (volatile FA_LAS float*)(lds + OFF_WS + wid * WS_PER_WAVE); volatile FA_LAS float* li_l = ws; volatile FA_LAS float* al_l = ws + 32; volatile FA_LAS float* co_l = ws + 64;
    const int vb0 = (int)(unsigned)(uintptr_t)V_lds + v_rd_base(lane);
    const DmaOff dof = dma_offsets(wid, lane);
    bf16x8 qr[8];
#pragma unroll
    for (int d0 = 0; d0 < 8; ++d0) qr[d0] = a.prefetched ? qc.q[d0] : *(const bf16x8*)(a.Q + (size_t)(qlo + r32) * D + d0 * 16 + hi * 8);
    float m_reg = -1e30f, l_reg = 0.f; f32x16 o[4] = {};
#define FA_DMA_PAIR(kb0, off_) do { const char* kb_ = (const char*)a.K + (size_t)(kb0) * (D * 2); const char* vb_ = (const char*)a.V + (size_t)(kb0) * (D * 2); \
        dma_k(kb_, lds + (off_) + OFF_K, wid, dof); dma_k(kb_ + 64 * D * 2, lds + (off_) + OFF_K + SHM_K, wid, dof); dma_v(vb_, lds + (off_) + OFF_V, wid, dof); dma_v(vb_ + 64 * D * 2, lds + (off_) + OFF_V + SHM_V, wid, dof); } while (0)
#define FA_BAND_TILE(kb, off_) do { const bool act = ((kb) <= qlo + 31) && ((kb) + 63 >= qlo - W + 1);     \
        if (act) { f32x16 p0, p1; float mn, alpha; bf16x8 pa0, pa1, pa2, pa3; \
            qkt(p0, p1, K_lds + (off_), r32, hi, qr); VPre vf_; pv_issue(vb0 + (off_), vf_); \
            if ((kb) + 63 > qlo || (kb) <= qlo + 31 - W) mask_tile(p0, p1, qm - (kb), (unsigned)W); \
            partialSM(p0, p1, m_reg, mn, alpha); rescale_o(o, alpha, l_reg, al_l, r32, hi); finishSM(p0, p1, alpha, l_reg, pa0, pa1, pa2, pa3); \
            pv_tile(o, vb0 + (off_), pa0, pa1, pa2, pa3, vf_); } } while (0)
    const int NP = NT >> 1;
    if (!a.prefetched) FA_DMA_PAIR(j_lo * 64, 0);
    FA_DMA_SYNC();
    for (int ip = 0; ip < NP; ++ip) {
        const int so = (ip & 1) * SLOT, kb = (j_lo + 2 * ip) * 64;
        if (ip + 1 < NP) FA_DMA_PAIR(kb + 128, so ^ SLOT);
        { const int kbA = kb, kbB = kb + 64;
          const bool actA = (kbA <= qlo + 31) && (kbA + 63 >= qlo - W + 1), actB = (kbB <= qlo + 31) && (kbB + 63 >= qlo - W + 1);
          { FA_BAND_TILE(kbA, so); FA_BAND_TILE(kbB, so + SHM_K); } }
        FA_DMA_SYNC();
    }
    if (a.has_next) {
#pragma unroll
        for (int d0 = 0; d0 < 8; ++d0) qc.q[d0] = *(const bf16x8*)(a.nQ + (size_t)(a.nP0 + wid * 32 + r32) * D + d0 * 16 + hi * 8);
    }
    if (a.has_next) {
        const int nlow = a.nP0 - a.nW + 1, njl = nlow > 0 ? (nlow >> 6) : 0;
        const char* kb_ = (const char*)a.nK + (size_t)(njl * 64) * (D * 2); const char* vb_ = (const char*)a.nV + (size_t)(njl * 64) * (D * 2);
        dma_k(kb_, lds + OFF_K, wid, dof); dma_k(kb_ + 64 * D * 2, lds + OFF_K + SHM_K, wid, dof); dma_v(vb_, lds + OFF_V, wid, dof); dma_v(vb_ + 64 * D * 2, lds + OFF_V + SHM_V, wid, dof); }
#undef FA_DMA_PAIR
#undef FA_BAND_TILE
    const int mode = a.mode; float coef, cold = 0.f;
    const size_t urow = (size_t)(qlo + r32);
    if (mode == 1) { coef = 1.0f / (l_reg + __builtin_amdgcn_exp2f(a.sink * 1.4426950408889634f - m_reg * C2)); }
    else if (mode == 2) { coef = 1.0f / l_reg; if (hi == 0) a.lse[urow * a.lse_stride] = m_reg * SCALE + __logf(l_reg); }
    else if (mode == 3) { const float lg = m_reg * SCALE + __logf(l_reg), lo_ = a.lse[urow * a.lse_stride], mx = fmaxf(lg, lo_), e0 = __expf(lo_ - mx), e1 = __expf(lg - mx), inv = 1.0f / (e0 + e1);
        cold = e0 * inv; coef = e1 * inv / l_reg; if (hi == 0) a.lse[urow * a.lse_stride] = mx + __logf(e0 + e1); }
    else coef = 1.0f / l_reg;
    if (hi == 0) { li_l[r32] = coef; co_l[r32] = cold; }
    asm volatile("s_waitcnt lgkmcnt(0)" ::: "memory");
    unsigned oldw[16][2];
    if (mode == 3) {
#pragma unroll
        for (int r = 0; r < 16; ++r) { const bf16* Ow = a.O + (size_t)(qlo + crow(r, hi)) * a.o_stride;
#pragma unroll
            for (int dp = 0; dp < 2; ++dp) oldw[r][dp] = *(const unsigned*)(Ow + (2 * dp + (r32 & 1)) * 32 + (r32 & ~1)); } }
#pragma unroll
    for (int r = 0; r < 16; ++r) { const int orow = crow(r, hi); const float cf = li_l[orow], co = co_l[orow];
        bf16* Ow = a.O + (size_t)(qlo + orow) * a.o_stride;
#pragma unroll
        for (int dp = 0; dp < 2; ++dp) {
            const float va = o[2 * dp][r] * cf, vb = o[2 * dp + 1][r] * cf, xa = xl_f<1>(va), xb = xl_f<1>(vb);
            const bool odd = (r32 & 1) != 0; float x0 = odd ? xb : va, x1 = odd ? vb : xa;
            if (mode == 3) { const unsigned old = oldw[r][dp]; x0 += co * __uint_as_float(old << 16); x1 += co * __uint_as_float(old & 0xffff0000u); }
            *(unsigned*)(Ow + (2 * dp + (r32 & 1)) * 32 + (r32 & ~1)) = cvtpk(x0, x1); } }
    asm volatile("s_waitcnt lgkmcnt(0)" ::: "memory");
    if (!a.has_next) __syncthreads();
}

constexpr int NSA_OFF_IMP = SLOT;
constexpr int NSA_OFF_SEL = 2 * SLOT;
constexpr int NSA_OFF_UNI = NSA_OFF_SEL + 2048;
constexpr int NSA_OFF_LIST = NSA_OFF_UNI + 64;
constexpr int NSA_OFF_WUN = NSA_OFF_LIST + 1024;
constexpr int NSA_OFF_AM = NSA_OFF_WUN + 256;
constexpr int NSA_BYTES = ENGINE_BYTES;
static_assert(NSA_OFF_AM + 256 <= OFF_WS, "NSA LDS map");
struct NsaArgs { const bf16* QA; const bf16* KA; const bf16* VA; const bf16* kc; const bf16* vc; const float* gates; const bf16* owin; bf16* ocat; int b, g, t0; bf16* dbg_stash; unsigned* dbg_sel; int dry;   };
__device__ __forceinline__ void nsa_unit(FA_LAS char* lds, const NsaArgs& a) {
    int tid_ = threadIdx.x; asm volatile("" : "+v"(tid_));
    const int tid = tid_, wid = __builtin_amdgcn_readfirstlane(tid >> 6), lane = tid & 63, r32 = lane & 31, hi = lane >> 5;
    const int b = a.b, g = a.g, t0 = a.t0, bg = b * 2 + g;
    const int hq = r32 >> 3, qq = r32 & 7, tq = t0 + 8 * wid + qq, head = g * 4 + hq;
    const int cur = t0 >> 6;
    const FA_LAS char* V_lds = lds + OFF_V; const FA_LAS char* K_lds = lds + OFF_K;
    volatile FA_LAS float* ws = (volatile FA_LAS float*)(lds + OFF_WS + wid * WS_PER_WAVE); volatile FA_LAS float* li_l = ws; volatile FA_LAS float* al_l = ws + 32; volatile FA_LAS float* g1_l = ws + 64; volatile FA_LAS float* g2_l = ws + 96;
    FA_LAS float* impw = (FA_LAS float*)(lds + NSA_OFF_IMP + wid * 8192);
    FA_LAS unsigned* selw = (FA_LAS unsigned*)(lds + NSA_OFF_SEL + wid * 256);
    FA_LAS unsigned* uni = (FA_LAS unsigned*)(lds + NSA_OFF_UNI);
    FA_LAS int* blist = (FA_LAS int*)(lds + NSA_OFF_LIST);
    const int vb0 = (int)(unsigned)(uintptr_t)V_lds + v_rd_base(lane);
    const DmaOff dof = dma_offsets(wid, lane);
    bf16x8 qr[8];
#pragma unroll
    for (int d0 = 0; d0 < 8; ++d0) qr[d0] = *(const bf16x8*)(a.QA + ((size_t)(b * 8 + head) * T + tq) * D + d0 * 16 + hi * 8);
    if (tid < 16) uni[tid] = 0u;
    const bf16* Kc = a.kc + (size_t)bg * 1024 * D; const bf16* Vc = a.vc + (size_t)bg * 1024 * D;
    const int n_ct = ((t0 + 32) >> 10) + 1;
    const int cvis = tq >= 31 ? ((tq - 31) >> 4) : -1;
#define FA_DMA_KT(P, kb0, bf) dma_k((const char*)(P) + (size_t)(kb0) * (D * 2), lds + OFF_K + (bf) * SHM_K, wid, dof)
#define FA_DMA_VT(P, kb0, bf) dma_v((const char*)(P) + (size_t)(kb0) * (D * 2), lds + OFF_V + (bf) * SHM_V, wid, dof)
    float m_reg = -1e30f, l_reg = 0.f;
    FA_DMA_KT(Kc, 0, 0);
    FA_DMA_SYNC();
    for (int j = 0; j < n_ct; ++j) {
        const int buf = j & 1;
        if (j + 1 < n_ct) FA_DMA_KT(Kc, (j + 1) * 64, buf ^ 1);
        { f32x16 p0, p1; float mn, alpha; bf16x8 pa0, pa1, pa2, pa3;
          qkt(p0, p1, K_lds + buf * SHM_K, r32, hi, qr);
          mask_gt(p0, p1, cvis - j * 64, hi);
          partialSM(p0, p1, m_reg, mn, alpha);
          finishSM(p0, p1, alpha, l_reg, pa0, pa1, pa2, pa3); }
        FA_DMA_SYNC();
    }
    const float inv_l = l_reg > 0.f ? 1.0f / l_reg : 0.f, mnL = -m_reg * C2;
    f32x16 o[4] = {};
    float carry = 0.f;
    FA_DMA_KT(Kc, 0, 0); FA_DMA_VT(Vc, 0, 0);
    FA_DMA_SYNC();
    for (int j = 0; j < n_ct; ++j) {
        const int buf = j & 1;
        if (j + 1 < n_ct) { FA_DMA_KT(Kc, (j + 1) * 64, buf ^ 1); FA_DMA_VT(Vc, (j + 1) * 64, buf ^ 1); }
        { f32x16 p0, p1; bf16x8 pa0, pa1, pa2, pa3;
          qkt(p0, p1, K_lds + buf * SHM_K, r32, hi, qr);
          mask_gt(p0, p1, cvis - j * 64, hi);
#pragma unroll
          for (int r = 0; r < 16; ++r) { p0[r] = __builtin_amdgcn_exp2f(fmaf(p0[r], C2, mnL)) * inv_l; p1[r] = __builtin_amdgcn_exp2f(fmaf(p1[r], C2, mnL)) * inv_l; }
          float Av[8], Xv[8];
#pragma unroll
          for (int i = 0; i < 4; ++i) { Av[i] = (p0[4 * i] + p0[4 * i + 1]) + (p0[4 * i + 2] + 0.5f * p0[4 * i + 3]); Xv[i] = 0.5f * p0[4 * i + 3];
                                        Av[4 + i] = (p1[4 * i] + p1[4 * i + 1]) + (p1[4 * i + 2] + 0.5f * p1[4 * i + 3]); Xv[4 + i] = 0.5f * p1[4 * i + 3]; }
#pragma unroll
          for (int i = 0; i < 8; ++i) Xv[i] = __uint_as_float(x32_u(__float_as_uint(Xv[i]), hi));
#pragma unroll
          for (int i = 0; i < 8; ++i) { float v = Av[i] + (hi ? Xv[i] : (i > 0 ? Xv[i - 1] : carry));
              v += xl_f<8>(v); v += xl_f<16>(v);
              if (r32 < 8) impw[r32 * 256 + 16 * j + 2 * i + hi] = v; }
          carry = Xv[7];
          packP(p0, p1, pa0, pa1, pa2, pa3);
          VPre vf_; pv_issue(vb0 + buf * SHM_V, vf_); pv_tile(o, vb0 + buf * SHM_V, pa0, pa1, pa2, pa3, vf_); }
        FA_DMA_SYNC();
    }
    { const float* gp = a.gates + ((size_t)(b * T + tq)) * 24 + head * 3; if (hi == 0) { li_l[r32] = gp[0]; g1_l[r32] = gp[1]; g2_l[r32] = gp[2]; } }
    asm volatile("s_waitcnt lgkmcnt(0)" ::: "memory");
#pragma unroll
    for (int r = 0; r < 16; ++r) { const int rho = crow(r, hi); const float gc = li_l[rho];
        const size_t trow = (size_t)(b * T + t0 + 8 * wid + (rho & 7)); const int hh = g * 4 + (rho >> 3);
        bf16* Ow = a.ocat + trow * 2048 + hh * 128;
#pragma unroll
        for (int dp = 0; dp < 2; ++dp) {
            const float va = o[2 * dp][r] * gc, vb = o[2 * dp + 1][r] * gc, xa = xl_f<1>(va), xb = xl_f<1>(vb);
            const bool odd = (r32 & 1) != 0; const unsigned w = cvtpk(odd ? xb : va, odd ? vb : xa); const int co = (2 * dp + (r32 & 1)) * 32 + (r32 & ~1);
            if (!a.dry) *(unsigned*)(Ow + co) = w;
            if (a.dbg_stash) *(unsigned*)(a.dbg_stash + trow * 1024 + hh * 128 + co) = w; } }
    asm volatile("s_waitcnt lgkmcnt(0)" ::: "memory");
    unsigned selbits = 0u;
    { const int qq8 = lane >> 3, sub = lane & 7;
      if (cur + 1 <= 16) { selbits = (sub == 0) ? ((cur + 1 >= 32) ? 0xffffffffu : ((1u << (cur + 1)) - 1u)) : 0u; }
      else {
        float v[32];
#pragma unroll
        for (int i4 = 0; i4 < 8; ++i4) { const f32x4 x = *(const FA_LAS f32x4*)(impw + qq8 * 256 + sub * 32 + i4 * 4); v[4 * i4] = x[0]; v[4 * i4 + 1] = x[1]; v[4 * i4 + 2] = x[2]; v[4 * i4 + 3] = x[3]; }
#pragma unroll
        for (int i = 0; i < 32; ++i) { const int n = sub * 32 + i; v[i] = (n == 0 || n == cur || n == cur - 1) ? __builtin_inff() : (n <= cur ? v[i] : -__builtin_inff()); }
        for (int round = 0; round < 16; ++round) {
            float bv = -__builtin_inff(); int bn = sub * 32;
#pragma unroll
            for (int i = 0; i < 32; ++i) { const bool take = (((selbits >> i) & 1u) == 0u) && (v[i] > bv); bv = take ? v[i] : bv; bn = take ? sub * 32 + i : bn; }
#define TOPK_STEP(S_) do { const float ov = xl_f<S_>(bv); const int on = (int)xl_u<S_>((unsigned)bn); const bool better = (ov > bv) || (ov == bv && on < bn); bv = better ? ov : bv; bn = better ? on : bn; } while (0)
            TOPK_STEP(1); TOPK_STEP(2); TOPK_STEP(4);
#undef TOPK_STEP
            if ((bn >> 5) == sub) selbits |= 1u << (bn & 31);
        }
      }
      selw[qq8 * 8 + sub] = selbits; if (a.dbg_sel) a.dbg_sel[((size_t)bg * T + t0 + 8 * wid + qq8) * 8 + sub] = selbits; }
    if (a.dry == 1) { __syncthreads(); return; }
    unsigned wh = selbits; wh |= xl_u<8>(wh); wh |= xl_u<16>(wh);
    unsigned wuni = x32_or(wh);
    FA_LAS unsigned* wun = (FA_LAS unsigned*)(lds + NSA_OFF_WUN); FA_LAS unsigned char* am = (FA_LAS unsigned char*)(lds + NSA_OFF_AM);
    if (lane < 8) { __hip_atomic_fetch_or(uni + lane, wuni, __ATOMIC_RELAXED, __HIP_MEMORY_SCOPE_WORKGROUP); wun[wid * 8 + lane] = wuni; }
    __syncthreads();
    { unsigned w8[8]; int tot = 0;
#pragma unroll
      for (int k = 0; k < 8; ++k) w8[k] = uni[k];
#pragma unroll
      for (int k = 0; k < 8; ++k) tot += __popc(w8[k]);
      const bool greedy = cur + 1 >= 150;
      if (tid < 256) { const int n = tid; int pos = 0; unsigned mine = 0, msk = 0;
#pragma unroll
          for (int k = 0; k < 8; ++k) { if (k < (n >> 5)) pos += __popc(w8[k]); if (k == (n >> 5)) mine = w8[k]; }
#pragma unroll
          for (int w = 0; w < 8; ++w) msk |= ((wun[w * 8 + (n >> 5)] >> (n & 31)) & 1u) << w;
          am[n] = (unsigned char)msk;
          if (!greedy && ((mine >> (n & 31)) & 1u)) { pos += __popc(mine & ((1u << (n & 31)) - 1u)); blist[pos] = n; } }
      if (!greedy) { if (tid == 0) { uni[8] = (unsigned)((tot + 1) >> 1); if (tot & 1) blist[tot] = -1; } }
      __syncthreads();
      if (greedy && wid == 0) {
          const unsigned m4 = ((const FA_LAS unsigned*)am)[lane];
          unsigned alive = ((m4 & 0xffu) ? 1u : 0u) | ((m4 & 0xff00u) ? 2u : 0u) | ((m4 & 0xff0000u) ? 4u : 0u) | ((m4 & 0xff000000u) ? 8u : 0u);
          int np = 0;
          for (;;) {
              const unsigned long long bal = __ballot(alive != 0u); if (bal == 0ull) break;
              const int Lx = __builtin_ctzll(bal); const int fj = alive ? __builtin_ctz(alive) : 0;
              const unsigned mx = (unsigned)__builtin_amdgcn_readlane((int)((m4 >> (8 * fj)) & 0xffu), Lx); const int nx = __builtin_amdgcn_readlane(4 * lane + fj, Lx);
              if (lane == Lx) alive &= ~(1u << fj);
              unsigned cand = 0u;
#pragma unroll
              for (int j = 0; j < 4; ++j) if (((alive >> j) & 1u) && ((((m4 >> (8 * j)) & 0xffu) & mx) == 0u)) cand |= 1u << j;
              unsigned long long bal2 = __ballot(cand != 0u); unsigned pick = cand;
              if (bal2 == 0ull) { bal2 = __ballot(alive != 0u); pick = alive; }
              int ny = -1;
              if (bal2 != 0ull) { const int Ly = __builtin_ctzll(bal2); const int cj = pick ? __builtin_ctz(pick) : 0; ny = __builtin_amdgcn_readlane(4 * lane + cj, Ly); if (lane == Ly) alive &= ~(1u << cj); }
              if (lane == 0) { blist[2 * np] = nx; blist[2 * np + 1] = ny; }
              ++np; }
          if (lane == 0) uni[8] = (unsigned)np; } }
    __syncthreads();
    const int npair = __builtin_amdgcn_readfirstlane((int)uni[8]);
    const bf16* Ks = a.KA + (size_t)(b * 6 + 2 + g) * T * D; const bf16* Vs = a.VA + (size_t)(b * 6 + 2 + g) * T * D;
    const int n16 = lane & 15, g4 = lane >> 4;
    bf16x8 qh[2][4];
#pragma unroll
    for (int hf = 0; hf < 2; ++hf)
#pragma unroll
        for (int ks = 0; ks < 4; ++ks) qh[hf][ks] = *(const bf16x8*)(a.QA + ((size_t)(b * 8 + g * 4 + (n16 >> 2)) * T + (t0 + 8 * wid + 4 * hf + (n16 & 3))) * D + ks * 32 + 8 * g4);
    float m_h[2] = {-1e30f, -1e30f}, l_h[2] = {0.f, 0.f};
    f32x4 oh[2][8];
#pragma unroll
    for (int hf = 0; hf < 2; ++hf)
#pragma unroll
        for (int db = 0; db < 8; ++db) oh[hf][db] = f32x4{0.f, 0.f, 0.f, 0.f};
    const int kx = ((g4 * 16) ^ ((n16 & 7) << 4)), kt0 = (int)(unsigned)(uintptr_t)K_lds + n16 * 256, ka0 = kt0 + kx, ka1 = kt0 + (kx ^ 64);
    const int vb16 = (int)(unsigned)(uintptr_t)V_lds + v16_rd_base(lane);
#define FA_DMA_BLK(n_, off_) do { const char* kb_ = (const char*)Ks + (size_t)(n_) * 64 * (D * 2); const char* vb_ = (const char*)Vs + (size_t)(n_) * 64 * (D * 2); \
        dma_k(kb_, lds + (off_) + OFF_K, wid, dof); dma_v(vb_, lds + (off_) + OFF_V, wid, dof); } while (0)
#define FA_SEL_HALF(hf, n_, off_) do { const unsigned hword = (unsigned)__builtin_amdgcn_readlane((int)wh, (hf) * 32 + ((n_) >> 5)); \
        if ((hword >> ((n_) & 31)) & 1u) { f32x4 s[4]; float mn, alpha; bf16x8 pa0, pa1; \
            qk16(s, ka0 + (off_), ka1 + (off_), qh[hf]); VPre vf_; pv16_issue(vb16 + (off_), vf_); \
            const unsigned myw = selw[(4 * (hf) + (n16 & 3)) * 8 + ((n_) >> 5)]; \
            const bool rowsel = ((myw >> ((n_) & 31)) & 1u) != 0u;                          \
            if ((n_) == cur) { const int lim = 8 * wid + 4 * (hf) + (n16 & 3);               \
                _Pragma("unroll") for (int mb = 0; mb < 4; ++mb) _Pragma("unroll") for (int j = 0; j < 4; ++j) if (mb * 16 + 4 * g4 + j > lim) s[mb][j] = -__builtin_inff(); } \
            sm16_max(s, m_h[hf], mn, alpha); rescale16(oh[hf], alpha, l_h[hf], al_l + 16 * (hf), n16, g4); sm16_fin(s, mn, alpha, rowsel, l_h[hf], pa0, pa1); \
            pv16(oh[hf], vb16 + (off_), pa0, pa1, vf_); } } while (0)
#define FA_SEL_TILE(n_, off_) do { FA_SEL_HALF(0, n_, off_); FA_SEL_HALF(1, n_, off_); } while (0)
    int na = __builtin_amdgcn_readfirstlane(blist[0]), nb = __builtin_amdgcn_readfirstlane(blist[1]);
    FA_DMA_BLK(na, 0); FA_DMA_BLK(nb >= 0 ? nb : na, SHM_K);
    FA_DMA_SYNC();
    for (int ip = 0; ip < npair; ++ip) {
        const int so = (ip & 1) * SLOT; int ma = na, mb = nb;
        if (ip + 1 < npair) { ma = __builtin_amdgcn_readfirstlane(blist[2 * ip + 2]); mb = __builtin_amdgcn_readfirstlane(blist[2 * ip + 3]); if (a.dry != 2) { FA_DMA_BLK(ma, so ^ SLOT); FA_DMA_BLK(mb >= 0 ? mb : ma, (so ^ SLOT) + SHM_K); } }
        if (a.dry != 3) { FA_SEL_TILE(na, so);
        if (nb >= 0) FA_SEL_TILE(nb, so + SHM_K); }
        na = ma; nb = mb;
        FA_DMA_SYNC();
    }
#undef FA_DMA_BLK
#undef FA_SEL_TILE
#undef FA_SEL_HALF
#undef FA_DMA_KT
#undef FA_DMA_VT
    if (a.dry) { asm volatile("" :: "v"(oh[0][0]), "v"(oh[0][7]), "v"(oh[1][0]), "v"(oh[1][7]), "v"(l_h[0]), "v"(l_h[1])); __syncthreads(); return; }
    if (g4 == 0) {
#pragma unroll
        for (int hf = 0; hf < 2; ++hf) { const int rho = (n16 >> 2) * 8 + 4 * hf + (n16 & 3); li_l[rho] = l_h[hf] > 0.f ? g1_l[rho] / l_h[hf] : 0.f; } }
    asm volatile("s_waitcnt lgkmcnt(0)" ::: "memory");
    { unsigned oldw[2][4][4], winw[2][4][4];
#pragma unroll
      for (int hf = 0; hf < 2; ++hf)
#pragma unroll
        for (int j = 0; j < 4; ++j) { const int m = 4 * g4 + j; const size_t trow = (size_t)(b * T + t0 + 8 * wid + 4 * hf + (m & 3)); const int hh = g * 4 + (m >> 2);
#pragma unroll
          for (int k = 0; k < 4; ++k) { const int co = (2 * k + (n16 & 1)) * 16 + (n16 & ~1); oldw[hf][k][j] = *(const unsigned*)(a.ocat + trow * 2048 + hh * 128 + co); winw[hf][k][j] = *(const unsigned*)(a.owin + trow * 1024 + hh * 128 + co); } }
#pragma unroll
      for (int hf = 0; hf < 2; ++hf)
#pragma unroll
        for (int j = 0; j < 4; ++j) { const int m = 4 * g4 + j, rho = (m >> 2) * 8 + 4 * hf + (m & 3); const float cs = li_l[rho], gw = g2_l[rho];
          const size_t trow = (size_t)(b * T + t0 + 8 * wid + 4 * hf + (m & 3)); const int hh = g * 4 + (m >> 2);
#pragma unroll
          for (int k = 0; k < 4; ++k) { const float va = oh[hf][2 * k][j] * cs, vb = oh[hf][2 * k + 1][j] * cs, xa = xl_f<1>(va), xb = xl_f<1>(vb);
              const bool odd = (n16 & 1) != 0; const unsigned old = oldw[hf][k][j], wv = winw[hf][k][j];
              const float x0 = (odd ? xb : va) + __uint_as_float(old << 16) + gw * __uint_as_float(wv << 16), x1 = (odd ? vb : xa) + __uint_as_float(old & 0xffff0000u) + gw * __uint_as_float(wv & 0xffff0000u);
              *(unsigned*)(a.ocat + trow * 2048 + hh * 128 + (2 * k + (n16 & 1)) * 16 + (n16 & ~1)) = cvtpk(x0, x1); } } }
    asm volatile("s_waitcnt lgkmcnt(0)" ::: "memory");
    __syncthreads();
}

__device__ __forceinline__ void compress_task(FA_LAS char* lds, const bf16* src  , const float* pe, const bf16* w1t  , const bf16* w2t  , bf16* dst  , int rb) {
    int tid_ = threadIdx.x; asm volatile("" : "+v"(tid_));
    const int tid = tid_, wid = __builtin_amdgcn_readfirstlane(tid >> 6), lane = tid & 63, r32 = lane & 31, hi = lane >> 5;
    const int m0 = rb * 32, bg = m0 >> 10, c0 = m0 & 1023, b = bg >> 1, g = bg & 1;
    const bf16* arow = src + (size_t)(b * 6 + g) * T * D + (size_t)(c0 + r32) * 2048;
    f32x16 acc[4] = {};
    const int kbeg = wid * 512;
#pragma unroll 4
    for (int ks = 0; ks < 32; ++ks) { const int k = kbeg + ks * 16 + hi * 8;
        const bf16x8 raw = *(const bf16x8*)(arow + k); const f32x4 pe0 = *(const f32x4*)(pe + k), pe1 = *(const f32x4*)(pe + k + 4);
        u32x4 w; w.x = cvtpk(bf2f((unsigned short)raw[0]) + pe0[0], bf2f((unsigned short)raw[1]) + pe0[1]); w.y = cvtpk(bf2f((unsigned short)raw[2]) + pe0[2], bf2f((unsigned short)raw[3]) + pe0[3]);
        w.z = cvtpk(bf2f((unsigned short)raw[4]) + pe1[0], bf2f((unsigned short)raw[5]) + pe1[1]); w.w = cvtpk(bf2f((unsigned short)raw[6]) + pe1[2], bf2f((unsigned short)raw[7]) + pe1[3]);
        const bf16x8 af = *reinterpret_cast<bf16x8*>(&w);
#pragma unroll
        for (int nt = 0; nt < 4; ++nt) { const bf16x8 bfr = *(const bf16x8*)(w1t + (size_t)(nt * 32 + r32) * 4096 + k); acc[nt] = __builtin_amdgcn_mfma_f32_32x32x16_bf16(af, bfr, acc[nt], 0, 0, 0); } }
    FA_LAS float* part = (FA_LAS float*)lds;
#pragma unroll
    for (int nt = 0; nt < 4; ++nt)
#pragma unroll
        for (int r = 0; r < 16; ++r) part[wid * 4096 + crow(r, hi) * 128 + nt * 32 + r32] = acc[nt][r];
    __syncthreads();
    FA_LAS bf16* G = (FA_LAS bf16*)(lds + 131072);
    { const int e = tid * 8, m = e >> 7, n = e & 127; f32x4 s0 = {0.f, 0.f, 0.f, 0.f}, s1 = {0.f, 0.f, 0.f, 0.f};
#pragma unroll
      for (int w = 0; w < 8; ++w) { s0 += *(const FA_LAS f32x4*)(part + w * 4096 + e); s1 += *(const FA_LAS f32x4*)(part + w * 4096 + e + 4); }
      float x[8] = {s0[0], s0[1], s0[2], s0[3], s1[0], s1[1], s1[2], s1[3]};
#pragma unroll
      for (int j = 0; j < 8; ++j) { const float u = 0.7978845608028654f * (x[j] + 0.044715f * x[j] * x[j] * x[j]); const float th = 1.0f - 2.0f / (__expf(2.0f * u) + 1.0f); x[j] = 0.5f * x[j] * (1.0f + th); }
      u32x4 w; w.x = cvtpk(x[0], x[1]); w.y = cvtpk(x[2], x[3]); w.z = cvtpk(x[4], x[5]); w.w = cvtpk(x[6], x[7]);
      *(FA_LAS u32x4*)(G + m * 136 + n) = w; }
    __syncthreads();
    if (wid < 4) { f32x16 c = {};
#pragma unroll
        for (int ks = 0; ks < 8; ++ks) { const bf16x8 af = *(const FA_LAS bf16x8*)(G + r32 * 136 + ks * 16 + hi * 8); const bf16x8 bfr = *(const bf16x8*)(w2t + (size_t)(wid * 32 + r32) * 128 + ks * 16 + hi * 8);
            c = __builtin_amdgcn_mfma_f32_32x32x16_bf16(af, bfr, c, 0, 0, 0); }
#pragma unroll
        for (int r = 0; r < 16; ++r) { const float v = c[r], vn = xl_f<1>(v);
            if ((r32 & 1) == 0) *(unsigned*)(dst + (size_t)(m0 + crow(r, hi)) * 128 + wid * 32 + r32) = cvtpk(v, vn); } }
    __syncthreads();
}

__device__ __forceinline__ void gate_task(const unsigned char* x8, const unsigned char* wg8, float* gates, float dq, int row0) {
    typedef int v8i_ __attribute__((ext_vector_type(8)));
    int tid_ = threadIdx.x; asm volatile("" : "+v"(tid_));
    const int tid = tid_, wid = __builtin_amdgcn_readfirstlane(tid >> 6), lane = tid & 63, i16 = lane & 15, g = lane >> 4;
    { const int r0 = row0 + wid * 16;
        f32x4 c0 = {0.f, 0.f, 0.f, 0.f}, c1 = {0.f, 0.f, 0.f, 0.f};
        const unsigned char* ap = x8 + (size_t)(r0 + i16) * 2048 + 32 * g; const unsigned char* bp0 = wg8 + (size_t)i16 * 2048 + 32 * g; const unsigned char* bp1 = wg8 + (size_t)(16 + (i16 & 7)) * 2048 + 32 * g;
#pragma unroll 4
        for (int ks = 0; ks < 16; ++ks) { const v8i_ a = *(const v8i_*)(ap + ks * 128), b0 = *(const v8i_*)(bp0 + ks * 128), b1 = *(const v8i_*)(bp1 + ks * 128);
            c0 = __builtin_amdgcn_mfma_scale_f32_16x16x128_f8f6f4(a, b0, c0, 0, 0, 0, 0, 0, 0); c1 = __builtin_amdgcn_mfma_scale_f32_16x16x128_f8f6f4(a, b1, c1, 0, 0, 0, 0, 0, 0); }
#pragma unroll
        for (int j = 0; j < 4; ++j) { float* gp = gates + (size_t)(r0 + 4 * g + j) * 24; gp[i16] = __builtin_amdgcn_rcpf(1.0f + __expf(-c0[j] * dq)); if (i16 < 8) gp[16 + i16] = __builtin_amdgcn_rcpf(1.0f + __expf(-c1[j] * dq)); } }
}
#undef FA_PK4
#undef KSWZ
#undef SBAR
}

#ifndef DBG
#define DBG 0
#endif
#if DBG
#ifndef DBG_A
#define DBG_A 0
#endif
#ifndef DBG_B
#define DBG_B 1
#endif
namespace dbg {
constexpr int CW_DBG = 131072;
constexpr size_t WS_STASH = WS_END;
constexpr size_t WS_SELD = WS_STASH + 64 * MiB;
constexpr size_t WS_ODD = WS_SELD + 4 * MiB;
typedef unsigned short bf16;
__device__ __forceinline__ float b2f(bf16 b) { return __uint_as_float(((unsigned)b) << 16); }
__device__ __forceinline__ float blk_max(float v, LAS float* red) { const int tid = threadIdx.x; red[tid] = v; __syncthreads();
    for (int s = 256; s > 0; s >>= 1) { if (tid < s) red[tid] = fmaxf(red[tid], red[tid + s]); __syncthreads(); } const float r = red[0]; __syncthreads(); return r; }
__device__ __forceinline__ float blk_sum(float v, LAS float* red) { const int tid = threadIdx.x; red[tid] = v; __syncthreads();
    for (int s = 256; s > 0; s >>= 1) { if (tid < s) red[tid] += red[tid + s]; __syncthreads(); } const float r = red[0]; __syncthreads(); return r; }
__device__ __forceinline__ float dot128(const bf16* a, const bf16* b) { float s = 0.f; for (int d = 0; d < 128; ++d) s += b2f(a[d]) * b2f(b[d]); return s; }
__device__ __forceinline__ void naive_attn(const bf16* q, const bf16* Kseq, const bf16* Vseq, const LAS int* klist, int n, float extra, LAS float* sc, LAS float* red, LAS float* o, LAS float* ml) {
    const int tid = threadIdx.x; float mx = extra;
    for (int i = tid; i < n; i += 512) { const float s = dot128(q, Kseq + (size_t)klist[i] * 128) * 0.08838834764831845f; sc[i] = s; mx = fmaxf(mx, s); }
    const float m = blk_max(mx, red); float ls = 0.f;
    for (int i = tid; i < n; i += 512) { const float p = __expf(sc[i] - m); sc[i] = p; ls += p; }
    float l = blk_sum(ls, red); if (extra > -1e30f) l += __expf(extra - m);
    if (tid < 128) { float a = 0.f; for (int i = 0; i < n; ++i) a += sc[i] * b2f(Vseq[(size_t)klist[i] * 128 + tid]); o[tid] = l > 0.f ? a / l : 0.f; }
    if (tid == 0) { ml[0] = m; ml[1] = l; }
    __syncthreads();
}
__device__ __forceinline__ void cmp128(const LAS float* nv, const bf16* fast, unsigned* errw, int k, LAS float* red) {
    const int tid = threadIdx.x; float d = 0.f, a = 0.f; if (tid < 128) { d = fabsf(nv[tid] - b2f(fast[tid])); a = fabsf(nv[tid]); }
    const float dm = blk_max(d, red), am = blk_max(a, red);
    if (tid == 0) atomicMax(errw + k, __float_as_uint(dm / fmaxf(am, 1e-20f)));
}
__constant__ int dbg_tt[16] = {0, 7, 30, 31, 63, 64, 200, 1000, 1023, 1024, 1031, 2500, 5000, 9999, 12345, 16383};
__device__ __forceinline__ int sample_t(int s) { return dbg_tt[s]; }
constexpr int NS = 32;

__device__ __forceinline__ void check_even(unsigned char* ws, const float* sinks, const float* pe_k, const float* ck_w1, const float* ck_w2, LAS unsigned char* lds) {
    unsigned* errw = (unsigned*)(ws + WS_CTL) + CW_DBG; const int tid = threadIdx.x;
    LAS float* sc = (LAS float*)lds; LAS float* red = sc + 1024; LAS float* o = red + 512; LAS float* ml = o + 128; LAS int* klist = (LAS int*)(ml + 8);
    LAS float* pc = (LAS float*)(klist + 1024);
    LAS float* imp = pc + 4096; LAS float* ocmp = imp + 256; LAS float* oslc = ocmp + 4 * 128; LAS float* oslc2 = oslc + 4 * 128; LAS float* owin = oslc2 + 4 * 128; LAS int* seln = (LAS int*)(owin + 4 * 128); LAS int* self = seln + 256;
    LAS float* mix = (LAS float*)(self + 256);
    const bf16* QA = (const bf16*)(ws + WS_R + R_QA); const bf16* KA = (const bf16*)(ws + WS_R + R_KA); const bf16* VA = (const bf16*)(ws + WS_R + R_VA);
    const bf16* QB = (const bf16*)(ws + WS_R + R_QB); const bf16* KB = (const bf16*)(ws + WS_R + R_KB); const bf16* VB = (const bf16*)(ws + WS_R + R_VB);
    const bf16* kc = (const bf16*)(ws + WS_KC); const bf16* vc = (const bf16*)(ws + WS_VC); const float* gates = (const float*)(ws + WS_GATES);
    const bf16* OC = (const bf16*)(ws + WS_O); const bf16* OWIN = (const bf16*)(ws + WS_OWIN); const bf16* STASH = (const bf16*)(ws + WS_STASH); const unsigned* SELD = (const unsigned*)(ws + WS_SELD);
    for (int s = blockIdx.x; s < NS; s += gridDim.x) { const int b = s >> 4, t = sample_t(s & 15); const size_t row = (size_t)b * T + t;
        for (int h = 0; h < 8; ++h) { const int n = t + 1 < 128 ? t + 1 : 128; for (int i = tid; i < n; i += 512) klist[i] = t - n + 1 + i; __syncthreads();
            naive_attn(QB + ((size_t)(b * 8 + h) * T + t) * 128, KB + (size_t)(b * 2 + (h >> 2)) * T * 128, VB + (size_t)(b * 2 + (h >> 2)) * T * 128, klist, n, sinks[h], sc, red, o, ml);
            cmp128(o, OC + row * 2048 + (8 + h) * 128, errw, 1, red); }
        for (int g = 0; g < 2; ++g) { const int bg = b * 2 + g; const int cvis = t >= 31 ? ((t - 31) >> 4) : -1, ncv = cvis + 1, cur = t >> 6;
            for (int hh = 0; hh < 4; ++hh) { const int h = g * 4 + hh; const bf16* q = QA + ((size_t)(b * 8 + h) * T + t) * 128;
                { const int n = t + 1 < 512 ? t + 1 : 512; for (int i = tid; i < n; i += 512) klist[i] = t - n + 1 + i; __syncthreads();
                  naive_attn(q, KA + (size_t)(b * 6 + 4 + g) * T * 128, VA + (size_t)(b * 6 + 4 + g) * T * 128, klist, n, -__builtin_inff(), sc, red, o, ml);
                  cmp128(o, OWIN + row * 1024 + h * 128, errw, 0, red); if (tid < 128) owin[hh * 128 + tid] = o[tid]; __syncthreads(); }
                { for (int i = tid; i < ncv; i += 512) klist[i] = i; __syncthreads();
                  naive_attn(q, kc + (size_t)bg * 1024 * 128, vc + (size_t)bg * 1024 * 128, klist, ncv, -__builtin_inff(), sc, red, o, ml);
                  for (int i = tid; i < 1024; i += 512) pc[hh * 1024 + i] = (i < ncv && ml[1] > 0.f) ? sc[i] / ml[1] : 0.f; if (tid < 128) ocmp[hh * 128 + tid] = o[tid]; __syncthreads(); } }
            if (tid < 256) { const int n = tid; float v = 0.f; for (int hh = 0; hh < 4; ++hh) { const LAS float* p = pc + hh * 1024; v += p[4 * n] + p[4 * n + 1] + p[4 * n + 2] + 0.5f * p[4 * n + 3] + (n > 0 ? 0.5f * p[4 * n - 1] : 0.f); }
                imp[n] = (n == 0 || n == cur || n == cur - 1) ? __builtin_inff() : (n <= cur ? v : -__builtin_inff()); }
            __syncthreads();
            if (tid < 256) { const int n = tid; int rank = 0; const float v = imp[n]; for (int m2 = 0; m2 < 256; ++m2) { const float w = imp[m2]; rank += (w > v || (w == v && m2 < n)) ? 1 : 0; }
                seln[n] = (rank < 16 && n <= cur) ? 1 : 0; const unsigned wd = SELD[((size_t)bg * T + t) * 8 + (n >> 5)]; self[n] = ((wd >> (n & 31)) & 1u) ? 1 : 0; }
            __syncthreads();
            { float mism = 0.f; if (tid < 256) mism = (seln[tid] != self[tid]) ? 1.f : 0.f; const float tot = blk_sum(mism, red); if (tid == 0) atomicMax(errw + 2, __float_as_uint(tot)); }
            for (int pass = 0; pass < 2; ++pass) { const LAS int* sel = pass ? self : seln; LAS float* od = pass ? oslc2 : oslc;
                if (tid == 0) { int n = 0; for (int nb = 0; nb < 256; ++nb) if (sel[nb]) for (int k = 0; k < 64; ++k) if (nb * 64 + k <= t) klist[n++] = nb * 64 + k; ((LAS int*)ml)[4] = n; }
                __syncthreads(); const int n = ((LAS int*)ml)[4];
                for (int hh = 0; hh < 4; ++hh) { const int h = g * 4 + hh; naive_attn(QA + ((size_t)(b * 8 + h) * T + t) * 128, KA + (size_t)(b * 6 + 2 + g) * T * 128, VA + (size_t)(b * 6 + 2 + g) * T * 128, klist, n, -__builtin_inff(), sc, red, o, ml);
                    if (tid < 128) od[hh * 128 + tid] = o[tid]; __syncthreads(); } }
            for (int hh = 0; hh < 4; ++hh) { const int h = g * 4 + hh; const float* gp = gates + row * 24 + h * 3;
                if (tid < 128) mix[tid] = gp[0] * ocmp[hh * 128 + tid]; __syncthreads(); cmp128(mix, STASH + row * 1024 + h * 128, errw, 3, red);
                if (tid < 128) mix[tid] = gp[0] * ocmp[hh * 128 + tid] + gp[1] * oslc[hh * 128 + tid] + gp[2] * owin[hh * 128 + tid]; __syncthreads(); cmp128(mix, OC + row * 2048 + h * 128, errw, 4, red);
                if (tid < 128) mix[tid] = gp[0] * ocmp[hh * 128 + tid] + gp[1] * oslc2[hh * 128 + tid] + gp[2] * owin[hh * 128 + tid]; __syncthreads(); cmp128(mix, OC + row * 2048 + h * 128, errw, 5, red); }
        }
        if (t >= 31) { const int c = (t - 31) >> 4; for (int g = 0; g < 2; ++g) { const int bg = b * 2 + g; const bf16* src = KA + (size_t)(b * 6 + g) * T * 128 + (size_t)c * 2048;
            if (tid < 128) { float a = 0.f; for (int k = 0; k < 4096; ++k) a += (b2f(src[k]) + pe_k[k]) * ck_w1[(size_t)k * 128 + tid]; const float u = 0.7978845608028654f * (a + 0.044715f * a * a * a); sc[tid] = 0.5f * a * (1.f + tanhf(u)); }
            __syncthreads();
            if (tid < 128) { float a = 0.f; for (int k = 0; k < 128; ++k) a += sc[k] * ck_w2[k * 128 + tid]; o[tid] = a; } __syncthreads();
            cmp128(o, kc + ((size_t)bg * 1024 + c) * 128, errw, 6, red); } }
    }
}
__device__ __forceinline__ void check_odd(unsigned char* ws, int grp, LAS unsigned char* lds) {
    unsigned* errw = (unsigned*)(ws + WS_CTL) + CW_DBG; const int tid = threadIdx.x;
    LAS float* sc = (LAS float*)lds; LAS float* red = sc + 1024; LAS float* o = red + 512; LAS float* ml = o + 128; LAS int* klist = (LAS int*)(ml + 8); LAS float* mix = (LAS float*)(klist + 1024);
    const bf16* Qg = (const bf16*)(ws + WS_R + R_QG); const bf16* Kg = (const bf16*)(ws + WS_R + R_KG); const bf16* Vg = (const bf16*)(ws + WS_R + R_VG); const bf16* OC = (const bf16*)(ws + WS_O);
    float* OD = (float*)(ws + WS_ODD); const int dsh = 2 * grp, dil = 1 << dsh, Lq = T >> dsh;
    for (int s = blockIdx.x; s < NS; s += gridDim.x) { const int b = s >> 4, t = sample_t(s & 15), c = t & (dil - 1), u = t >> dsh; const size_t row = (size_t)b * T + t;
        for (int h = 0; h < 16; ++h) { const size_t so = ((size_t)(b * 16 + h) * T + (size_t)c * Lq) * 128; const int n = u + 1 < 129 ? u + 1 : 129;
            for (int i = tid; i < n; i += 512) klist[i] = u - n + 1 + i; __syncthreads();
            naive_attn(Qg + so + (size_t)u * 128, Kg + so, Vg + so, klist, n, -__builtin_inff(), sc, red, o, ml);
            float* od = OD + (((size_t)grp * NS + s) * 16 + h) * 132; if (tid < 128) od[tid] = o[tid]; if (tid == 0) od[128] = ml[0] + __logf(ml[1]);
            if (grp == 0) cmp128(o, OC + row * 2048 + h * 128, errw, 7, red);
            if (grp == 2) { __threadfence(); __syncthreads(); const float* o0 = OD + (((size_t)0 * NS + s) * 16 + h) * 132; const float* o1 = OD + (((size_t)1 * NS + s) * 16 + h) * 132;
                const float l0 = o0[128], l1 = o1[128], l2 = ml[0] + __logf(ml[1]), mx = fmaxf(l0, fmaxf(l1, l2)), e0 = __expf(l0 - mx), e1 = __expf(l1 - mx), e2 = __expf(l2 - mx), inv = 1.f / (e0 + e1 + e2);
                if (tid < 128) mix[tid] = (e0 * o0[tid] + e1 * o1[tid] + e2 * o[tid]) * inv; __syncthreads(); cmp128(mix, OC + row * 2048 + h * 128, errw, 8, red); }
            __syncthreads(); }
    }
}
}
#endif

constexpr int NWAVES = 8;
#ifndef MK_PER_PHASE
#define MK_PER_PHASE 0
#endif
constexpr float F8_SX = 32.f, F8_SW = 1024.f;
constexpr int CW_BAR = 4096;
constexpr int LDS_BYTES = 147456, MISC_OFF = LDS_BYTES - 256;
static_assert(fa::ENGINE_BYTES <= MISC_OFF && 131072 + 32 * 136 * 2 <= MISC_OFF && pg8::STAGE_BYTES <= MISC_OFF, "LDS map");

struct Params {
    const float* x; const int* pos; const float* e_w_in; const float* e_w_o; const float* pe_k; const float* pe_v; const float* ck_w1; const float* ck_w2; const float* cv_w1; const float* cv_w2;
    const float* sinks; const float* o_w_in; const float* o_w_o; const float* ln1_g; const float* ln1_b; const float* w1; const float* w2; const float* ln2_g; const float* ln2_b;
    float* out; unsigned char* ws; int ph_lo, ph_hi, li, pad; float inv_freq[64];
};

__device__ __forceinline__ float wave_sum(float v) {
    v += xl_f<1>(v); v += xl_f<2>(v); v += xl_f<4>(v); v += xl_f<8>(v); v += xl_f<16>(v); return x32_sum(v);
}
__device__ __forceinline__ int cphys(int d) { return 32 * ((d >> 4) & 3) + 16 * (d >> 6) + (d & 15); }
__device__ __forceinline__ int dst_row(int kind, int n) {
    if (kind == 0) return n;
    if (kind == 1) return (n & ~127) + cphys(n & 127);
    if (n < 2560) return (n & ~127) + cphys(n & 127);
    if (n < 2584) return 32 * 128 + (n - 2560);
    const int s = n - 2584; return (20 + (s >> 7)) * 128 + cphys(s & 127);
}
__device__ __forceinline__ unsigned pk4_fp8(float a, float b, float c, float d) { unsigned w = 0; w = __builtin_amdgcn_cvt_pk_fp8_f32(a, b, w, false); w = __builtin_amdgcn_cvt_pk_fp8_f32(c, d, w, true); return w; }
struct TrRegs { f32x4 t[8]; };
__device__ __forceinline__ void tr_load(TrRegs& r, const float* W, int K, int N, int item, int lane) {
    const int nblk = (N + 31) / 32, kb = item / nblk, nb = item % nblk, k0 = 64 * kb, n0 = 32 * nb, c4 = (lane & 7) * 4, kr = lane >> 3; const bool okc = (n0 + c4) < N;
#pragma unroll
    for (int i = 0; i < 8; ++i) r.t[i] = okc ? *(const f32x4*)(W + (size_t)(k0 + 8 * i + kr) * N + n0 + c4) : (f32x4){0.f, 0.f, 0.f, 0.f};
}
template <bool F8> __device__ __forceinline__ void tr_store(const TrRegs& r, int K, int N, void* WTv, int kind, float scale, LAS float* scr, int item, int lane) {
    const int nblk = (N + 31) / 32, kb = item / nblk, nb = item % nblk, k0 = 64 * kb, n0 = 32 * nb, c4 = (lane & 7) * 4, kr = lane >> 3;
#pragma unroll
    for (int i = 0; i < 8; ++i) { LAS float* d = scr + (8 * i + kr) * 33 + c4; d[0] = r.t[i].x * scale; d[1] = r.t[i].y * scale; d[2] = r.t[i].z * scale; d[3] = r.t[i].w * scale; }
    asm volatile("s_waitcnt lgkmcnt(0)" ::: "memory");
    const int c = lane & 7;
#pragma unroll
    for (int j = 0; j < 4; ++j) { const int n = (lane >> 3) + 8 * j; const LAS float* s = scr + (8 * c) * 33 + n;
        if (F8) { const unsigned long long o = (unsigned long long)pk4_fp8(s[0 * 33], s[1 * 33], s[2 * 33], s[3 * 33]) | ((unsigned long long)pk4_fp8(s[4 * 33], s[5 * 33], s[6 * 33], s[7 * 33]) << 32);
            if (n0 + n < N) *(unsigned long long*)((unsigned char*)WTv + (size_t)dst_row(kind, n0 + n) * K + k0 + 8 * c) = o; }
        else { v4u o; o.x = pk2(s[0 * 33], s[1 * 33]); o.y = pk2(s[2 * 33], s[3 * 33]); o.z = pk2(s[4 * 33], s[5 * 33]); o.w = pk2(s[6 * 33], s[7 * 33]);
            if (n0 + n < N) *(v4u*)((unsigned short*)WTv + (size_t)dst_row(kind, n0 + n) * K + k0 + 8 * c) = o; } }
    asm volatile("s_waitcnt lgkmcnt(0)" ::: "memory");
}
template <bool F8> __device__ __forceinline__ void convert_matrix_t(const float* W, int K, int N, void* WT, int kind, float scale, LAS float* scr, int gw, int ngw, int lane) {
    const int nitems = (K / 64) * ((N + 31) / 32); if (gw >= nitems) return;
    TrRegs cur, nxt; tr_load(cur, W, K, N, gw, lane);
    for (int it = gw; it < nitems; it += ngw) { const bool more = it + ngw < nitems;
        if (more) tr_load(nxt, W, K, N, it + ngw, lane);
        tr_store<F8>(cur, K, N, WT, kind, scale, scr, it, lane);
        if (more) cur = nxt; }
}
__device__ __forceinline__ void convert_matrix(const float* W, int K, int N, unsigned short* WT, int kind, LAS float* scr, int gw, int ngw, int lane) { convert_matrix_t<false>(W, K, N, WT, kind, 1.0f, scr, gw, ngw, lane); }
__device__ __forceinline__ void convert_matrix_f8(const float* W, int K, int N, unsigned char* WT, int kind, float scale, LAS float* scr, int gw, int ngw, int lane) { convert_matrix_t<true>(W, K, N, WT, kind, scale, scr, gw, ngw, lane); }
template <int R> __device__ __forceinline__ void ln_rows(float* z, unsigned short* xb, unsigned char* xb8  , float* stats, int m0, int rstride, const float* gam, const float* bet, int lane, bool full) {
    f32x4 v[R][8];
#pragma unroll
    for (int r = 0; r < R; ++r) { const f32x4* xr = (const f32x4*)(z + (size_t)(m0 + r * rstride) * DM) + lane;
#pragma unroll
        for (int j = 0; j < 8; ++j) v[r][j] = xr[64 * j]; }
#pragma unroll
    for (int r = 0; r < R; ++r) { const int m = m0 + r * rstride; float s = 0.f;
#pragma unroll
        for (int j = 0; j < 8; ++j) s += (v[r][j].x + v[r][j].y) + (v[r][j].z + v[r][j].w);
        const float mean = wave_sum(s) * (1.f / DM); float s2 = 0.f;
#pragma unroll
        for (int j = 0; j < 8; ++j) { v[r][j] = v[r][j] - mean; s2 += (v[r][j].x * v[r][j].x + v[r][j].y * v[r][j].y) + (v[r][j].z * v[r][j].z + v[r][j].w * v[r][j].w); }
        const float rstd = 1.f / sqrtf(wave_sum(s2) * (1.f / DM) + LN_EPS);
        if (lane == 0) { stats[2 * m] = mean; stats[2 * m + 1] = rstd; }
        f32x4* xw = (f32x4*)(z + (size_t)m * DM) + lane; unsigned long long* o8 = (unsigned long long*)(xb + (size_t)m * DM) + lane; unsigned* o4 = (unsigned*)(xb8 + (size_t)m * DM) + lane;
#pragma unroll
        for (int j = 0; j < 8; ++j) { const f32x4 gm = ((const f32x4*)gam)[lane + 64 * j], bt = ((const f32x4*)bet)[lane + 64 * j]; const f32x4 y = v[r][j] * rstd * gm + bt;
            if (full) xw[64 * j] = y;
            if (xb8) o4[64 * j] = pk4_fp8(y.x * F8_SX, y.y * F8_SX, y.z * F8_SX, y.w * F8_SX); else o8[64 * j] = (unsigned long long)pk2(y.x, y.y) | ((unsigned long long)pk2(y.z, y.w) << 32); } }
}
template <int R> __device__ __forceinline__ void cvt_rows(const float* x, unsigned char* x8, int m0, int rstride, int lane) {
    f32x4 v[R][8];
#pragma unroll
    for (int r = 0; r < R; ++r) { const f32x4* xr = (const f32x4*)(x + (size_t)(m0 + r * rstride) * DM) + lane;
#pragma unroll
        for (int j = 0; j < 8; ++j) v[r][j] = xr[64 * j]; }
#pragma unroll
    for (int r = 0; r < R; ++r) { unsigned* o4 = (unsigned*)(x8 + (size_t)(m0 + r * rstride) * DM) + lane;
#pragma unroll
        for (int j = 0; j < 8; ++j) o4[64 * j] = pk4_fp8(v[r][j].x * F8_SX, v[r][j].y * F8_SX, v[r][j].z * F8_SX, v[r][j].w * F8_SX); }
}
__device__ __forceinline__ void rope_entry(float ang, float& c, float& s) {
    const double a = (double)ang; const double q = rint(a * 0.63661977236758134308); const double y = fma(-q, 1.57079632679489655800, a) - q * 6.12323399573676603587e-17;
    const double y2 = y * y;
    const double sn = y * (1.0 + y2 * (-1.0 / 6 + y2 * (1.0 / 120 + y2 * (-1.0 / 5040 + y2 * (1.0 / 362880 + y2 * (-1.0 / 39916800))))));
    const double cs = 1.0 + y2 * (-0.5 + y2 * (1.0 / 24 + y2 * (-1.0 / 720 + y2 * (1.0 / 40320 + y2 * (-1.0 / 3628800 + y2 * (1.0 / 479001600))))));
    const int qi = ((int)q) & 3;
    const double cc = (qi == 0) ? cs : (qi == 1) ? -sn : (qi == 2) ? -cs : sn;
    const double ss = (qi == 0) ? sn : (qi == 1) ? cs : (qi == 2) ? -sn : -cs;
    c = (float)cc; s = (float)ss;
}

template <class Tp> __device__ __forceinline__ Tp* as_global(Tp* p) { return (Tp*)(GAS Tp*)p; }
#define CAS __attribute__((address_space(4)))
typedef const CAS Params* ParamsPtr;
__device__ __forceinline__ ParamsPtr params_ptr(ParamsPtr kp) { asm volatile("" : "+s"(kp)); return kp; }
__device__ __forceinline__ int opaque_bx() { int v = blockIdx.x; asm volatile("" : "+s"(v)); return v; }
__device__ __forceinline__ int opaque_i(int v) { asm volatile("" : "+s"(v)); return v; }
__device__ __forceinline__ int opaque_g() { int v = gridDim.x; asm volatile("" : "+s"(v)); return v; }
#if DBG
#define DBG_STASH_PTR(ws) ((unsigned short*)((ws) + dbg::WS_STASH))
#define DBG_SEL_PTR(ws) ((unsigned*)((ws) + dbg::WS_SELD))
#else
#define DBG_STASH_PTR(ws) nullptr
#define DBG_SEL_PTR(ws) nullptr
#endif
#ifndef WGM_INPROJ
#define WGM_INPROJ 4
#endif
#ifndef WGM_RESID
#define WGM_RESID 4
#endif
#ifndef WGM_UP
#define WGM_UP 4
#endif
#ifndef REP_MASK
#define REP_MASK 0
#endif
#ifndef DBG_MASK
#define DBG_MASK 0
#endif
#ifndef DBG_LAYER_EVEN
#define DBG_LAYER_EVEN 0
#endif
#ifndef DBG_LAYER_ODD
#define DBG_LAYER_ODD 1
#endif
#ifndef ONLY_PHASE
#define ONLY_PHASE -1
#endif
#define PHASE_ENABLED(k) (ONLY_PHASE < 0 || ONLY_PHASE == (k))

__device__ __forceinline__ void convert_layer(ParamsPtr pp, int L, LAS unsigned char* lds, int gw, int ngw, int lane, int wave) {
    unsigned char* ws = as_global(pp->ws); const int i_ = L >> 1; LAS float* scr = (LAS float*)(lds + wave * 16384);
    unsigned short* Win_t = (unsigned short*)(ws + WS_W + W_WIN); unsigned short* Wo_t = (unsigned short*)(ws + WS_W + W_WO);
    unsigned short* W1_t = (unsigned short*)(ws + WS_W + W_W1); unsigned short* W2_t = (unsigned short*)(ws + WS_W + W_W2);
    if ((L & 1) == 0) { unsigned short* cw = (unsigned short*)(ws + WS_CW);
        convert_matrix_f8(as_global(pp->e_w_in) + (size_t)i_ * DM * EVEN_IN, DM, EVEN_IN, (unsigned char*)Win_t, 2, F8_SW, scr, gw, ngw, lane);
        convert_matrix(as_global(pp->e_w_o) + (size_t)i_ * DM * DM, DM, DM, Wo_t, 0, scr, gw, ngw, lane);
        convert_matrix(as_global(pp->ck_w1) + (size_t)i_ * 4096 * 128, 4096, 128, cw, 0, scr, gw, ngw, lane); convert_matrix(as_global(pp->cv_w1) + (size_t)i_ * 4096 * 128, 4096, 128, cw + 128 * 4096, 0, scr, gw, ngw, lane);
        convert_matrix(as_global(pp->ck_w2) + (size_t)i_ * 128 * 128, 128, 128, cw + 2 * 128 * 4096, 0, scr, gw, ngw, lane); convert_matrix(as_global(pp->cv_w2) + (size_t)i_ * 128 * 128, 128, 128, cw + 2 * 128 * 4096 + 128 * 128, 0, scr, gw, ngw, lane);
    } else {
        convert_matrix_f8(as_global(pp->o_w_in) + (size_t)i_ * DM * ODD_IN, DM, ODD_IN, (unsigned char*)Win_t, 1, F8_SW, scr, gw, ngw, lane);
        convert_matrix(as_global(pp->o_w_o) + (size_t)i_ * DM * DM, DM, DM, Wo_t, 0, scr, gw, ngw, lane); }
    convert_matrix(as_global(pp->w1) + (size_t)L * DM * DFF, DM, DFF, W1_t, 0, scr, gw, ngw, lane);
    convert_matrix(as_global(pp->w2) + (size_t)L * DFF * DM, DFF, DM, W2_t, 0, scr, gw, ngw, lane);
}
__device__ __forceinline__ void phase_prologue(ParamsPtr pp, LAS unsigned char* lds) {
    int tid_ = threadIdx.x; asm volatile("" : "+v"(tid_));
    const int tid = tid_, lane = tid & 63, wave = __builtin_amdgcn_readfirstlane(tid >> 6), G = opaque_g(), bx = opaque_bx(), gw = bx * NWAVES + wave, ngw = G * NWAVES;
    unsigned char* ws = as_global(pp->ws); unsigned* ropet = (unsigned*)(ws + WS_ROPEC); const int* pos = as_global(pp->pos); const float* x = as_global(pp->x);
    for (size_t e = (size_t)bx * 512 + tid; e < (size_t)M * 64; e += (size_t)G * 512) { const int row = (int)(e >> 6), i = (int)(e & 63);
        const float ang = (float)pos[row] * pp->inv_freq[i]; float c, s; rope_entry(ang, c, s);
        ropet[e] = (unsigned)__builtin_bit_cast(unsigned short, (_Float16)c) | ((unsigned)__builtin_bit_cast(unsigned short, (_Float16)s) << 16); }
    if (ngw * 16 == M) { for (int m = gw; m < M; m += 4 * ngw) cvt_rows<4>(x, ws + WS_XB8, m, ngw, lane); }
    else { for (int m = gw; m < M; m += ngw) cvt_rows<1>(x, ws + WS_XB8, m, ngw, lane); }
    convert_layer(pp, 0, lds, gw, ngw, lane, wave);
}
__device__ __forceinline__ void phase_e1(ParamsPtr pp, LAS unsigned char* lds) {
    unsigned char* ws = as_global(pp->ws);
    pg8::Gemm g{(const unsigned short*)(ws + WS_XB8), (const unsigned short*)(ws + WS_W + W_WIN), M, 4096, DM / 2}; pg8::StaticOrder S; S.init(M, 4096, opaque_g(), opaque_bx(), WGM_INPROJ);
    pg8::EpiEven E{ws, 1.0f / (F8_SX * F8_SW)};
    pg8::gemm_phase<pg8::EpiEven, pg8::StaticOrder, true, true, true>(lds, g, S, E);
}
__device__ __forceinline__ fa::BandArgs decode_e2(unsigned char* ws0, const float* sinks, int li, int u0, int G) {
    const int u = (G == 256) ? (u0 & ~255) + ((u0 & 7) << 5) + ((u0 & 255) >> 3) : u0;
    const int kind = u >> 10, r = u & 1023, C = r >> 5, p = r & 31, b = C >> 4, blk = (C & 7) * 8 + (p >> 2), h = ((C >> 3) & 1) * 4 + (p & 3); fa::BandArgs a;
    GAS unsigned char* wsg = (GAS unsigned char*)ws0; asm volatile("" : "+s"(wsg)); unsigned char* ws = (unsigned char*)wsg; unsigned char* R = ws + WS_R;
    if (kind == 0) {
        a.Q = (const unsigned short*)(R + R_QA) + (size_t)(b * 8 + h) * T * 128; a.K = (const unsigned short*)(R + R_KA) + (size_t)(b * 6 + 4 + (h >> 2)) * T * 128; a.V = (const unsigned short*)(R + R_VA) + (size_t)(b * 6 + 4 + (h >> 2)) * T * 128;
        a.O = (unsigned short*)(ws + WS_OWIN) + (size_t)b * T * 1024 + h * 128; a.o_stride = 1024; a.lse = nullptr; a.lse_stride = 0; a.P0 = blk * 256; a.W = 512; a.mode = 0; a.sink = 0.f;
    } else {
        a.Q = (const unsigned short*)(R + R_QB) + (size_t)(b * 8 + h) * T * 128; a.K = (const unsigned short*)(R + R_KB) + (size_t)(b * 2 + (h >> 2)) * T * 128; a.V = (const unsigned short*)(R + R_VB) + (size_t)(b * 2 + (h >> 2)) * T * 128;
        a.O = (unsigned short*)(ws + WS_O) + (size_t)b * T * 2048 + (8 + h) * 128; a.o_stride = 2048; a.lse = nullptr; a.lse_stride = 0; a.P0 = blk * 256; a.W = 128; a.mode = 1; a.sink = sinks[li * 8 + h];
    }
    a.nK = a.K; a.nV = a.V; a.nP0 = a.P0; a.nW = a.W; a.has_next = 0; a.prefetched = 0; a.nQ = a.Q; return a;
}
__device__ __forceinline__ void phase_e2(ParamsPtr pp, int li, LAS unsigned char* lds) {
    unsigned char* const ws0 = as_global(pp->ws); const int G = opaque_g(), bx = opaque_bx();
    for (int gt = bx; gt < 256; gt += G) { GAS unsigned char* wsg = (GAS unsigned char*)ws0; asm volatile("" : "+s"(wsg)); unsigned char* ws = (unsigned char*)wsg;
        fa::gate_task(ws + WS_XB8, ws + WS_W + W_WIN + (size_t)4096 * DM, (float*)(ws + WS_GATES), 1.0f / (F8_SX * F8_SW), gt * 128); }
    for (int ct = bx; ct < 256; ct += G) { const int z = ct >> 7;
        GAS unsigned char* wsg = (GAS unsigned char*)ws0; asm volatile("" : "+s"(wsg)); unsigned char* ws = (unsigned char*)wsg; unsigned char* R = ws + WS_R; unsigned short* cw = (unsigned short*)(ws + WS_CW);
        fa::compress_task((FA_LAS char*)lds, (const unsigned short*)(R + (z ? R_VA : R_KA)), (z ? as_global(pp->pe_v) : as_global(pp->pe_k)) + (size_t)li * 4096, cw + (z ? 128 * 4096 : 0), cw + 2 * 128 * 4096 + (z ? 128 * 128 : 0),
                          (unsigned short*)(ws + (z ? WS_VC : WS_KC)), ct & 127); }
    int pre = 0; fa::QCarry qc;
#pragma unroll
    for (int d0 = 0; d0 < 8; ++d0) qc.q[d0] = fa::bf16x8{};
    for (int u0 = bx; u0 < 2048; u0 += G) { fa::BandArgs a = decode_e2(ws0, as_global(pp->sinks), li, u0, G); const bool hn = u0 + G < 2048;
        if (hn) { const fa::BandArgs n = decode_e2(ws0, as_global(pp->sinks), li, u0 + G, G); a.nK = n.K; a.nV = n.V; a.nP0 = n.P0; a.nW = n.W; a.nQ = n.Q; }
        a.has_next = hn ? 1 : 0; a.prefetched = pre; pre = a.has_next;
        fa::banded_unit((FA_LAS char*)lds, a, qc); }
}
constexpr int CW_NSAQ = 1024;
__device__ __forceinline__ void nsa_run(unsigned char* ws0, LAS unsigned char* lds, int bg, int tile, int dry) {
    GAS unsigned char* wsg = (GAS unsigned char*)ws0; asm volatile("" : "+s"(wsg)); unsigned char* ws = (unsigned char*)wsg; unsigned char* R = ws + WS_R;
    fa::NsaArgs a{(const unsigned short*)(R + R_QA), (const unsigned short*)(R + R_KA), (const unsigned short*)(R + R_VA), (const unsigned short*)(ws + WS_KC), (const unsigned short*)(ws + WS_VC),
                  (const float*)(ws + WS_GATES), (const unsigned short*)(ws + WS_OWIN), (unsigned short*)(ws + WS_O), bg >> 1, bg & 1, tile * 64, DBG_STASH_PTR(ws), DBG_SEL_PTR(ws), dry};
    fa::nsa_unit((FA_LAS char*)lds, a);
}
__device__ __forceinline__ void phase_e3(ParamsPtr pp, int li, LAS unsigned char* lds, int dry = 0) {
    unsigned char* const ws0 = as_global(pp->ws); const int G = opaque_g(), bx = opaque_bx();
    if (dry == 0 && G == 256) {
        const int bg = bx & 3; int tid = threadIdx.x; asm volatile("" : "+v"(tid));
        volatile LAS unsigned* slot = (volatile LAS unsigned*)(lds + MISC_OFF) + 40;
        GAS unsigned* q = (GAS unsigned*)(ws0 + WS_CTL) + CW_NSAQ + li * 64 + bg * 16;
        unsigned mine = 0u; if (tid == 0) mine = __hip_atomic_fetch_add(q, 1u, __ATOMIC_RELAXED, __HIP_MEMORY_SCOPE_AGENT);
        for (;;) {
            if (tid == 0) slot[0] = mine;
            __syncthreads();
            const int u = __builtin_amdgcn_readfirstlane((int)slot[0]);
            if (u >= 256) break;
            if (tid == 0) mine = __hip_atomic_fetch_add(q, 1u, __ATOMIC_RELAXED, __HIP_MEMORY_SCOPE_AGENT);
            nsa_run(ws0, lds, bg, 255 - u, 0); }
        __syncthreads();
        return; }
    for (int i = bx; i < 1024; i += G) { const int r = i >> 8, k = i & 255, bg = k & 3, idx = k >> 2;
        const int tile = (r == 0) ? 255 - idx : (r == 1) ? idx : (r == 2) ? 191 - idx : 64 + idx;
        nsa_run(ws0, lds, bg, tile, dry); }
}
__device__ __forceinline__ void phase_o1(ParamsPtr pp, int grp, LAS unsigned char* lds, bool nullepi = false, int norope_probe = 0) {
    unsigned char* ws = as_global(pp->ws);
    pg8::Gemm g{(const unsigned short*)(ws + WS_XB8), (const unsigned short*)(ws + WS_W + W_WIN + (size_t)grp * ODD_G * DM), M, ODD_G, DM / 2}; pg8::StaticOrder S; S.init(M, ODD_G, opaque_g(), opaque_bx(), WGM_INPROJ);
    pg8::EpiOdd E{ws, 2 * grp, 1.0f / (F8_SX * F8_SW), norope_probe};
#if REP_MASK & 0x1000
    if (nullepi) { pg8::EpiNull E0; pg8::gemm_phase<pg8::EpiNull, pg8::StaticOrder, true, true, true>(lds, g, S, E0); return; }
#endif
    pg8::gemm_phase<pg8::EpiOdd, pg8::StaticOrder, true, true, true>(lds, g, S, E);
}
__device__ __forceinline__ fa::BandArgs decode_o2(unsigned char* ws0, int grp, int u0, int G, bool dry) {
    const int dsh = 2 * grp, dil = 1 << dsh, Lq = T >> dsh, nblk = Lq >> 8;
    const int u = (G == 256) ? (u0 & ~255) + ((u0 & 7) << 5) + ((u0 & 255) >> 3) : u0;
    const int seq = u / nblk, blk = u - seq * nblk, bh = seq >> dsh, c = seq & (dil - 1), b = bh >> 4, h = bh & 15; fa::BandArgs a;
    const size_t so = ((size_t)bh * T + (size_t)c * Lq) * 128;
    GAS unsigned char* wsg = (GAS unsigned char*)ws0; asm volatile("" : "+s"(wsg)); unsigned char* ws = (unsigned char*)wsg; unsigned char* R = ws + WS_R;
    a.Q = (const unsigned short*)(R + R_QG) + so; a.K = (const unsigned short*)(R + R_KG) + so; a.V = (const unsigned short*)(R + R_VG) + so;
    a.O = (unsigned short*)(ws + WS_O) + ((size_t)b * T + c) * 2048 + h * 128; a.o_stride = (size_t)dil * 2048; a.lse = (float*)(ws + WS_LSE) + ((size_t)b * T + c) * 16 + h; a.lse_stride = (size_t)dil * 16;
    a.P0 = blk * 256; a.W = 129; a.mode = grp == 0 ? 2 : 3; a.sink = 0.f;
    if (dry) { a.O = (unsigned short*)(ws + WS_XB) + ((size_t)b * T + c) * 2048 + h * 128; a.lse = (float*)(ws + WS_GATES) + ((size_t)b * T + c) * 16 + h; a.mode = 2; }
    a.nK = a.K; a.nV = a.V; a.nP0 = a.P0; a.nW = a.W; a.has_next = 0; a.prefetched = 0; a.nQ = a.Q; return a;
}
__device__ __forceinline__ void phase_o2(ParamsPtr pp, int grp, LAS unsigned char* lds, bool dry = false) {
    unsigned char* const ws0 = as_global(pp->ws); const int G = opaque_g(), bx = opaque_bx();
    int pre = 0; fa::QCarry qc;
#pragma unroll
    for (int d0 = 0; d0 < 8; ++d0) qc.q[d0] = fa::bf16x8{};
    for (int u0 = bx; u0 < 2048; u0 += G) { fa::BandArgs a = decode_o2(ws0, grp, u0, G, dry); const bool hn = u0 + G < 2048;
        if (hn) { const fa::BandArgs n = decode_o2(ws0, grp, u0 + G, G, dry); a.nK = n.K; a.nV = n.V; a.nP0 = n.P0; a.nW = n.W; a.nQ = n.Q; }
        a.has_next = hn ? 1 : 0; a.prefetched = pre; pre = a.has_next;
        fa::banded_unit((FA_LAS char*)lds, a, qc); }
}
__device__ __forceinline__ void phase_resid_gemm(ParamsPtr pp, int which  , int layer, LAS unsigned char* lds) {
    unsigned char* ws = as_global(pp->ws); float* out = as_global(pp->out);
    pg8::Gemm g{(const unsigned short*)(ws + (which ? WS_R : WS_O)), (const unsigned short*)(ws + WS_W + (which ? W_W2 : W_WO)), M, DM, which ? DFF : DM}; pg8::StaticOrder S; S.init(M, DM, opaque_g(), opaque_bx(), WGM_RESID);
    const bool raw = (which == 0 && layer == 0);
    const float* gam = raw ? nullptr : (which ? as_global(pp->ln1_g) + layer * DM : as_global(pp->ln2_g) + (layer - 1) * DM);
    const float* bet = raw ? nullptr : (which ? as_global(pp->ln1_b) + layer * DM : as_global(pp->ln2_b) + (layer - 1) * DM);
    pg8::EpiResid E{raw ? as_global(pp->x) : out, out, DM, DN_ALPHA, (const float*)(ws + WS_STATS), gam, bet};
    pg8::gemm_phase<pg8::EpiResid, pg8::StaticOrder, true, true>(lds, g, S, E);
}
#if REP_MASK & 0x240
__device__ __forceinline__ void phase_probe_gemm(ParamsPtr pp, int which, LAS unsigned char* lds) {
    unsigned char* ws = as_global(pp->ws);
    pg8::Gemm g{(const unsigned short*)(ws + (which ? WS_R : WS_O)), (const unsigned short*)(ws + WS_W + (which ? W_W2 : W_WO)), M, DM, which ? DFF : DM}; pg8::StaticOrder S; S.init(M, DM, opaque_g(), opaque_bx());
    pg8::EpiRelu2 E{(unsigned short*)(ws + WS_XB), DM};
    pg8::gemm_phase<pg8::EpiRelu2, pg8::StaticOrder, true, true>(lds, g, S, E);
}
#endif
__device__ __forceinline__ void phase_ln(ParamsPtr pp, int which, int layer) {
    int tid_ = threadIdx.x; asm volatile("" : "+v"(tid_));
    const int tid = tid_, lane = tid & 63, wave = __builtin_amdgcn_readfirstlane(tid >> 6), gw = opaque_bx() * NWAVES + wave, ngw = opaque_g() * NWAVES;
    float* out = as_global(pp->out); unsigned short* XB = (unsigned short*)(as_global(pp->ws) + WS_XB); const float* gam = (which ? as_global(pp->ln2_g) : as_global(pp->ln1_g)) + layer * DM; const float* bet = (which ? as_global(pp->ln2_b) : as_global(pp->ln1_b)) + layer * DM;
    unsigned char* XB8 = (which == 1 && layer + 1 < DEPTH) ? as_global(pp->ws) + WS_XB8 : nullptr;
    float* stats = (float*)(as_global(pp->ws) + WS_STATS); const bool full = which == 1 && layer == DEPTH - 1;
    if (ngw * 16 == M) { for (int m = gw; m < M; m += 4 * ngw) ln_rows<4>(out, XB, XB8, stats, m, ngw, gam, bet, lane, full); }
    else { for (int m = gw; m < M; m += ngw) ln_rows<1>(out, XB, XB8, stats, m, ngw, gam, bet, lane, full); }
}
__device__ __forceinline__ void phase_up(ParamsPtr pp, LAS unsigned char* lds, bool nullepi = false) {
    unsigned char* ws = as_global(pp->ws);
    pg8::Gemm g{(const unsigned short*)(ws + WS_XB), (const unsigned short*)(ws + WS_W + W_W1), M, DFF, DM}; pg8::StaticOrder S; S.init(M, DFF, opaque_g(), opaque_bx(), WGM_UP);
    pg8::EpiRelu2 E{(unsigned short*)(ws + WS_R), DFF};
#if REP_MASK & 0x2000
    if (nullepi) { pg8::EpiNull E0; pg8::gemm_phase<pg8::EpiNull, pg8::StaticOrder, true, true>(lds, g, S, E0); return; }
#endif
    pg8::gemm_phase<pg8::EpiRelu2, pg8::StaticOrder, true, true>(lds, g, S, E);
}

#define PH_ON (pc >= lo && pc < hi)
#if DBG
#define T_BEGIN() do { if (blockIdx.x == 0 && threadIdx.x == 0) { const unsigned long long t_ = wall_clock64(); MISC[16] = (unsigned)t_; MISC[17] = (unsigned)(t_ >> 32); } } while (0)
#define T_END(cat) do { if (blockIdx.x == 0 && threadIdx.x == 0) { const unsigned long long t0_ = ((unsigned long long)MISC[17] << 32) | MISC[16]; unsigned* w_ = (unsigned*)(as_global(P.ws) + WS_CTL) + dbg::CW_DBG + 32 + (cat); *w_ += (unsigned)((wall_clock64() - t0_) / 100ull); } } while (0)
#define DBG_BAR() do { XcdBarrier b_ = bar; GAS unsigned* bg_ = (GAS unsigned*)b_.bar; asm volatile("" : "+s"(bg_)); b_.bar = (unsigned*)bg_; xcd_barrier(b_); } while (0)
#else
#define T_BEGIN() do {} while (0)
#define T_END(cat) do {} while (0)
#endif
#define SEAM() do { if (pc >= lo && pc + 1 < hi) { XcdBarrier b_ = bar; GAS unsigned* bg_ = (GAS unsigned*)b_.bar; asm volatile("" : "+s"(bg_)); b_.bar = (unsigned*)bg_; xcd_barrier(b_); if (REP_MASK & 0x4000) xcd_barrier(b_); } ++pc; } while (0)
template <int layer> __device__ __forceinline__ void run_layer(Params& P, ParamsPtr kp, LAS unsigned char* lds, volatile LAS unsigned* MISC, const XcdBarrier& bar, int lo, int hi, int& pc) {
        if ((layer & 1) == 0) {
            T_BEGIN(); if (PH_ON && PHASE_ENABLED(1)) { phase_e1(params_ptr(kp), lds); if (REP_MASK & 2) phase_e1(params_ptr(kp), lds); }
            SEAM(); T_END(1);
            T_BEGIN(); if (PH_ON && PHASE_ENABLED(2)) { phase_e2(params_ptr(kp), layer >> 1, lds); if (REP_MASK & 4) phase_e2(params_ptr(kp), layer >> 1, lds); }
            SEAM(); T_END(2);
            T_BEGIN(); if (PH_ON && PHASE_ENABLED(3)) { phase_e3(params_ptr(kp), layer >> 1, lds); if (REP_MASK & 0x800) phase_e3(params_ptr(kp), layer >> 1, lds, 1); if (REP_MASK & 0x20000) phase_e3(params_ptr(kp), layer >> 1, lds, 2); if (REP_MASK & 0x40000) phase_e3(params_ptr(kp), layer >> 1, lds, 3); if (REP_MASK & 0x80000) phase_e3(params_ptr(kp), layer >> 1, lds, 4); }
            SEAM(); T_END(3);
        } else {
            for (int grp = 0; grp < 3; ++grp) {
                T_BEGIN(); if (PH_ON && PHASE_ENABLED(4)) { phase_o1(params_ptr(kp), grp, lds); if (REP_MASK & 16) phase_o1(params_ptr(kp), grp, lds); if (REP_MASK & 0x1000) phase_o1(params_ptr(kp), grp, lds, true); if (REP_MASK & 0x8000) { phase_o1(params_ptr(kp), grp, lds, false, 1); phase_o1(params_ptr(kp), grp, lds); } if (REP_MASK & 0x10000) { phase_o1(params_ptr(kp), grp, lds, false, 2); phase_o1(params_ptr(kp), grp, lds); } }
                SEAM(); T_END(4);
                T_BEGIN(); if (PH_ON && PHASE_ENABLED(5)) { phase_o2(params_ptr(kp), grp, lds); if (REP_MASK & 32) phase_o2(params_ptr(kp), grp, lds, true); }
                SEAM(); T_END(5);
            }
        }
        T_BEGIN(); if (PH_ON && PHASE_ENABLED(6)) {
#if REP_MASK & 0x40
            phase_probe_gemm(params_ptr(kp), 0, lds);
#endif
            phase_resid_gemm(params_ptr(kp), 0, layer, lds); }
        SEAM(); T_END(6);
        T_BEGIN(); if (PH_ON && PHASE_ENABLED(7)) { phase_ln(params_ptr(kp), 0, layer); if (REP_MASK & 0x80) phase_ln(params_ptr(kp), 0, layer); }
        SEAM(); T_END(7);
        T_BEGIN(); if (PH_ON && PHASE_ENABLED(8)) { phase_up(params_ptr(kp), lds); if (REP_MASK & 256) phase_up(params_ptr(kp), lds); if (REP_MASK & 0x2000) phase_up(params_ptr(kp), lds, true); }
        SEAM(); T_END(8);
        T_BEGIN(); if (PH_ON && PHASE_ENABLED(9)) {
#if REP_MASK & 0x200
            phase_probe_gemm(params_ptr(kp), 1, lds);
#endif
            phase_resid_gemm(params_ptr(kp), 1, layer, lds); }
        SEAM(); T_END(9);
        T_BEGIN(); if (PH_ON && PHASE_ENABLED(10)) {
            phase_ln(params_ptr(kp), 1, layer); if ((REP_MASK & 0x80) && layer + 1 < DEPTH) phase_ln(params_ptr(kp), 1, layer);
            if (layer + 1 < DEPTH) { int tid = threadIdx.x; asm volatile("" : "+v"(tid)); const int wave = __builtin_amdgcn_readfirstlane(tid >> 6); convert_layer(params_ptr(kp), layer + 1, lds, opaque_bx() * NWAVES + wave, opaque_g() * NWAVES, tid & 63, wave);
                if (REP_MASK & 0x400) convert_layer(params_ptr(kp), layer + 1, lds, opaque_bx() * NWAVES + wave, opaque_g() * NWAVES, tid & 63, wave); }
        }
        SEAM(); T_END(10);

}
__global__ void __launch_bounds__(NWAVES * 64, 2) fwd_kernel(Params P) {
    extern __shared__ __attribute__((aligned(16))) unsigned char lds_raw[];
    LAS unsigned char* lds = (LAS unsigned char*)lds_raw;
    volatile LAS unsigned* MISC = (volatile LAS unsigned*)(lds + MISC_OFF);
    ParamsPtr kp = (ParamsPtr)__builtin_amdgcn_kernarg_segment_ptr();
    if (threadIdx.x < 64) MISC[threadIdx.x] = 0u;
    __syncthreads();
    XcdBarrier bar = xcd_barrier_post((unsigned*)(as_global(P.ws) + WS_CTL) + CW_BAR + P.li * XCD_BAR_WORDS, MISC + 8);
    const int lo = P.ph_lo, hi = P.ph_hi; int pc = 0;
    T_BEGIN(); if (PH_ON && PHASE_ENABLED(0)) phase_prologue(params_ptr(kp), lds);
    SEAM(); T_END(0);
    run_layer<0>(P, kp, lds, MISC, bar, lo, hi, pc); run_layer<1>(P, kp, lds, MISC, bar, lo, hi, pc); run_layer<2>(P, kp, lds, MISC, bar, lo, hi, pc); run_layer<3>(P, kp, lds, MISC, bar, lo, hi, pc);
#undef PH_ON
#undef SEAM
}
#if DBG
__global__ void __launch_bounds__(512) dbg_even_kernel(Params P) { extern __shared__ __attribute__((aligned(16))) unsigned char l_[]; const int li_ = DBG_LAYER_EVEN >> 1;
    dbg::check_even(P.ws, P.sinks + li_ * 8, P.pe_k + (size_t)li_ * 4096, P.ck_w1 + (size_t)li_ * 4096 * 128, P.ck_w2 + (size_t)li_ * 128 * 128, (LAS unsigned char*)l_); }
__global__ void __launch_bounds__(512) dbg_odd_kernel(Params P, int grp) { extern __shared__ __attribute__((aligned(16))) unsigned char l_[]; dbg::check_odd(P.ws, grp, (LAS unsigned char*)l_); }
__global__ void __launch_bounds__(512) dbg_report_kernel(Params P) { const unsigned* w_ = (const unsigned*)(P.ws + WS_CTL) + dbg::CW_DBG; float* o_ = P.out;
#if DBG == 1
    unsigned us = 0; for (int c = 0; c < 16; ++c) if ((DBG_MASK >> c) & 1) us += w_[32 + c];
    const float v = 0.1f * rintf((float)us * 1e-2f); for (int i = 1 + blockIdx.x * 512 + threadIdx.x; i <= 100000; i += gridDim.x * 512) o_[i] = v;
#else
    if (blockIdx.x == 0) { const unsigned wa = w_[DBG_A], wb = w_[DBG_B]; const float va = __uint_as_float(wa) * 1e5f, vb = __uint_as_float(wb) * 1e4f;
    for (int i = threadIdx.x; i <= 10000; i += 512) o_[i] = (i == 0) ? va : vb; }
#endif
}
#endif
constexpr int N_PHASES = 1 + 2 * (3 + 5) + 2 * (6 + 5);

extern "C" void kernel_launch(void* const* d_in, const int* in_sizes, int n_in, void* d_out, int out_size, void* d_ws, size_t ws_size, hipStream_t stream) {
    static int grid = 0;
    if (grid == 0) {
        if (n_in != 19 || in_sizes[0] != M * DM || out_size != M * DM || ws_size < WS_END) { fprintf(stderr, "kernel_launch: unexpected problem (n_in %d, in0 %d, out %d, ws %zu < %zu); nothing launched\n", n_in, n_in > 0 ? in_sizes[0] : -1, out_size, ws_size, (size_t)WS_END); grid = -1; return; }
        int dev = 0, cus = 0, per_cu = 0;
        if (hipGetDevice(&dev) != hipSuccess || hipDeviceGetAttribute(&cus, hipDeviceAttributeMultiprocessorCount, dev) != hipSuccess) { grid = -1; return; }
        if (hipFuncSetAttribute((const void*)fwd_kernel, hipFuncAttributeMaxDynamicSharedMemorySize, LDS_BYTES) != hipSuccess) { fprintf(stderr, "kernel_launch: hipFuncSetAttribute failed\n"); grid = -1; return; }
        if (hipOccupancyMaxActiveBlocksPerMultiprocessor(&per_cu, (const void*)fwd_kernel, NWAVES * 64, LDS_BYTES) != hipSuccess || per_cu < 1) { fprintf(stderr, "kernel_launch: occupancy query reports %d workgroups per CU\n", per_cu); }
        (void)hipGetLastError();
        grid = cus;
    }
    if (grid < 0) return;
    if (hipMemsetAsync((char*)d_ws + WS_CTL, 0, CTL_ZERO_BYTES, stream) != hipSuccess) return;
    Params p{};
    p.x = (const float*)d_in[0]; p.pos = (const int*)d_in[1]; p.e_w_in = (const float*)d_in[2]; p.e_w_o = (const float*)d_in[3]; p.pe_k = (const float*)d_in[4]; p.pe_v = (const float*)d_in[5];
    p.ck_w1 = (const float*)d_in[6]; p.ck_w2 = (const float*)d_in[7]; p.cv_w1 = (const float*)d_in[8]; p.cv_w2 = (const float*)d_in[9]; p.sinks = (const float*)d_in[10];
    p.o_w_in = (const float*)d_in[11]; p.o_w_o = (const float*)d_in[12]; p.ln1_g = (const float*)d_in[13]; p.ln1_b = (const float*)d_in[14]; p.w1 = (const float*)d_in[15]; p.w2 = (const float*)d_in[16];
    p.ln2_g = (const float*)d_in[17]; p.ln2_b = (const float*)d_in[18]; p.out = (float*)d_out; p.ws = (unsigned char*)d_ws;
    for (int i = 0; i < 64; ++i) p.inv_freq[i] = (float)pow(10000.0, -(double)(2 * i) / 128.0);
#if DBG == 2
    {
        const int pe_ = 1 + (DBG_LAYER_EVEN / 2) * 19 + 3;
        const int po_ = 1 + (DBG_LAYER_ODD / 2) * 19 + 8;
        int li = 0;
#define RUN_MAIN(a_, b_) do { p.ph_lo = (a_); p.ph_hi = (b_); p.li = li++; hipLaunchKernelGGL(fwd_kernel, dim3(grid), dim3(NWAVES * 64), LDS_BYTES, stream, p); } while (0)
        RUN_MAIN(0, pe_); hipLaunchKernelGGL(dbg_even_kernel, dim3(dbg::NS), dim3(512), 49152, stream, p);
        RUN_MAIN(pe_, po_ + 2); hipLaunchKernelGGL(dbg_odd_kernel, dim3(dbg::NS), dim3(512), 49152, stream, p, 0);
        RUN_MAIN(po_ + 2, po_ + 4); hipLaunchKernelGGL(dbg_odd_kernel, dim3(dbg::NS), dim3(512), 49152, stream, p, 1);
        RUN_MAIN(po_ + 4, po_ + 6); hipLaunchKernelGGL(dbg_odd_kernel, dim3(dbg::NS), dim3(512), 49152, stream, p, 2);
        RUN_MAIN(po_ + 6, N_PHASES);
        hipLaunchKernelGGL(dbg_report_kernel, dim3(1), dim3(512), 0, stream, p);
    }
#elif DBG == 1
    p.ph_lo = 0; p.ph_hi = N_PHASES;
    hipLaunchKernelGGL(fwd_kernel, dim3(grid), dim3(NWAVES * 64), LDS_BYTES, stream, p);
    hipLaunchKernelGGL(dbg_report_kernel, dim3(256), dim3(512), 0, stream, p);
#elif MK_PER_PHASE
    for (int ph = 0; ph < N_PHASES; ++ph) { p.ph_lo = ph; p.ph_hi = ph + 1; hipLaunchKernelGGL(fwd_kernel, dim3(grid), dim3(NWAVES * 64), LDS_BYTES, stream, p); }
#else
    p.ph_lo = 0; p.ph_hi = N_PHASES;
    hipLaunchKernelGGL(fwd_kernel, dim3(grid), dim3(NWAVES * 64), LDS_BYTES, stream, p);
#endif
    const hipError_t le = hipPeekAtLastError();
    if (le != hipSuccess) fprintf(stderr, "kernel_launch: launch failed: %s\n", hipGetErrorName(le));
}
```

```cpp
#include <hip/hip_runtime.h>
#include <cstdio>
#include <cstdint>
#include <cmath>

constexpr int BATCH = 2, T = 16384, DM = 2048, DEPTH = 4, HD = 128, DFF = 8192;
constexpr int M = BATCH * T;
constexpr int EVEN_IN = 4120, EVEN_NPAD = 4352, ODD_IN = 18432, ODD_G = 6144;
constexpr float LN_EPS = 1e-5f;
constexpr float DN_ALPHA = 1.6817928305074290f;

constexpr size_t MiB = 1u << 20;
constexpr size_t WS_CTL = 0, CTL_ZERO_BYTES = 1 * MiB;
constexpr size_t WS_ROPEC = 1 * MiB, WS_ROPES = 9 * MiB;
constexpr size_t WS_GATES = 17 * MiB;
constexpr size_t WS_KC = 20 * MiB, WS_VC = 21 * MiB;
constexpr size_t WS_LSE = 22 * MiB;
constexpr size_t WS_STATS = 30 * MiB;
constexpr size_t WS_CW = 24 * MiB;
constexpr size_t WS_W = 32 * MiB;
constexpr size_t W_WIN = 0, W_WO = (size_t)ODD_IN * DM * 2, W_W1 = W_WO + (size_t)DM * DM * 2, W_W2 = W_W1 + (size_t)DFF * DM * 2, W_END = W_W2 + (size_t)DM * DFF * 2;
constexpr size_t WS_XB = 248 * MiB;
constexpr size_t WS_R = 376 * MiB;
constexpr size_t WS_O = 760 * MiB;
constexpr size_t WS_OWIN = 888 * MiB;
constexpr size_t WS_XB8 = 952 * MiB;
constexpr size_t WS_END = 1016 * MiB;
static_assert(WS_W + W_END <= WS_XB && WS_R + 384 * MiB == WS_O && WS_O + 128 * MiB == WS_OWIN, "d_ws map");
constexpr size_t R_QA = 0, R_KA = 64 * MiB, R_VA = 112 * MiB, R_QB = 160 * MiB, R_KB = 224 * MiB, R_VB = 240 * MiB;
constexpr size_t R_QG = 0, R_KG = 128 * MiB, R_VG = 256 * MiB;


template <int K> __device__ __forceinline__ unsigned xl_u(unsigned v) { return (unsigned)__builtin_amdgcn_ds_swizzle((int)v, (K << 10) | 0x1f); }
template <int K> __device__ __forceinline__ float xl_f(float v) { return __uint_as_float(xl_u<K>(__float_as_uint(v))); }
__device__ __forceinline__ unsigned x32_u(unsigned v, int hi) { auto rr = __builtin_amdgcn_permlane32_swap(v, v, false, false); return hi ? rr[0] : rr[1]; }
__device__ __forceinline__ float x32_sum(float v) { auto rr = __builtin_amdgcn_permlane32_swap(__float_as_uint(v), __float_as_uint(v), false, false); return __uint_as_float(rr[0]) + __uint_as_float(rr[1]); }
__device__ __forceinline__ unsigned x32_or(unsigned v) { auto rr = __builtin_amdgcn_permlane32_swap(v, v, false, false); return rr[0] | rr[1]; }
namespace pg8 {
#define PG8_LAS __attribute__((address_space(3)))
typedef unsigned short bf16_t;
typedef short bf16x8 __attribute__((ext_vector_type(8)));
typedef float f32x4 __attribute__((ext_vector_type(4)));
typedef unsigned u32x4 __attribute__((ext_vector_type(4)));
constexpr int BM = 256, BK = 64, HALF = 128, HTB = HALF * BK * 2  , STAGE_BYTES = 8 * HTB, NXCD = 8, WGM = 8;

__host__ __device__ __forceinline__ int lds_byte(int r, int c) { const int st = (r >> 4) * 2 + (c >> 5), rr = r & 15, cc = c & 31, ob = rr * 64 + cc * 2; return st * 1024 + (ob ^ (((ob >> 9) & 1) << 5)); }
__host__ __device__ __forceinline__ void stage_rc(int b, int& R, int& C) { const int st = b / 1024, sb = b % 1024, swz = sb ^ (((sb >> 9) & 1) << 5); R = (st >> 1) * 16 + swz / 64; C = (st & 1) * 32 + (swz % 64) / 2; }
__host__ __device__ __forceinline__ int perm32(int rho) { const int n = rho >> 4, i = rho & 15; return 8 * (i >> 2) + 4 * n + (i & 3); }

struct Unit { int pm, pn; };
struct Gemm { const bf16_t* A; const bf16_t* Bt; int M, N, K; };

struct StaticOrder {
    int nM, nN, nwg, G, c, wgm;
    __host__ __device__ void init(int M, int N, int G_, int c_, int wgm_ = WGM) { nM = M / BM; nN = N / BM; nwg = nM * nN; G = G_; c = c_; wgm = wgm_; }
    __host__ __device__ bool next(int i, Unit& u) const {
        const long L = (long)i * G + c; if (L >= nwg) return false;
        int wgid = (int)L; { const int q = nwg / NXCD, r = nwg % NXCD, xcd = wgid % NXCD, off = wgid / NXCD; wgid = (xcd < r ? xcd * (q + 1) : r * (q + 1) + (xcd - r) * q) + off; }
        const int nig = wgm * nN, gid = wgid / nig, fm = gid * wgm, gsz = (nM - fm) < wgm ? (nM - fm) : wgm;
        u.pm = fm + ((wgid % nig) % gsz); u.pn = (wgid % nig) / gsz; return true;
    }
    __device__ __forceinline__ void a_ready(const Unit&) const {}
    __device__ __forceinline__ void done(const Unit&) const {}
};

__device__ __forceinline__ unsigned cvt_pk_bf16(float lo, float hi) { unsigned r; asm volatile("v_cvt_pk_bf16_f32 %0, %1, %2" : "=v"(r) : "v"(lo), "v"(hi)); return r; }
typedef float f32x2 __attribute__((ext_vector_type(2)));

typedef unsigned u32x2 __attribute__((ext_vector_type(2)));
template <class V> __device__ __forceinline__ V ldg_(const void* sbase, unsigned boff) { return *(const V*)((const char*)sbase + boff); }
template <class V> __device__ __forceinline__ void stg_(void* sbase, unsigned boff, V v) { *(V*)((char*)sbase + boff) = v; }
__device__ __forceinline__ void rope_load(const void* sbase, unsigned boff, float dq, f32x4& cs, f32x4& sn) {
    const u32x4 w = ldg_<u32x4>(sbase, boff);
#pragma unroll
    for (int i = 0; i < 4; ++i) { cs[i] = (float)__builtin_bit_cast(_Float16, (unsigned short)(w[i] & 0xffffu)) * dq; sn[i] = (float)__builtin_bit_cast(_Float16, (unsigned short)(w[i] >> 16)) * dq; }
}
__device__ __forceinline__ void rope_store(const f32x4 a0, const f32x4 a1, const f32x4 cs, const f32x4 sn, void* sbase, unsigned boff) {
    const f32x4 o0 = a0 * cs - a1 * sn, o1 = a1 * cs + a0 * sn;
    u32x2 w0, w1; w0.x = cvt_pk_bf16(o0[0], o0[1]); w0.y = cvt_pk_bf16(o0[2], o0[3]); w1.x = cvt_pk_bf16(o1[0], o1[1]); w1.y = cvt_pk_bf16(o1[2], o1[3]);
    stg_<u32x2>(sbase, boff, w0); stg_<u32x2>(sbase, boff + 128, w1);
}
struct EpiNull { static constexpr bool PERM = false, AFTER_DRAIN = false;
    __device__ __forceinline__ void operator()(const f32x4 (&acc)[2][2][4][2], const Unit& u, int wr, int wc, int fr, int fq) const {
#pragma unroll
        for (int ai = 0; ai < 2; ++ai)
#pragma unroll
            for (int bj = 0; bj < 2; ++bj) asm volatile("" :: "v"(acc[ai][bj][0][0]), "v"(acc[ai][bj][0][1]), "v"(acc[ai][bj][1][0]), "v"(acc[ai][bj][1][1]), "v"(acc[ai][bj][2][0]), "v"(acc[ai][bj][2][1]), "v"(acc[ai][bj][3][0]), "v"(acc[ai][bj][3][1])); } };
__device__ __forceinline__ void rope_store16(const f32x4 a0, const f32x4 a1, const f32x4 cs, const f32x4 sn, void* sbase, unsigned boff) {
    const f32x4 o0 = a0 * cs - a1 * sn, o1 = a1 * cs + a0 * sn;
    u32x4 w; w.x = cvt_pk_bf16(o0[0], o0[1]); w.y = cvt_pk_bf16(o0[2], o0[3]); w.z = cvt_pk_bf16(o1[0], o1[1]); w.w = cvt_pk_bf16(o1[2], o1[3]);
    stg_<u32x4>(sbase, boff, w);
}
struct EpiEven {
    static constexpr bool PERM = false, AFTER_DRAIN = false;
    unsigned char* ws; float dq;
    __device__ __forceinline__ void operator()(const f32x4 (&acc)[2][2][4][2], const Unit& u, int wr, int wc, int fr, int fq) const {
        int tl_ = threadIdx.x; asm volatile("" : "+v"(tl_));
        wr = (tl_ >> 8) & 1; wc = (tl_ >> 6) & 3; fr = tl_ & 15; fq = (tl_ >> 4) & 3;
        const unsigned rl = (unsigned)(wr * 64 + fr);
        const int b = u.pm >> 6, tb = (u.pm & 63) * 256;
        unsigned char* dst[2]; bool rope = true;
#pragma unroll
        for (int bj = 0; bj < 2; ++bj) { const int cb = 2 * u.pn + bj; size_t base; int nH, hh;
            if (cb < 8) { base = R_QA; nH = 8; hh = cb; } else if (cb < 14) { base = R_KA; nH = 6; hh = cb - 8; } else if (cb < 20) { base = R_VA; nH = 6; hh = cb - 14; rope = false; }
            else if (cb < 28) { base = R_QB; nH = 8; hh = cb - 20; } else if (cb < 30) { base = R_KB; nH = 2; hh = cb - 28; } else { base = R_VB; nH = 2; hh = cb - 30; rope = false; }
            dst[bj] = ws + WS_R + base + ((size_t)(b * nH + hh) * T + tb) * 256; }
        const unsigned so = (rl * 128 + 16 * wc + 4 * fq) * 2, ro_ = (rl * 64 + 16 * wc + 4 * fq) * 4;
        const unsigned char* rc = ws + WS_ROPEC + (size_t)u.pm * 256 * 256;
#pragma unroll
        for (int ai = 0; ai < 2; ++ai) {
            f32x4 cs[4], sn[4];
#pragma unroll
            for (int m = 0; m < 4; ++m) { const int ro = ai * 128 + m * 16; cs[m] = (f32x4){dq, dq, dq, dq}; sn[m] = (f32x4){0.f, 0.f, 0.f, 0.f};
                if (rope) rope_load(rc, ro_ + ro * 256, dq, cs[m], sn[m]); }
#pragma unroll
            for (int m = 0; m < 4; ++m) { const int ro = ai * 128 + m * 16;
#pragma unroll
                for (int bj = 0; bj < 2; ++bj) rope_store(acc[ai][bj][m][0], acc[ai][bj][m][1], cs[m], sn[m], dst[bj], so + ro * 256); }
            asm volatile("" ::: "memory"); }
    }
};
struct EpiOdd {
    static constexpr bool PERM = false, AFTER_DRAIN = false;
    unsigned char* ws; int dsh;    float dq;    int norope;
    __device__ __forceinline__ void operator()(const f32x4 (&acc)[2][2][4][2], const Unit& u, int wr, int wc, int fr, int fq) const {
        int tl_ = threadIdx.x; asm volatile("" : "+v"(tl_));
        wr = (tl_ >> 8) & 1; wc = (tl_ >> 6) & 3; fr = tl_ & 15; fq = (tl_ >> 4) & 3;
        const unsigned rl = (unsigned)(wr * 64 + fr);
        const int b = u.pm >> 6, tb = (u.pm & 63) * 256;
        const bool rope = u.pn < 16 && norope != 1; const int lsh = 14 - dsh, dmask = (1 << dsh) - 1;
        unsigned char* dst[2];
#pragma unroll
        for (int bj = 0; bj < 2; ++bj) { const int cb = 2 * u.pn + bj, which = cb >> 4, h = cb & 15;
            dst[bj] = ws + WS_R + (which == 0 ? R_QG : (which == 1 ? R_KG : R_VG)) + (size_t)(b * 16 + h) * T * 256; }
        const unsigned co = (16 * wc + 4 * fq) * 2, ro_ = (rl * 64 + 16 * wc + 4 * fq) * 4;
        const unsigned char* rc = ws + WS_ROPEC + (size_t)u.pm * 256 * 256;
#pragma unroll
        for (int ai = 0; ai < 2; ++ai) {
            f32x4 cs[4], sn[4];
#pragma unroll
            for (int m = 0; m < 4; ++m) { const int ro = ai * 128 + m * 16; cs[m] = (f32x4){dq, dq, dq, dq}; sn[m] = (f32x4){0.f, 0.f, 0.f, 0.f};
                if (rope) rope_load(rc, ro_ + ro * 256, dq, cs[m], sn[m]); }
#pragma unroll
            for (int m = 0; m < 4; ++m) { const int ro = ai * 128 + m * 16; const unsigned t = (unsigned)tb + rl + ro, row = ((t & dmask) << lsh) + (t >> dsh);
#pragma unroll
                for (int bj = 0; bj < 2; ++bj) { if (norope == 2) rope_store16(acc[ai][bj][m][0], acc[ai][bj][m][1], cs[m], sn[m], dst[bj], row * 256 + 2 * co); else rope_store(acc[ai][bj][m][0], acc[ai][bj][m][1], cs[m], sn[m], dst[bj], row * 256 + co); } }
            asm volatile("" ::: "memory"); }
    }
};
struct EpiResid {
    static constexpr bool PERM = false, AFTER_DRAIN = false;
    const float* base; float* out; int ldc; float alpha; const float* stats; const float* gam; const float* bet;
    __device__ __forceinline__ void operator()(const f32x4 (&acc)[2][2][4][2], const Unit& u, int wr, int wc, int fr, int fq) const {
        int tl_ = threadIdx.x; asm volatile("" : "+v"(tl_));
        wr = (tl_ >> 8) & 1; wc = (tl_ >> 6) & 3; fr = tl_ & 15; fq = (tl_ >> 4) & 3;
        const size_t tile = ((size_t)u.pm * BM * ldc + (size_t)u.pn * BM) * 4;
        const unsigned lo_ = ((unsigned)(wr * 64 + fr) * (unsigned)ldc + wc * 32 + 4 * fq) * 4;
        unsigned char* op = (unsigned char*)out + tile; const bool ln = gam != nullptr;
        const unsigned char* bp = ln ? op : (const unsigned char*)base + tile;
        const unsigned char* sp = (const unsigned char*)stats + (size_t)u.pm * BM * 8; const unsigned so_ = (unsigned)(wr * 64 + fr) * 8;
        const unsigned char* gp = (const unsigned char*)gam + (size_t)u.pn * BM * 4; const unsigned char* tp = (const unsigned char*)bet + (size_t)u.pn * BM * 4; const unsigned co_ = (wc * 32 + 4 * fq) * 4;
#pragma unroll
        for (int ai = 0; ai < 2; ++ai)
#pragma unroll
            for (int mp = 0; mp < 2; ++mp) {
                f32x4 bs[2][2][2]; typedef float f32x2_ __attribute__((ext_vector_type(2))); f32x2_ st[2] = {{0.f, 1.f}, {0.f, 1.f}};
#pragma unroll
                for (int mm = 0; mm < 2; ++mm) { const int rg = ai * HALF + (2 * mp + mm) * 16; const unsigned ro = lo_ + (unsigned)rg * (unsigned)ldc * 4;
                    if (ln) st[mm] = ldg_<f32x2_>(sp, so_ + rg * 8);
#pragma unroll
                    for (int bj = 0; bj < 2; ++bj)
#pragma unroll
                        for (int n = 0; n < 2; ++n) bs[mm][bj][n] = ldg_<f32x4>(bp, ro + (bj * HALF + n * 16) * 4); }
#pragma unroll
                for (int bj = 0; bj < 2; ++bj)
#pragma unroll
                    for (int n = 0; n < 2; ++n) { f32x4 g4 = {1.f, 1.f, 1.f, 1.f}, b4 = {0.f, 0.f, 0.f, 0.f};
                        if (ln) { g4 = ldg_<f32x4>(gp, co_ + (bj * HALF + n * 16) * 4); b4 = ldg_<f32x4>(tp, co_ + (bj * HALF + n * 16) * 4); }
#pragma unroll
                        for (int mm = 0; mm < 2; ++mm) { const unsigned ro = lo_ + (unsigned)(ai * HALF + (2 * mp + mm) * 16) * (unsigned)ldc * 4;
                            const f32x4 x = ln ? (bs[mm][bj][n] - st[mm].x) * st[mm].y * g4 + b4 : bs[mm][bj][n];
                            stg_<f32x4>(op, ro + (bj * HALF + n * 16) * 4, x * alpha + acc[ai][bj][2 * mp + mm][n]); } }
                asm volatile("" ::: "memory");
            }
    }
};
struct EpiRelu2 {
    static constexpr bool PERM = true, AFTER_DRAIN = false;
    bf16_t* O; int ldc;
    __device__ __forceinline__ void operator()(const f32x4 (&acc)[2][2][4][2], const Unit& u, int wr, int wc, int fr, int fq) const {
        int tl_ = threadIdx.x; asm volatile("" : "+v"(tl_));
        wr = (tl_ >> 8) & 1; wc = (tl_ >> 6) & 3; fr = tl_ & 15; fq = (tl_ >> 4) & 3;
        unsigned char* op = (unsigned char*)O + ((size_t)u.pm * BM * ldc + (size_t)u.pn * BM) * 2;
        const unsigned lo_ = ((unsigned)(wr * 64 + fr) * (unsigned)ldc + wc * 32 + 8 * fq) * 2;
#pragma unroll
        for (int ai = 0; ai < 2; ++ai)
#pragma unroll
            for (int m = 0; m < 4; ++m) { const unsigned ro = lo_ + (unsigned)(ai * HALF + m * 16) * (unsigned)ldc * 2;
#pragma unroll
                for (int bj = 0; bj < 2; ++bj) { f32x4 v0 = acc[ai][bj][m][0], v1 = acc[ai][bj][m][1];
#pragma unroll
                    for (int j = 0; j < 4; ++j) { const float a = fmaxf(v0[j], 0.f), c = fmaxf(v1[j], 0.f); v0[j] = a * a; v1[j] = c * c; }
                    u32x4 w; w.x = cvt_pk_bf16(v0[0], v0[1]); w.y = cvt_pk_bf16(v0[2], v0[3]); w.z = cvt_pk_bf16(v1[0], v1[1]); w.w = cvt_pk_bf16(v1[2], v1[3]);
                    stg_<u32x4>(op, ro + bj * HALF * 2, w); } }
    }
};

template <class Epi, class Sched, bool ALIGN_EPI = false, bool SP2 = false, bool FP8 = false>
__device__ __forceinline__ void gemm_phase(PG8_LAS unsigned char* lds, const Gemm g, const Sched& S, const Epi& E) {
    int tid_ = threadIdx.x; asm volatile("" : "+v"(tid_));
    const int tid = tid_, wid = __builtin_amdgcn_readfirstlane(tid >> 6), lane = tid & 63, wr = wid >> 2, wc = wid & 3, fr = lane & 15, fq = lane >> 4;
    const int K = g.K, nt = K / BK;
    unsigned voffA[2], voffB[2];
#pragma unroll
    for (int i = 0; i < 2; ++i) { int R, C; stage_rc(tid * 16 + i * 8192, R, C); const int Rb = Epi::PERM ? ((R & ~31) + perm32(R & 31)) : R;
        voffA[i] = (unsigned)(R * K + C) * 2u; voffB[i] = (unsigned)(Rb * K + C) * 2u; }
    const size_t rstep64 = (size_t)64 * K * 2;
    const size_t kstep = (size_t)(BK * 2);
    const size_t hstep = (size_t)HALF * K * 2;
    const size_t tstep = 2 * hstep;
    const unsigned ldsw = (unsigned)wid * 1024u;
    const int aoff = lds_byte(wr * 64 + fr, fq * 8), boff = lds_byte(wc * 32 + fr, fq * 8);
#define PG8_SA(b, h) (((b) * 2 + (h)) * HTB)
#define PG8_SB(b, h) ((4 + (b) * 2 + (h)) * HTB)
#define PG8_STAGE(bufoff, gbase, voff) do { _Pragma("unroll") for (int _i = 0; _i < 2; ++_i)   \
        __builtin_amdgcn_global_load_lds((const unsigned*)((const char*)(gbase) + (size_t)_i * rstep64 + (voff)[0]), (PG8_LAS unsigned*)(lds + (bufoff) + ldsw + _i * 8192), 16, 0, 0); } while (0)
#define PG8_LDA(dst, b, h) do { _Pragma("unroll") for (int m = 0; m < 4; ++m) _Pragma("unroll") for (int k = 0; k < 2; ++k) dst[m][k] = *(const PG8_LAS bf16x8*)(lds + PG8_SA(b, h) + aoff + m * 2048 + k * 1024); } while (0)
#define PG8_LDB(dst, b, h) do { _Pragma("unroll") for (int n = 0; n < 2; ++n) _Pragma("unroll") for (int k = 0; k < 2; ++k) dst[n][k] = *(const PG8_LAS bf16x8*)(lds + PG8_SB(b, h) + boff + n * 2048 + k * 1024); } while (0)
#define PG8_MMA(ai, bj, At, Bt) do { __builtin_amdgcn_s_setprio(1); _Pragma("unroll") for (int m = 0; m < 4; ++m) _Pragma("unroll") for (int n = 0; n < 2; ++n) { \
        if constexpr (FP8) { typedef int v4i_ __attribute__((ext_vector_type(4))); typedef int v8i_ __attribute__((ext_vector_type(8))); \
            const v8i_ b8 = __builtin_shufflevector(__builtin_bit_cast(v4i_, Bt[n][0]), __builtin_bit_cast(v4i_, Bt[n][1]), 0, 1, 2, 3, 4, 5, 6, 7), a8 = __builtin_shufflevector(__builtin_bit_cast(v4i_, At[m][0]), __builtin_bit_cast(v4i_, At[m][1]), 0, 1, 2, 3, 4, 5, 6, 7); \
            acc[ai][bj][m][n] = __builtin_amdgcn_mfma_scale_f32_16x16x128_f8f6f4(b8, a8, acc[ai][bj][m][n], 0, 0, 0, 0, 0, 0); } \
        else { _Pragma("unroll") for (int k = 0; k < 2; ++k) acc[ai][bj][m][n] = __builtin_amdgcn_mfma_f32_16x16x32_bf16(Bt[n][k], At[m][k], acc[ai][bj][m][n], 0, 0, 0); } } __builtin_amdgcn_s_setprio(0); } while (0)
#define PG8_WAIT_V(n) asm volatile("s_waitcnt vmcnt(" #n ")" ::: "memory")
#define PG8_WAIT_L(n) asm volatile("s_waitcnt lgkmcnt(" #n ")" ::: "memory")
#define PG8_BAR __builtin_amdgcn_s_barrier()
#define PG8_SCHED __builtin_amdgcn_sched_barrier(0)
    Unit cur, nxt; int ui = 0;
    if (!S.next(0, cur)) return;
    f32x4 acc[2][2][4][2];
#pragma unroll
    for (int a = 0; a < 2; ++a)
#pragma unroll
        for (int b = 0; b < 2; ++b)
#pragma unroll
            for (int m = 0; m < 4; ++m)
#pragma unroll
                for (int n = 0; n < 2; ++n) acc[a][b][m][n] = (f32x4){0.f, 0.f, 0.f, 0.f};
    bf16x8 At[4][2], B0[2][2], B1[2][2];
    const char* cA = (const char*)g.A + (size_t)cur.pm * tstep; const char* cB = (const char*)g.Bt + (size_t)cur.pn * tstep;
    S.a_ready(cur);
    if constexpr (SP2) {
        PG8_STAGE(PG8_SB(0, 0), cB, voffB); PG8_STAGE(PG8_SB(0, 1), cB + hstep, voffB); PG8_STAGE(PG8_SA(0, 0), cA, voffA); PG8_STAGE(PG8_SA(0, 1), cA + hstep, voffA);
        if (wr == 1) PG8_BAR;
        PG8_WAIT_V(2); PG8_BAR;
        PG8_STAGE(PG8_SB(1, 0), cB + kstep, voffB); PG8_STAGE(PG8_SA(1, 0), cA + kstep, voffA); PG8_STAGE(PG8_SB(1, 1), cB + hstep + kstep, voffB);
        PG8_WAIT_V(6); PG8_BAR;
    } else {
        PG8_STAGE(PG8_SB(0, 0), cB, voffB); PG8_STAGE(PG8_SA(0, 0), cA, voffA); PG8_STAGE(PG8_SB(0, 1), cB + hstep, voffB); PG8_STAGE(PG8_SA(0, 1), cA + hstep, voffA);
        if (wr == 1) PG8_BAR;
        PG8_WAIT_V(4); PG8_BAR;
        PG8_STAGE(PG8_SB(1, 0), cB + kstep, voffB); PG8_STAGE(PG8_SA(1, 0), cA + kstep, voffA); PG8_STAGE(PG8_SB(1, 1), cB + hstep + kstep, voffB);
        PG8_WAIT_V(6); PG8_BAR;
    }
    for (;;) {
        const bool has_next = S.next(ui + 1, nxt);
        const char* nA = has_next ? (const char*)g.A + (size_t)nxt.pm * tstep : cA; const char* nB = has_next ? (const char*)g.Bt + (size_t)nxt.pn * tstep : cB;
        for (int t = 0; t < nt; t += 2) {
            const bool last = (t == nt - 2);
            const char* a1 = cA + (size_t)(t + 1) * kstep;
            const char* a2 = last ? nA : cA + (size_t)(t + 2) * kstep; const char* b2 = last ? nB : cB + (size_t)(t + 2) * kstep;
            const char* a3 = a2 + kstep; const char* b3 = b2 + kstep;
            if (last && has_next) S.a_ready(nxt);
            if constexpr (SP2) {
            PG8_LDB(B0, 0, 0); PG8_LDB(B1, 0, 1); PG8_SCHED; PG8_LDA(At, 0, 0); PG8_STAGE(PG8_SA(1, 1), a1 + hstep, voffA);
            PG8_WAIT_V(8); PG8_WAIT_L(0); PG8_BAR; PG8_MMA(0, 0, At, B0); PG8_MMA(0, 1, At, B1); PG8_BAR; PG8_SCHED;
            PG8_LDA(At, 0, 1); PG8_STAGE(PG8_SB(0, 0), b2, voffB); PG8_STAGE(PG8_SB(0, 1), b2 + hstep, voffB); PG8_STAGE(PG8_SA(0, 0), a2, voffA);
            PG8_WAIT_V(8); PG8_WAIT_L(0); PG8_BAR; PG8_MMA(1, 0, At, B0); PG8_MMA(1, 1, At, B1); PG8_BAR; PG8_SCHED;
            PG8_LDB(B0, 1, 0); PG8_LDB(B1, 1, 1); PG8_SCHED; PG8_LDA(At, 1, 0); PG8_STAGE(PG8_SA(0, 1), a2 + hstep, voffA);
            PG8_WAIT_V(8); PG8_WAIT_L(0); PG8_BAR; PG8_MMA(0, 0, At, B0); PG8_MMA(0, 1, At, B1); PG8_BAR; PG8_SCHED;
            PG8_LDA(At, 1, 1); PG8_STAGE(PG8_SB(1, 0), b3, voffB); PG8_STAGE(PG8_SB(1, 1), b3 + hstep, voffB); PG8_STAGE(PG8_SA(1, 0), a3, voffA);
            PG8_WAIT_V(8); PG8_WAIT_L(0); PG8_BAR; PG8_MMA(1, 0, At, B0); PG8_MMA(1, 1, At, B1); PG8_BAR; PG8_SCHED;
            } else {
            PG8_LDB(B0, 0, 0); PG8_SCHED; PG8_LDA(At, 0, 0); PG8_STAGE(PG8_SA(1, 1), a1 + hstep, voffA);
            PG8_WAIT_L(8); PG8_BAR; PG8_WAIT_L(0); PG8_MMA(0, 0, At, B0); PG8_BAR; PG8_SCHED;
            PG8_LDB(B1, 0, 1); PG8_STAGE(PG8_SB(0, 0), b2, voffB);
            PG8_BAR; PG8_WAIT_L(0); PG8_MMA(0, 1, At, B1); PG8_BAR;
            PG8_LDA(At, 0, 1); PG8_STAGE(PG8_SA(0, 0), a2, voffA);
            PG8_BAR; PG8_WAIT_L(0); PG8_MMA(1, 0, At, B0); PG8_BAR; PG8_SCHED;
            PG8_STAGE(PG8_SB(0, 1), b2 + hstep, voffB);
            PG8_WAIT_V(6); PG8_BAR; PG8_MMA(1, 1, At, B1); PG8_BAR;
            PG8_LDB(B0, 1, 0); PG8_SCHED; PG8_LDA(At, 1, 0); PG8_STAGE(PG8_SA(0, 1), a2 + hstep, voffA);
            PG8_WAIT_L(8); PG8_BAR; PG8_WAIT_L(0); PG8_MMA(0, 0, At, B0); PG8_BAR; PG8_SCHED;
            PG8_LDB(B1, 1, 1); PG8_STAGE(PG8_SB(1, 0), b3, voffB);
            PG8_BAR; PG8_WAIT_L(0); PG8_MMA(0, 1, At, B1); PG8_BAR;
            PG8_LDA(At, 1, 1); PG8_STAGE(PG8_SA(1, 0), a3, voffA);
            PG8_BAR; PG8_WAIT_L(0); PG8_MMA(1, 0, At, B0); PG8_BAR; PG8_SCHED;
            PG8_STAGE(PG8_SB(1, 1), b3 + hstep, voffB);
            PG8_WAIT_V(6); PG8_BAR; PG8_MMA(1, 1, At, B1); PG8_BAR;
            }
        }
        if constexpr (ALIGN_EPI) { if (wr == 0) PG8_BAR; }
        if constexpr (!Epi::AFTER_DRAIN) { E(acc, cur, wr, wc, fr, fq); S.done(cur); }
        if (!has_next) break;
#pragma unroll
        for (int a = 0; a < 2; ++a)
#pragma unroll
            for (int b = 0; b < 2; ++b)
#pragma unroll
                for (int m = 0; m < 4; ++m)
#pragma unroll
                    for (int n = 0; n < 2; ++n) acc[a][b][m][n] = (f32x4){0.f, 0.f, 0.f, 0.f};
        cur = nxt; cA = nA; cB = nB; ++ui;
        if constexpr (ALIGN_EPI) { if (wr == 1) PG8_BAR; }
    }
    PG8_WAIT_V(0);
    if constexpr (!ALIGN_EPI) { if (wr == 0) PG8_BAR; }
    PG8_BAR;
    if constexpr (Epi::AFTER_DRAIN) { E.fused(acc, cur, wr, wc, fr, fq, lds, wid, lane); S.done(cur); }
#undef PG8_SA
#undef PG8_SB
#undef PG8_STAGE
#undef PG8_LDA
#undef PG8_LDB
#undef PG8_MMA
#undef PG8_WAIT_V
#undef PG8_WAIT_L
#undef PG8_BAR
#undef PG8_SCHED
}
}
#define GAS __attribute__((address_space(1)))
#define LAS __attribute__((address_space(3)))
typedef unsigned short bf16;
typedef unsigned v4u __attribute__((ext_vector_type(4)));
typedef float f32x4 __attribute__((ext_vector_type(4)));
typedef short bf16x8 __attribute__((ext_vector_type(8)));
typedef GAS unsigned gu32;
typedef GAS unsigned long long gu64;
#define RLX_AGENT __ATOMIC_RELAXED, __HIP_MEMORY_SCOPE_AGENT
#define LDS_WAIT() asm volatile("s_waitcnt lgkmcnt(0)" ::: "memory")
#define VM_WAIT() asm volatile("s_waitcnt vmcnt(0)" ::: "memory")
__device__ __forceinline__ unsigned long long rt() { return __builtin_amdgcn_s_memrealtime(); }
__device__ __forceinline__ unsigned f2bf(float f) { unsigned u = __builtin_bit_cast(unsigned, f); return (u + 0x7fffu + ((u >> 16) & 1u)) >> 16; }
__device__ __forceinline__ unsigned pk2(float lo, float hi) { return f2bf(lo) | (f2bf(hi) << 16); }

#define XB_TMO      128
#define XB_XCNT(j)  (256  + 64 * (j))
#define XB_XSUB(j)  (1280 + 64 * (j))
#define XB_XGEN(j)  (2304 + 64 * (j))
#define XB_TOP      3328
#define XB_TOPGEN   3392
#define XCD_BAR_WORDS 3456
#define XB_SPIN_CAP (1u << 18)

__device__ __forceinline__ unsigned xb_ld(unsigned* p)              { return __hip_atomic_load(p, __ATOMIC_RELAXED, __HIP_MEMORY_SCOPE_AGENT); }
__device__ __forceinline__ unsigned xb_add(unsigned* p, unsigned v) { return __hip_atomic_fetch_add(p, v, __ATOMIC_RELAXED, __HIP_MEMORY_SCOPE_AGENT); }
__device__ __forceinline__ unsigned xb_xcc_id() { return (unsigned)__builtin_amdgcn_s_getreg((3 << 11) | 20) & 0xFu; }
#define XB_SPIN(cond, bar) do { unsigned _sp = 0; while (cond) { __builtin_amdgcn_s_sleep(1); \
    if ((++_sp & 255u) == 0u) { if (xb_ld(&(bar)[XB_TMO])) break; if (_sp > XB_SPIN_CAP) { atomicAdd(&(bar)[XB_TMO], 1u); break; } } } } while (0)

struct XcdBarrier {
    unsigned* bar; unsigned x;
    volatile LAS unsigned* st;
};

__device__ __forceinline__ XcdBarrier xcd_barrier_post(unsigned* bar, volatile LAS unsigned* st) {
    XcdBarrier b; b.bar = bar; b.x = xb_xcc_id(); b.st = st;
    if (threadIdx.x == 0) (void)xb_add(&bar[XB_XCNT(b.x)], 1u);
    return b;
}
__device__ __forceinline__ void xcd_barrier_complete(unsigned* bar, unsigned x, unsigned& nloc, unsigned& nx) {
    const unsigned G = gridDim.x * gridDim.y * gridDim.z;
    unsigned sum, cnt, mine, sp = 0u;
    for (;;) {
        sum = 0u; cnt = 0u; mine = 0u;
#pragma unroll
        for (unsigned j = 0; j < 16; ++j) { const unsigned c = xb_ld(&bar[XB_XCNT(j)]); sum += c; cnt += (c > 0u) ? 1u : 0u; mine = (j == x) ? c : mine; }
        if (sum == G) break;
        __builtin_amdgcn_s_sleep(1);
        if ((++sp & 255u) == 0u) { if (xb_ld(&bar[XB_TMO])) break; if (sp > XB_SPIN_CAP) { atomicAdd(&bar[XB_TMO], 1u); break; } }
    }
    nloc = mine > 0u ? mine : 1u; nx = cnt > 0u ? cnt : 1u;
}

__device__ __forceinline__ void xcd_barrier(const XcdBarrier& b) {
    asm volatile("s_waitcnt vmcnt(0)" ::: "memory");
    __syncthreads();
    if (threadIdx.x == 0) {
        unsigned* bar = b.bar;
        __builtin_amdgcn_s_waitcnt(0);
        unsigned nloc = b.st[0], nx = b.st[1];
        if (nloc == 0u) { xcd_barrier_complete(bar, b.x, nloc, nx); b.st[0] = nloc; b.st[1] = nx; }
        const unsigned old = xb_add(&bar[XB_XSUB(b.x)], 1u);
        const unsigned gen = old / nloc;
        if (old + 1u == (gen + 1u) * nloc) {
            __builtin_amdgcn_fence(__ATOMIC_RELEASE, "agent");
            asm volatile("s_waitcnt vmcnt(0)" ::: "memory");
            const unsigned og = xb_add(&bar[XB_TOP], 1u);
            const unsigned tg = og / nx;
            if (og + 1u == (tg + 1u) * nx) xb_add(&bar[XB_TOPGEN], 1u);
            else XB_SPIN(xb_ld(&bar[XB_TOPGEN]) == tg, bar);
            __builtin_amdgcn_fence(__ATOMIC_ACQUIRE, "agent");
            xb_add(&bar[XB_XGEN(b.x)], 1u);
            asm volatile("s_waitcnt vmcnt(0)" ::: "memory");
        } else {
            XB_SPIN(xb_ld(&bar[XB_XGEN(b.x)]) == gen, bar);
            __builtin_amdgcn_fence(__ATOMIC_ACQUIRE, "agent");
            asm volatile("s_waitcnt vmcnt(0)" ::: "memory");
        }
    }
    __syncthreads();
}

namespace fa {
#define FA_LAS __attribute__((address_space(3)))
typedef unsigned short bf16;
typedef short bf16x8 __attribute__((ext_vector_type(8)));
typedef short s16x4 __attribute__((ext_vector_type(4)));
typedef float f32x16 __attribute__((ext_vector_type(16)));
typedef float f32x4 __attribute__((ext_vector_type(4)));
typedef unsigned u32x4 __attribute__((ext_vector_type(4)));
constexpr int D = 128, KVBLK = 64, SHM_V = KVBLK * D * 2, SHM_K = KVBLK * D * 2;
constexpr int OFF_V = 0, OFF_K = 2 * SHM_V, SLOT = 2 * SHM_V + 2 * SHM_K, OFF_WS = 135168, WS_PER_WAVE = 512, ENGINE_BYTES = OFF_WS + 8 * WS_PER_WAVE;
constexpr float SCALE = 0.08838834764831845f;
constexpr float THR = 8.f;
constexpr float C2 = 1.4426950408889634f * SCALE;
#define KSWZ(row, colB) ((row) * 256 + ((colB) ^ (((row) & 7) << 4)))
#define SBAR() __builtin_amdgcn_sched_barrier(0)
__device__ __forceinline__ int v_st(int k, int c) { const int kk = (k & ~0xC) | ((k & 4) << 1) | ((k & 8) >> 1); return ((kk >> 3) * 4 + (c >> 5)) * 512 + ((kk & 7) * 32 + (c & 31)) * 2; }
__device__ __forceinline__ int v_rd_base(int lane) { return ((lane & 3) << 3) | (((lane >> 2) & 3) << 6) | (((lane >> 4) & 1) << 5) | (((lane >> 5) & 1) << 8); }
constexpr int v_rd_off(int d0, int ks, int half) { return d0 * 512 + ks * 4096 + half * 2048; }
__device__ __forceinline__ int crow(int r, int hi) { return (r & 3) + 8 * (r >> 2) + 4 * hi; }
typedef float f32x2_t __attribute__((ext_vector_type(2))); typedef __bf16 bf16x2_t __attribute__((ext_vector_type(2)));
__device__ __forceinline__ unsigned cvtpk(float lo, float hi) { f32x2_t v = {lo, hi}; bf16x2_t b = __builtin_convertvector(v, bf16x2_t); return __builtin_bit_cast(unsigned, b); }
__device__ __forceinline__ float bf2f(unsigned short b) { return __uint_as_float(((unsigned)b) << 16); }
__device__ __forceinline__ void mask_tile(f32x16& p0, f32x16& p1, int dq, unsigned W) {
    const float NEG = -__builtin_inff();
#pragma unroll
    for (int r = 0; r < 16; ++r) { const int c = (r & 3) + 8 * (r >> 2);
        if ((unsigned)(dq - c) >= W) p0[r] = NEG;
        if ((unsigned)(dq - c - 32) >= W) p1[r] = NEG; }
}
__device__ __forceinline__ void mask_gt(f32x16& p0, f32x16& p1, int lim, int hi) {
    const float NEG = -__builtin_inff();
#pragma unroll
    for (int r = 0; r < 16; ++r) { const int c = (r & 3) + 8 * (r >> 2) + 4 * hi;
        if (c > lim) p0[r] = NEG;
        if (c + 32 > lim) p1[r] = NEG; }
}
__device__ __forceinline__ void partialSM(f32x16& p0, f32x16& p1, float& m_reg, float& mn, float& alpha) {
    float pmax = p0[0];
#pragma unroll
    for (int r = 1; r < 16; ++r) pmax = fmaxf(pmax, p0[r]);
#pragma unroll
    for (int r = 0; r < 16; ++r) pmax = fmaxf(pmax, p1[r]);
    { auto rr = __builtin_amdgcn_permlane32_swap(__float_as_uint(pmax), __float_as_uint(pmax), false, false);
      pmax = fmaxf(__uint_as_float(rr[0]), __uint_as_float(rr[1])); }
    if (__builtin_expect(__all((pmax - m_reg) * SCALE <= THR), 1)) { mn = m_reg; alpha = 1.f; }
    else { mn = fmaxf(m_reg, pmax); alpha = __builtin_amdgcn_exp2f((m_reg - mn) * C2); m_reg = mn; }
    const float mnL = -mn * C2;
#pragma unroll
    for (int r = 0; r < 16; ++r) p0[r] = fmaf(p0[r], C2, mnL);
#pragma unroll
    for (int r = 0; r < 16; ++r) p1[r] = fmaf(p1[r], C2, mnL);
#pragma unroll
    for (int r = 0; r < 16; ++r) p0[r] = __builtin_amdgcn_exp2f(p0[r]);
}
__device__ __forceinline__ void partialSM_sel(f32x16& p0, f32x16& p1, float& m_reg, float& mn, float& alpha, bool rowsel) {
    float pmax = p0[0];
#pragma unroll
    for (int r = 1; r < 16; ++r) pmax = fmaxf(pmax, p0[r]);
#pragma unroll
    for (int r = 0; r < 16; ++r) pmax = fmaxf(pmax, p1[r]);
    { auto rr = __builtin_amdgcn_permlane32_swap(__float_as_uint(pmax), __float_as_uint(pmax), false, false);
      pmax = fmaxf(__uint_as_float(rr[0]), __uint_as_float(rr[1])); }
    if (__builtin_expect(__all((pmax - m_reg) * SCALE <= THR), 1)) { mn = m_reg; alpha = 1.f; }
    else { mn = fmaxf(m_reg, pmax); alpha = __builtin_amdgcn_exp2f((m_reg - mn) * C2); m_reg = mn; }
    const float mnL = rowsel ? -mn * C2 : -__builtin_inff();
#pragma unroll
    for (int r = 0; r < 16; ++r) p0[r] = fmaf(p0[r], C2, mnL);
#pragma unroll
    for (int r = 0; r < 16; ++r) p1[r] = fmaf(p1[r], C2, mnL);
#pragma unroll
    for (int r = 0; r < 16; ++r) p0[r] = __builtin_amdgcn_exp2f(p0[r]);
}
#define FA_PK4(P, B_, OUT) do { unsigned a0 = cvtpk(P[B_+0], P[B_+1]), a1 = cvtpk(P[B_+2], P[B_+3]);                          \
        unsigned b0 = cvtpk(P[B_+4], P[B_+5]), b1 = cvtpk(P[B_+6], P[B_+7]);                                             \
        auto r0 = __builtin_amdgcn_permlane32_swap(a0, b0, false, false); auto r1 = __builtin_amdgcn_permlane32_swap(a1, b1, false, false); \
        u32x4 w = {r0[0], r1[0], r0[1], r1[1]}; OUT = *reinterpret_cast<bf16x8*>(&w); } while (0)
__device__ __forceinline__ void packP(const f32x16& p0, const f32x16& p1, bf16x8& pa0, bf16x8& pa1, bf16x8& pa2, bf16x8& pa3) {
    FA_PK4(p0, 0, pa0); FA_PK4(p0, 8, pa1); FA_PK4(p1, 0, pa2); FA_PK4(p1, 8, pa3);
}
__device__ __forceinline__ void finishSM(f32x16& p0, f32x16& p1, float alpha, float& l_reg, bf16x8& pa0, bf16x8& pa1, bf16x8& pa2, bf16x8& pa3) {
#pragma unroll
    for (int r = 0; r < 16; ++r) p1[r] = __builtin_amdgcn_exp2f(p1[r]);
    float ps = 0;
#pragma unroll
    for (int r = 0; r < 16; ++r) ps += p0[r];
#pragma unroll
    for (int r = 0; r < 16; ++r) ps += p1[r];
    { auto rr = __builtin_amdgcn_permlane32_swap(__float_as_uint(ps), __float_as_uint(ps), false, false);
      ps = __uint_as_float(rr[0]) + __uint_as_float(rr[1]); }
    l_reg = l_reg * alpha + ps;
    packP(p0, p1, pa0, pa1, pa2, pa3);
}
#define FA_K4(F, B_, A0, A1, O0, O1) asm volatile("ds_read_b128 %0, %4 offset:" O0 "\n\tds_read_b128 %1, %4 offset:" O1 "\n\tds_read_b128 %2, %5 offset:" O0 "\n\tds_read_b128 %3, %5 offset:" O1 \
                                      : "=&v"(F[B_ + 0]), "=&v"(F[B_ + 1]), "=&v"(F[B_ + 2]), "=&v"(F[B_ + 3]) : "v"(A0), "v"(A1) : "memory")
#define FA_W4(F, B_, N_) asm volatile("s_waitcnt lgkmcnt(" #N_ ")" : "+v"(F[B_ + 0]), "+v"(F[B_ + 1]), "+v"(F[B_ + 2]), "+v"(F[B_ + 3]) :: "memory")
#define FA_W8(F, B_, N_) asm volatile("s_waitcnt lgkmcnt(" #N_ ")" : "+v"(F[B_ + 0]), "+v"(F[B_ + 1]), "+v"(F[B_ + 2]), "+v"(F[B_ + 3]), "+v"(F[B_ + 4]), "+v"(F[B_ + 5]), "+v"(F[B_ + 6]), "+v"(F[B_ + 7]) :: "memory")
#define FA_QK2(F, B_, d0) do { p0 = __builtin_amdgcn_mfma_f32_32x32x16_bf16(F[B_ + 0], qr[d0], p0, 0, 0, 0); p1 = __builtin_amdgcn_mfma_f32_32x32x16_bf16(F[B_ + 1], qr[d0], p1, 0, 0, 0); \
                               p0 = __builtin_amdgcn_mfma_f32_32x32x16_bf16(F[B_ + 2], qr[d0 + 1], p0, 0, 0, 0); p1 = __builtin_amdgcn_mfma_f32_32x32x16_bf16(F[B_ + 3], qr[d0 + 1], p1, 0, 0, 0); } while (0)
__device__ __forceinline__ void qkt(f32x16& p0, f32x16& p1, const FA_LAS char* Kt, int r32, int hi, const bf16x8* qr) {
    p0 = f32x16{}; p1 = f32x16{};
    int ka[4];
#pragma unroll
    for (int dd = 0; dd < 4; ++dd) ka[dd] = (int)(unsigned)(uintptr_t)(Kt + KSWZ(r32, (dd * 16 + hi * 8) * 2));
    bf16x8 f[16];
    FA_K4(f, 0, ka[0], ka[1], "0", "8192"); FA_K4(f, 4, ka[2], ka[3], "0", "8192"); FA_K4(f, 8, ka[0], ka[1], "128", "8320");
    FA_W4(f, 0, 8); FA_QK2(f, 0, 0);
    SBAR();
    FA_W4(f, 4, 4); FA_K4(f, 12, ka[2], ka[3], "128", "8320"); FA_QK2(f, 4, 2);
    SBAR();
    FA_W4(f, 8, 4); FA_QK2(f, 8, 4);
    SBAR();
    FA_W4(f, 12, 0); FA_QK2(f, 12, 6);
}
struct VPre { s16x4 v[16]; };
#define FA_V8(F, B_, d0) do { constexpr int b_ = v_rd_off(d0, 0, 0); \
        asm volatile("ds_read_b64_tr_b16 %0, %8 offset:%9\n\tds_read_b64_tr_b16 %1, %8 offset:%10\n\tds_read_b64_tr_b16 %2, %8 offset:%11\n\tds_read_b64_tr_b16 %3, %8 offset:%12\n\t" \
                     "ds_read_b64_tr_b16 %4, %8 offset:%13\n\tds_read_b64_tr_b16 %5, %8 offset:%14\n\tds_read_b64_tr_b16 %6, %8 offset:%15\n\tds_read_b64_tr_b16 %7, %8 offset:%16" \
                     : "=&v"(F[B_ + 0]), "=&v"(F[B_ + 1]), "=&v"(F[B_ + 2]), "=&v"(F[B_ + 3]), "=&v"(F[B_ + 4]), "=&v"(F[B_ + 5]), "=&v"(F[B_ + 6]), "=&v"(F[B_ + 7]) \
                     : "v"(vb0), "i"(b_), "i"(b_ + 2048), "i"(b_ + 4096), "i"(b_ + 6144), "i"(b_ + 8192), "i"(b_ + 10240), "i"(b_ + 12288), "i"(b_ + 14336) : "memory"); } while (0)
__device__ __forceinline__ void pv_issue(int vb0, VPre& f) { FA_V8(f.v, 0, 0); FA_V8(f.v, 8, 1); }
#define FA_PVM(d0, F, B_) do { \
        o[d0] = __builtin_amdgcn_mfma_f32_32x32x16_bf16(pa0, (bf16x8){F[B_+0][0], F[B_+0][1], F[B_+0][2], F[B_+0][3], F[B_+1][0], F[B_+1][1], F[B_+1][2], F[B_+1][3]}, o[d0], 0, 0, 0);   \
        o[d0] = __builtin_amdgcn_mfma_f32_32x32x16_bf16(pa1, (bf16x8){F[B_+2][0], F[B_+2][1], F[B_+2][2], F[B_+2][3], F[B_+3][0], F[B_+3][1], F[B_+3][2], F[B_+3][3]}, o[d0], 0, 0, 0);   \
        o[d0] = __builtin_amdgcn_mfma_f32_32x32x16_bf16(pa2, (bf16x8){F[B_+4][0], F[B_+4][1], F[B_+4][2], F[B_+4][3], F[B_+5][0], F[B_+5][1], F[B_+5][2], F[B_+5][3]}, o[d0], 0, 0, 0);   \
        o[d0] = __builtin_amdgcn_mfma_f32_32x32x16_bf16(pa3, (bf16x8){F[B_+6][0], F[B_+6][1], F[B_+6][2], F[B_+6][3], F[B_+7][0], F[B_+7][1], F[B_+7][2], F[B_+7][3]}, o[d0], 0, 0, 0); } while (0)
__device__ __forceinline__ void pv_tile(f32x16* o, int vb0, bf16x8 pa0, bf16x8 pa1, bf16x8 pa2, bf16x8 pa3, VPre& f) {
    s16x4 g[16];
    FA_W8(f.v, 0, 0); FA_W8(f.v, 8, 0);
    FA_V8(g, 0, 2);
    SBAR();
    FA_PVM(0, f.v, 0);
    SBAR();
    FA_V8(g, 8, 3);
    SBAR();
    FA_PVM(1, f.v, 8);
    SBAR();
    FA_W8(g, 0, 8); FA_PVM(2, g, 0);
    SBAR();
    FA_W8(g, 8, 0); FA_PVM(3, g, 8);
}
#define FA_K4S(F, B_, A, O0, O1, O2, O3) asm volatile("ds_read_b128 %0, %4 offset:" O0 "\n\tds_read_b128 %1, %4 offset:" O1 "\n\tds_read_b128 %2, %4 offset:" O2 "\n\tds_read_b128 %3, %4 offset:" O3 \
                                      : "=&v"(F[B_ + 0]), "=&v"(F[B_ + 1]), "=&v"(F[B_ + 2]), "=&v"(F[B_ + 3]) : "v"(A) : "memory")
#define FA_QK16(F, B_, ks) do { s[0] = __builtin_amdgcn_mfma_f32_16x16x32_bf16(F[B_ + 0], qh[ks], s[0], 0, 0, 0); s[1] = __builtin_amdgcn_mfma_f32_16x16x32_bf16(F[B_ + 1], qh[ks], s[1], 0, 0, 0); \
                                 s[2] = __builtin_amdgcn_mfma_f32_16x16x32_bf16(F[B_ + 2], qh[ks], s[2], 0, 0, 0); s[3] = __builtin_amdgcn_mfma_f32_16x16x32_bf16(F[B_ + 3], qh[ks], s[3], 0, 0, 0); } while (0)
__device__ __forceinline__ void qk16(f32x4* s, int a0, int a1, const bf16x8* qh) {
    s[0] = f32x4{0.f, 0.f, 0.f, 0.f}; s[1] = s[0]; s[2] = s[0]; s[3] = s[0];
    bf16x8 f[16];
    FA_K4S(f, 0, a0, "0", "4096", "8192", "12288"); FA_K4S(f, 4, a1, "0", "4096", "8192", "12288"); FA_K4S(f, 8, a0, "128", "4224", "8320", "12416");
    FA_W4(f, 0, 8); FA_QK16(f, 0, 0);
    SBAR();
    FA_W4(f, 4, 4); FA_K4S(f, 12, a1, "128", "4224", "8320", "12416"); FA_QK16(f, 4, 1);
    SBAR();
    FA_W4(f, 8, 4); FA_QK16(f, 8, 2);
    SBAR();
    FA_W4(f, 12, 0); FA_QK16(f, 12, 3);
}
__device__ __forceinline__ int v16_rd_base(int lane) { const int g4 = lane >> 4, q = (lane & 15) >> 2, p = lane & 3, k0 = 4 * g4 + q, kk0 = (k0 & ~0xC) | ((k0 & 4) << 1) | ((k0 & 8) >> 1); return ((kk0 >> 3) * 4) * 512 + ((kk0 & 7) * 32 + 4 * p) * 2; }
#define FA_V8H(F, B_, dbp) do { constexpr int b_ = (dbp) * 512; \
        asm volatile("ds_read_b64_tr_b16 %0, %8 offset:%9\n\tds_read_b64_tr_b16 %1, %8 offset:%10\n\tds_read_b64_tr_b16 %2, %8 offset:%11\n\tds_read_b64_tr_b16 %3, %8 offset:%12\n\t" \
                     "ds_read_b64_tr_b16 %4, %8 offset:%13\n\tds_read_b64_tr_b16 %5, %8 offset:%14\n\tds_read_b64_tr_b16 %6, %8 offset:%15\n\tds_read_b64_tr_b16 %7, %8 offset:%16" \
                     : "=&v"(F[B_ + 0]), "=&v"(F[B_ + 1]), "=&v"(F[B_ + 2]), "=&v"(F[B_ + 3]), "=&v"(F[B_ + 4]), "=&v"(F[B_ + 5]), "=&v"(F[B_ + 6]), "=&v"(F[B_ + 7]) \
                     : "v"(vb0), "i"(b_), "i"(b_ + 4096), "i"(b_ + 8192), "i"(b_ + 12288), "i"(b_ + 32), "i"(b_ + 32 + 4096), "i"(b_ + 32 + 8192), "i"(b_ + 32 + 12288) : "memory"); } while (0)
__device__ __forceinline__ void pv16_issue(int vb0, VPre& f) { FA_V8H(f.v, 0, 0); FA_V8H(f.v, 8, 1); }
#define FA_PVM16(db, F, B_) do { \
        o[db] = __builtin_amdgcn_mfma_f32_16x16x32_bf16(pa0, (bf16x8){F[B_+0][0], F[B_+0][1], F[B_+0][2], F[B_+0][3], F[B_+1][0], F[B_+1][1], F[B_+1][2], F[B_+1][3]}, o[db], 0, 0, 0);   \
        o[db] = __builtin_amdgcn_mfma_f32_16x16x32_bf16(pa1, (bf16x8){F[B_+2][0], F[B_+2][1], F[B_+2][2], F[B_+2][3], F[B_+3][0], F[B_+3][1], F[B_+3][2], F[B_+3][3]}, o[db], 0, 0, 0); } while (0)
__device__ __forceinline__ void pv16(f32x4* o, int vb0, bf16x8 pa0, bf16x8 pa1, VPre& f) {
    s16x4 g[16];
    FA_W8(f.v, 0, 0); FA_W8(f.v, 8, 0);
    FA_V8H(g, 0, 2); FA_V8H(g, 8, 3);
    SBAR();
    FA_PVM16(0, f.v, 0); FA_PVM16(1, f.v, 4); FA_PVM16(2, f.v, 8); FA_PVM16(3, f.v, 12);
    SBAR();
    FA_W8(g, 0, 8); FA_PVM16(4, g, 0); FA_PVM16(5, g, 4);
    SBAR();
    FA_W8(g, 8, 0); FA_PVM16(6, g, 8); FA_PVM16(7, g, 12);
}
__device__ __forceinline__ void sm16_max(const f32x4* s, float& m_reg, float& mn, float& alpha) {
    float pmax = fmaxf(fmaxf(s[0][0], s[0][1]), fmaxf(s[0][2], s[0][3]));
#pragma unroll
    for (int mb = 1; mb < 4; ++mb) pmax = fmaxf(pmax, fmaxf(fmaxf(s[mb][0], s[mb][1]), fmaxf(s[mb][2], s[mb][3])));
    pmax = fmaxf(pmax, xl_f<16>(pmax));
    { auto rr = __builtin_amdgcn_permlane32_swap(__float_as_uint(pmax), __float_as_uint(pmax), false, false); pmax = fmaxf(__uint_as_float(rr[0]), __uint_as_float(rr[1])); }
    if (__builtin_expect(__all((pmax - m_reg) * SCALE <= THR), 1)) { mn = m_reg; alpha = 1.f; }
    else { mn = fmaxf(m_reg, pmax); alpha = __builtin_amdgcn_exp2f((m_reg - mn) * C2); m_reg = mn; }
}
__device__ __forceinline__ void sm16_fin(f32x4* s, float mn, float alpha, bool rowsel, float& l_reg, bf16x8& pa0, bf16x8& pa1) {
    const float mnL = rowsel ? -mn * C2 : -__builtin_inff();
    float ps = 0.f;
#pragma unroll
    for (int mb = 0; mb < 4; ++mb)
#pragma unroll
        for (int j = 0; j < 4; ++j) { s[mb][j] = __builtin_amdgcn_exp2f(fmaf(s[mb][j], C2, mnL)); ps += s[mb][j]; }
    ps += xl_f<16>(ps); ps = x32_sum(ps);
    l_reg = l_reg * alpha + ps;
    { u32x4 w = {cvtpk(s[0][0], s[0][1]), cvtpk(s[0][2], s[0][3]), cvtpk(s[1][0], s[1][1]), cvtpk(s[1][2], s[1][3])}; pa0 = *reinterpret_cast<bf16x8*>(&w); }
    { u32x4 w = {cvtpk(s[2][0], s[2][1]), cvtpk(s[2][2], s[2][3]), cvtpk(s[3][0], s[3][1]), cvtpk(s[3][2], s[3][3])}; pa1 = *reinterpret_cast<bf16x8*>(&w); }
}
__device__ __forceinline__ void rescale16(f32x4* o, float alpha, float l_prev, volatile FA_LAS float* al16, int n16, int g4) {
    if (__any(alpha < 1.f && l_prev > 0.f)) { if (g4 == 0) al16[n16] = alpha; asm volatile("s_waitcnt lgkmcnt(0)" ::: "memory");
        const float a0 = al16[4 * g4], a1 = al16[4 * g4 + 1], a2 = al16[4 * g4 + 2], a3 = al16[4 * g4 + 3];
#pragma unroll
        for (int db = 0; db < 8; ++db) { o[db][0] *= a0; o[db][1] *= a1; o[db][2] *= a2; o[db][3] *= a3; }
        asm volatile("s_waitcnt lgkmcnt(0)" ::: "memory"); }
}
struct DmaOff { unsigned k0, k1, v0, v1; };
__device__ __forceinline__ DmaOff dma_offsets(int wid, int lane) {
    DmaOff d; unsigned ko[2], vo[2];
#pragma unroll
    for (int i = 0; i < 2; ++i) { const int q = (2 * wid + i) * 64 + lane;
        { const int row = q >> 4, c16 = (q & 15) ^ (row & 7); ko[i] = (unsigned)(row * 256 + c16 * 16); }
        { const int sub = q >> 5, kk = (sub >> 2) * 8 + ((q & 31) >> 2), c = (sub & 3) * 32 + (q & 3) * 8, k = (kk & ~0xC) | ((kk & 4) << 1) | ((kk & 8) >> 1); vo[i] = (unsigned)(k * 256 + c * 2); } }
    d.k0 = ko[0]; d.k1 = ko[1]; d.v0 = vo[0]; d.v1 = vo[1]; return d;
}
__device__ __forceinline__ void dma_k(const char* src_tile, FA_LAS char* img, int wid, const DmaOff& d) {
    __builtin_amdgcn_global_load_lds((const unsigned*)(src_tile + d.k0), (FA_LAS unsigned*)(img + (2 * wid) * 1024), 16, 0, 0);
    __builtin_amdgcn_global_load_lds((const unsigned*)(src_tile + d.k1), (FA_LAS unsigned*)(img + (2 * wid + 1) * 1024), 16, 0, 0);
}
__device__ __forceinline__ void dma_v(const char* src_tile, FA_LAS char* img, int wid, const DmaOff& d) {
    __builtin_amdgcn_global_load_lds((const unsigned*)(src_tile + d.v0), (FA_LAS unsigned*)(img + (2 * wid) * 1024), 16, 0, 0);
    __builtin_amdgcn_global_load_lds((const unsigned*)(src_tile + d.v1), (FA_LAS unsigned*)(img + (2 * wid + 1) * 1024), 16, 0, 0);
}
#define FA_DMA_SYNC() do { asm volatile("s_waitcnt vmcnt(0)" ::: "memory"); __syncthreads(); } while (0)
__device__ __forceinline__ void rescale_o(f32x16* o, float alpha, float l_prev, volatile FA_LAS float* al_l, int r32, int hi) {
    if (__any(alpha < 1.f && l_prev > 0.f)) { if (hi == 0) al_l[r32] = alpha; asm volatile("s_waitcnt lgkmcnt(0)" ::: "memory");
#pragma unroll
        for (int d_ = 0; d_ < 4; ++d_)
#pragma unroll
            for (int r = 0; r < 16; ++r) o[d_][r] *= al_l[crow(r, hi)];
        asm volatile("s_waitcnt lgkmcnt(0)" ::: "memory"); }
}

struct BandArgs { const bf16* Q; const bf16* K; const bf16* V; bf16* O; size_t o_stride; float* lse; size_t lse_stride; int P0, W, mode; float sink;
                  const bf16* nK; const bf16* nV; int nP0, nW, has_next, prefetched; };
__device__ __forceinline__ void banded_unit(FA_LAS char* lds, const BandArgs& a) {
    int tid_ = threadIdx.x; asm volatile("" : "+v"(tid_));
    const int tid = tid_, wid = __builtin_amdgcn_readfirstlane(tid >> 6), lane = tid & 63, r32 = lane & 31, hi = lane >> 5;
    const int P0 = a.P0, W = a.W;
    const int lowk = P0 - W + 1, j_lo = lowk > 0 ? (lowk >> 6) : 0, j_hi = (P0 >> 6) + 4, NT = j_hi - j_lo;
    const int qlo = P0 + wid * 32, qm = qlo + r32 - 4 * hi;
    const FA_LAS char* V_lds = lds + OFF_V; const FA_LAS char* K_lds = lds + OFF_K;
    volatile FA_LAS float* ws = (volatile FA_LAS float*)(lds + OFF_WS + wid * WS_PER_WAVE); volatile FA_LAS float* li_l = ws; volatile FA_LAS float* al_l = ws + 32; volatile FA_LAS float* co_l = ws + 64;
    const int vb0 = (int)(unsigned)(uintptr_t)V_lds + v_rd_base(lane);
    const DmaOff dof = dma_offsets(wid, lane);
    bf16x8 qr[8];
#pragma unroll
    for (int d0 = 0; d0 < 8; ++d0) qr[d0] = *(const bf16x8*)(a.Q + (size_t)(qlo + r32) * D + d0 * 16 + hi * 8);
    float m_reg = -1e30f, l_reg = 0.f; f32x16 o[4] = {};
#define FA_DMA_PAIR(K_, V_, kbA_, kbB_, off_) do { const char* ka_ = (const char*)(K_) + (size_t)(kbA_) * (D * 2); const char* kb_ = (const char*)(K_) + (size_t)(kbB_) * (D * 2); \
        const char* va_ = (const char*)(V_) + (size_t)(kbA_) * (D * 2); const char* vb_ = (const char*)(V_) + (size_t)(kbB_) * (D * 2); \
        dma_k(ka_, lds + (off_) + OFF_K, wid, dof); dma_k(kb_, lds + (off_) + OFF_K + SHM_K, wid, dof); dma_v(va_, lds + (off_) + OFF_V, wid, dof); dma_v(vb_, lds + (off_) + OFF_V + SHM_V, wid, dof); } while (0)
#define FA_BAND_TILE(kb, off_) do { const bool act = ((kb) <= qlo + 31) && ((kb) + 63 >= qlo - W + 1);     \
        if (act) { f32x16 p0, p1; float mn, alpha; bf16x8 pa0, pa1, pa2, pa3; \
            qkt(p0, p1, K_lds + (off_), r32, hi, qr); VPre vf_; pv_issue(vb0 + (off_), vf_); \
            if ((kb) + 63 > qlo || (kb) <= qlo + 31 - W) mask_tile(p0, p1, qm - (kb), (unsigned)W); \
            partialSM(p0, p1, m_reg, mn, alpha); rescale_o(o, alpha, l_reg, al_l, r32, hi); finishSM(p0, p1, alpha, l_reg, pa0, pa1, pa2, pa3); \
            pv_tile(o, vb0 + (off_), pa0, pa1, pa2, pa3, vf_); } } while (0)
    const int NP = NT >> 1;
    if (!a.prefetched) FA_DMA_PAIR(a.K, a.V, j_lo * 64, (j_lo + NP) * 64, 0);
    FA_DMA_SYNC();
    for (int ip = 0; ip < NP; ++ip) {
        const int so = (ip & 1) * SLOT, kbA = (j_lo + ip) * 64, kbB = (j_lo + ip + NP) * 64;
        if (ip + 1 < NP) FA_DMA_PAIR(a.K, a.V, kbA + 64, kbB + 64, so ^ SLOT);
        { FA_BAND_TILE(kbA, so); FA_BAND_TILE(kbB, so + SHM_K); }
        FA_DMA_SYNC();
    }
    if (a.has_next) {
        const int nlow = a.nP0 - a.nW + 1, njl = nlow > 0 ? (nlow >> 6) : 0, nNP = (((a.nP0 >> 6) + 4) - njl) >> 1;
        FA_DMA_PAIR(a.nK, a.nV, njl * 64, (njl + nNP) * 64, 0); }
#undef FA_DMA_PAIR
#undef FA_BAND_TILE
    const int mode = a.mode; float coef, cold = 0.f;
    const size_t urow = (size_t)(qlo + r32);
    if (mode == 1) { coef = 1.0f / (l_reg + __builtin_amdgcn_exp2f(a.sink * 1.4426950408889634f - m_reg * C2)); }
    else if (mode == 2) { coef = 1.0f / l_reg; if (hi == 0) a.lse[urow * a.lse_stride] = m_reg * SCALE + __logf(l_reg); }
    else if (mode == 3) { const float lg = m_reg * SCALE + __logf(l_reg), lo_ = a.lse[urow * a.lse_stride], mx = fmaxf(lg, lo_), e0 = __expf(lo_ - mx), e1 = __expf(lg - mx), inv = 1.0f / (e0 + e1);
        cold = e0 * inv; coef = e1 * inv / l_reg; if (hi == 0) a.lse[urow * a.lse_stride] = mx + __logf(e0 + e1); }
    else coef = 1.0f / l_reg;
    if (hi == 0) { li_l[r32] = coef; co_l[r32] = cold; }
    asm volatile("s_waitcnt lgkmcnt(0)" ::: "memory");
    unsigned oldw[16][2];
    if (mode == 3) {
#pragma unroll
        for (int r = 0; r < 16; ++r) { const bf16* Ow = a.O + (size_t)(qlo + crow(r, hi)) * a.o_stride;
#pragma unroll
            for (int dp = 0; dp < 2; ++dp) oldw[r][dp] = *(const unsigned*)(Ow + (2 * dp + (r32 & 1)) * 32 + (r32 & ~1)); } }
#pragma unroll
    for (int r = 0; r < 16; ++r) { const int orow = crow(r, hi); const float cf = li_l[orow], co = co_l[orow];
        bf16* Ow = a.O + (size_t)(qlo + orow) * a.o_stride;
#pragma unroll
        for (int dp = 0; dp < 2; ++dp) {
            const float va = o[2 * dp][r] * cf, vb = o[2 * dp + 1][r] * cf, xa = xl_f<1>(va), xb = xl_f<1>(vb);
            const bool odd = (r32 & 1) != 0; float x0 = odd ? xb : va, x1 = odd ? vb : xa;
            if (mode == 3) { const unsigned old = oldw[r][dp]; x0 += co * __uint_as_float(old << 16); x1 += co * __uint_as_float(old & 0xffff0000u); }
            *(unsigned*)(Ow + (2 * dp + (r32 & 1)) * 32 + (r32 & ~1)) = cvtpk(x0, x1); } }
    asm volatile("s_waitcnt lgkmcnt(0)" ::: "memory");
    if (!a.has_next) __syncthreads();
}

constexpr int NSA_OFF_IMP = SLOT;
constexpr int NSA_OFF_SEL = 2 * SLOT;
constexpr int NSA_OFF_UNI = NSA_OFF_SEL + 2048;
constexpr int NSA_OFF_LIST = NSA_OFF_UNI + 64;
constexpr int NSA_OFF_WUN = NSA_OFF_LIST + 1024;
constexpr int NSA_OFF_AM = NSA_OFF_WUN + 256;
constexpr int NSA_BYTES = ENGINE_BYTES;
static_assert(NSA_OFF_AM + 256 <= OFF_WS, "NSA LDS map");
struct NsaArgs { const bf16* QA; const bf16* KA; const bf16* VA; const bf16* kc; const bf16* vc; const float* gates; const bf16* owin; bf16* ocat; int b, g, t0; bf16* dbg_stash; unsigned* dbg_sel; int dry;   };
__device__ __forceinline__ void nsa_unit(FA_LAS char* lds, const NsaArgs& a) {
    int tid_ = threadIdx.x; asm volatile("" : "+v"(tid_));
    const int tid = tid_, wid = __builtin_amdgcn_readfirstlane(tid >> 6), lane = tid & 63, r32 = lane & 31, hi = lane >> 5;
    const int b = a.b, g = a.g, t0 = a.t0, bg = b * 2 + g;
    const int hq = r32 >> 3, qq = r32 & 7, tq = t0 + 8 * wid + qq, head = g * 4 + hq;
    const int cur = t0 >> 6;
    const FA_LAS char* V_lds = lds + OFF_V; const FA_LAS char* K_lds = lds + OFF_K;
    volatile FA_LAS float* ws = (volatile FA_LAS float*)(lds + OFF_WS + wid * WS_PER_WAVE); volatile FA_LAS float* li_l = ws; volatile FA_LAS float* al_l = ws + 32; volatile FA_LAS float* g1_l = ws + 64; volatile FA_LAS float* g2_l = ws + 96;
    FA_LAS float* impw = (FA_LAS float*)(lds + NSA_OFF_IMP + wid * 8192);
    FA_LAS unsigned* selw = (FA_LAS unsigned*)(lds + NSA_OFF_SEL + wid * 256);
    FA_LAS unsigned* uni = (FA_LAS unsigned*)(lds + NSA_OFF_UNI);
    FA_LAS int* blist = (FA_LAS int*)(lds + NSA_OFF_LIST);
    const int vb0 = (int)(unsigned)(uintptr_t)V_lds + v_rd_base(lane);
    const DmaOff dof = dma_offsets(wid, lane);
    bf16x8 qr[8];
#pragma unroll
    for (int d0 = 0; d0 < 8; ++d0) qr[d0] = *(const bf16x8*)(a.QA + ((size_t)(b * 8 + head) * T + tq) * D + d0 * 16 + hi * 8);
    if (tid < 16) uni[tid] = 0u;
    const bf16* Kc = a.kc + (size_t)bg * 1024 * D; const bf16* Vc = a.vc + (size_t)bg * 1024 * D;
    const int n_ct = ((t0 + 32) >> 10) + 1;
    const int cvis = tq >= 31 ? ((tq - 31) >> 4) : -1;
#define FA_DMA_KT(P, kb0, bf) dma_k((const char*)(P) + (size_t)(kb0) * (D * 2), lds + OFF_K + (bf) * SHM_K, wid, dof)
#define FA_DMA_VT(P, kb0, bf) dma_v((const char*)(P) + (size_t)(kb0) * (D * 2), lds + OFF_V + (bf) * SHM_V, wid, dof)
    float m_reg = -1e30f, l_reg = 0.f;
    FA_DMA_KT(Kc, 0, 0);
    FA_DMA_SYNC();
    for (int j = 0; j < n_ct; ++j) {
        const int buf = j & 1;
        if (j + 1 < n_ct) FA_DMA_KT(Kc, (j + 1) * 64, buf ^ 1);
        { f32x16 p0, p1; float mn, alpha; bf16x8 pa0, pa1, pa2, pa3;
          qkt(p0, p1, K_lds + buf * SHM_K, r32, hi, qr);
          mask_gt(p0, p1, cvis - j * 64, hi);
          partialSM(p0, p1, m_reg, mn, alpha);
          finishSM(p0, p1, alpha, l_reg, pa0, pa1, pa2, pa3); }
        FA_DMA_SYNC();
    }
    const float inv_l = l_reg > 0.f ? 1.0f / l_reg : 0.f, mnL = -m_reg * C2;
    f32x16 o[4] = {};
    float carry = 0.f;
    FA_DMA_KT(Kc, 0, 0); FA_DMA_VT(Vc, 0, 0);
    FA_DMA_SYNC();
    for (int j = 0; j < n_ct; ++j) {
        const int buf = j & 1;
        if (j + 1 < n_ct) { FA_DMA_KT(Kc, (j + 1) * 64, buf ^ 1); FA_DMA_VT(Vc, (j + 1) * 64, buf ^ 1); }
        { f32x16 p0, p1; bf16x8 pa0, pa1, pa2, pa3;
          qkt(p0, p1, K_lds + buf * SHM_K, r32, hi, qr);
          mask_gt(p0, p1, cvis - j * 64, hi);
#pragma unroll
          for (int r = 0; r < 16; ++r) { p0[r] = __builtin_amdgcn_exp2f(fmaf(p0[r], C2, mnL)) * inv_l; p1[r] = __builtin_amdgcn_exp2f(fmaf(p1[r], C2, mnL)) * inv_l; }
          float Av[8], Xv[8];
#pragma unroll
          for (int i = 0; i < 4; ++i) { Av[i] = (p0[4 * i] + p0[4 * i + 1]) + (p0[4 * i + 2] + 0.5f * p0[4 * i + 3]); Xv[i] = 0.5f * p0[4 * i + 3];
                                        Av[4 + i] = (p1[4 * i] + p1[4 * i + 1]) + (p1[4 * i + 2] + 0.5f * p1[4 * i + 3]); Xv[4 + i] = 0.5f * p1[4 * i + 3]; }
#pragma unroll
          for (int i = 0; i < 8; ++i) Xv[i] = __uint_as_float(x32_u(__float_as_uint(Xv[i]), hi));
#pragma unroll
          for (int i = 0; i < 8; ++i) { float v = Av[i] + (hi ? Xv[i] : (i > 0 ? Xv[i - 1] : carry));
              v += xl_f<8>(v); v += xl_f<16>(v);
              if (r32 < 8) impw[r32 * 256 + 16 * j + 2 * i + hi] = v; }
          carry = Xv[7];
          packP(p0, p1, pa0, pa1, pa2, pa3);
          VPre vf_; pv_issue(vb0 + buf * SHM_V, vf_); pv_tile(o, vb0 + buf * SHM_V, pa0, pa1, pa2, pa3, vf_); }
        FA_DMA_SYNC();
    }
    { const float* gp = a.gates + ((size_t)(b * T + tq)) * 24 + head * 3; if (hi == 0) { li_l[r32] = gp[0]; g1_l[r32] = gp[1]; g2_l[r32] = gp[2]; } }
    asm volatile("s_waitcnt lgkmcnt(0)" ::: "memory");
#pragma unroll
    for (int r = 0; r < 16; ++r) { const int rho = crow(r, hi); const float gc = li_l[rho];
        const size_t trow = (size_t)(b * T + t0 + 8 * wid + (rho & 7)); const int hh = g * 4 + (rho >> 3);
        bf16* Ow = a.ocat + trow * 2048 + hh * 128;
#pragma unroll
        for (int dp = 0; dp < 2; ++dp) {
            const float va = o[2 * dp][r] * gc, vb = o[2 * dp + 1][r] * gc, xa = xl_f<1>(va), xb = xl_f<1>(vb);
            const bool odd = (r32 & 1) != 0; const unsigned w = cvtpk(odd ? xb : va, odd ? vb : xa); const int co = (2 * dp + (r32 & 1)) * 32 + (r32 & ~1);
            if (!a.dry) *(unsigned*)(Ow + co) = w;
            if (a.dbg_stash) *(unsigned*)(a.dbg_stash + trow * 1024 + hh * 128 + co) = w; } }
    asm volatile("s_waitcnt lgkmcnt(0)" ::: "memory");
    unsigned selbits = 0u;
    { const int qq8 = lane >> 3, sub = lane & 7;
      if (cur + 1 <= 16) { selbits = (sub == 0) ? ((cur + 1 >= 32) ? 0xffffffffu : ((1u << (cur + 1)) - 1u)) : 0u; }
      else {
        float v[32];
#pragma unroll
        for (int i4 = 0; i4 < 8; ++i4) { const f32x4 x = *(const FA_LAS f32x4*)(impw + qq8 * 256 + sub * 32 + i4 * 4); v[4 * i4] = x[0]; v[4 * i4 + 1] = x[1]; v[4 * i4 + 2] = x[2]; v[4 * i4 + 3] = x[3]; }
#pragma unroll
        for (int i = 0; i < 32; ++i) { const int n = sub * 32 + i; v[i] = (n == 0 || n == cur || n == cur - 1) ? __builtin_inff() : (n <= cur ? v[i] : -__builtin_inff()); }
        for (int round = 0; round < 16; ++round) {
            float bv = -__builtin_inff(); int bn = sub * 32;
#pragma unroll
            for (int i = 0; i < 32; ++i) { const bool take = (((selbits >> i) & 1u) == 0u) && (v[i] > bv); bv = take ? v[i] : bv; bn = take ? sub * 32 + i : bn; }
#define TOPK_STEP(S_) do { const float ov = xl_f<S_>(bv); const int on = (int)xl_u<S_>((unsigned)bn); const bool better = (ov > bv) || (ov == bv && on < bn); bv = better ? ov : bv; bn = better ? on : bn; } while (0)
            TOPK_STEP(1); TOPK_STEP(2); TOPK_STEP(4);
#undef TOPK_STEP
            if ((bn >> 5) == sub) selbits |= 1u << (bn & 31);
        }
      }
      selw[qq8 * 8 + sub] = selbits; if (a.dbg_sel) a.dbg_sel[((size_t)bg * T + t0 + 8 * wid + qq8) * 8 + sub] = selbits; }
    if (a.dry == 1) { __syncthreads(); return; }
    unsigned wh = selbits; wh |= xl_u<8>(wh); wh |= xl_u<16>(wh);
    unsigned wuni = x32_or(wh);
    FA_LAS unsigned* wun = (FA_LAS unsigned*)(lds + NSA_OFF_WUN); FA_LAS unsigned char* am = (FA_LAS unsigned char*)(lds + NSA_OFF_AM);
    if (lane < 8) { __hip_atomic_fetch_or(uni + lane, wuni, __ATOMIC_RELAXED, __HIP_MEMORY_SCOPE_WORKGROUP); wun[wid * 8 + lane] = wuni; }
    __syncthreads();
    { unsigned w8[8]; int tot = 0;
#pragma unroll
      for (int k = 0; k < 8; ++k) w8[k] = uni[k];
#pragma unroll
      for (int k = 0; k < 8; ++k) tot += __popc(w8[k]);
      const bool greedy = cur + 1 >= 150;
      if (tid < 256) { const int n = tid; int pos = 0; unsigned mine = 0, msk = 0;
#pragma unroll
          for (int k = 0; k < 8; ++k) { if (k < (n >> 5)) pos += __popc(w8[k]); if (k == (n >> 5)) mine = w8[k]; }
#pragma unroll
          for (int w = 0; w < 8; ++w) msk |= ((wun[w * 8 + (n >> 5)] >> (n & 31)) & 1u) << w;
          am[n] = (unsigned char)msk;
          if (!greedy && ((mine >> (n & 31)) & 1u)) { pos += __popc(mine & ((1u << (n & 31)) - 1u)); blist[pos] = n; } }
      if (!greedy) { if (tid == 0) { uni[8] = (unsigned)((tot + 1) >> 1); if (tot & 1) blist[tot] = -1; } }
      __syncthreads();
      if (greedy && wid == 0) {
          const unsigned m4 = ((const FA_LAS unsigned*)am)[lane];
          unsigned alive = ((m4 & 0xffu) ? 1u : 0u) | ((m4 & 0xff00u) ? 2u : 0u) | ((m4 & 0xff0000u) ? 4u : 0u) | ((m4 & 0xff000000u) ? 8u : 0u);
          int np = 0;
          for (;;) {
              const unsigned long long bal = __ballot(alive != 0u); if (bal == 0ull) break;
              const int Lx = __builtin_ctzll(bal); const int fj = alive ? __builtin_ctz(alive) : 0;
              const unsigned mx = (unsigned)__builtin_amdgcn_readlane((int)((m4 >> (8 * fj)) & 0xffu), Lx); const int nx = __builtin_amdgcn_readlane(4 * lane + fj, Lx);
              if (lane == Lx) alive &= ~(1u << fj);
              unsigned cand = 0u;
#pragma unroll
              for (int j = 0; j < 4; ++j) if (((alive >> j) & 1u) && ((((m4 >> (8 * j)) & 0xffu) & mx) == 0u)) cand |= 1u << j;
              unsigned long long bal2 = __ballot(cand != 0u); unsigned pick = cand;
              if (bal2 == 0ull) { bal2 = __ballot(alive != 0u); pick = alive; }
              int ny = -1;
              if (bal2 != 0ull) { const int Ly = __builtin_ctzll(bal2); const int cj = pick ? __builtin_ctz(pick) : 0; ny = __builtin_amdgcn_readlane(4 * lane + cj, Ly); if (lane == Ly) alive &= ~(1u << cj); }
              if (lane == 0) { blist[2 * np] = nx; blist[2 * np + 1] = ny; }
              ++np; }
          if (lane == 0) uni[8] = (unsigned)np; } }
    __syncthreads();
    const int npair = __builtin_amdgcn_readfirstlane((int)uni[8]);
    const bf16* Ks = a.KA + (size_t)(b * 6 + 2 + g) * T * D; const bf16* Vs = a.VA + (size_t)(b * 6 + 2 + g) * T * D;
    const int n16 = lane & 15, g4 = lane >> 4;
    bf16x8 qh[2][4];
#pragma unroll
    for (int hf = 0; hf < 2; ++hf)
#pragma unroll
        for (int ks = 0; ks < 4; ++ks) qh[hf][ks] = *(const bf16x8*)(a.QA + ((size_t)(b * 8 + g * 4 + (n16 >> 2)) * T + (t0 + 8 * wid + 4 * hf + (n16 & 3))) * D + ks * 32 + 8 * g4);
    float m_h[2] = {-1e30f, -1e30f}, l_h[2] = {0.f, 0.f};
    f32x4 oh[2][8];
#pragma unroll
    for (int hf = 0; hf < 2; ++hf)
#pragma unroll
        for (int db = 0; db < 8; ++db) oh[hf][db] = f32x4{0.f, 0.f, 0.f, 0.f};
    const int kx = ((g4 * 16) ^ ((n16 & 7) << 4)), kt0 = (int)(unsigned)(uintptr_t)K_lds + n16 * 256, ka0 = kt0 + kx, ka1 = kt0 + (kx ^ 64);
    const int vb16 = (int)(unsigned)(uintptr_t)V_lds + v16_rd_base(lane);
#define FA_DMA_BLK(n_, off_) do { const char* kb_ = (const char*)Ks + (size_t)(n_) * 64 * (D * 2); const char* vb_ = (const char*)Vs + (size_t)(n_) * 64 * (D * 2); \
        dma_k(kb_, lds + (off_) + OFF_K, wid, dof); dma_v(vb_, lds + (off_) + OFF_V, wid, dof); } while (0)
#define FA_SEL_HALF(hf, n_, off_) do { const unsigned hword = (unsigned)__builtin_amdgcn_readlane((int)wh, (hf) * 32 + ((n_) >> 5)); \
        if ((hword >> ((n_) & 31)) & 1u) { f32x4 s[4]; float mn, alpha; bf16x8 pa0, pa1; \
            qk16(s, ka0 + (off_), ka1 + (off_), qh[hf]); VPre vf_; pv16_issue(vb16 + (off_), vf_); \
            const unsigned myw = selw[(4 * (hf) + (n16 & 3)) * 8 + ((n_) >> 5)]; \
            const bool rowsel = ((myw >> ((n_) & 31)) & 1u) != 0u;                          \
            if ((n_) == cur) { const int lim = 8 * wid + 4 * (hf) + (n16 & 3);               \
                _Pragma("unroll") for (int mb = 0; mb < 4; ++mb) _Pragma("unroll") for (int j = 0; j < 4; ++j) if (mb * 16 + 4 * g4 + j > lim) s[mb][j] = -__builtin_inff(); } \
            sm16_max(s, m_h[hf], mn, alpha); rescale16(oh[hf], alpha, l_h[hf], al_l + 16 * (hf), n16, g4); sm16_fin(s, mn, alpha, rowsel, l_h[hf], pa0, pa1); \
            pv16(oh[hf], vb16 + (off_), pa0, pa1, vf_); } } while (0)
#define FA_SEL_TILE(n_, off_) do { FA_SEL_HALF(0, n_, off_); FA_SEL_HALF(1, n_, off_); } while (0)
    int na = __builtin_amdgcn_readfirstlane(blist[0]), nb = __builtin_amdgcn_readfirstlane(blist[1]);
    FA_DMA_BLK(na, 0); FA_DMA_BLK(nb >= 0 ? nb : na, SHM_K);
    FA_DMA_SYNC();
    for (int ip = 0; ip < npair; ++ip) {
        const int so = (ip & 1) * SLOT; int ma = na, mb = nb;
        if (ip + 1 < npair) { ma = __builtin_amdgcn_readfirstlane(blist[2 * ip + 2]); mb = __builtin_amdgcn_readfirstlane(blist[2 * ip + 3]); if (a.dry != 2) { FA_DMA_BLK(ma, so ^ SLOT); FA_DMA_BLK(mb >= 0 ? mb : ma, (so ^ SLOT) + SHM_K); } }
        if (a.dry != 3) { FA_SEL_TILE(na, so);
        if (nb >= 0) FA_SEL_TILE(nb, so + SHM_K); }
        na = ma; nb = mb;
        FA_DMA_SYNC();
    }
#undef FA_DMA_BLK
#undef FA_SEL_TILE
#undef FA_SEL_HALF
#undef FA_DMA_KT
#undef FA_DMA_VT
    if (a.dry) { asm volatile("" :: "v"(oh[0][0]), "v"(oh[0][7]), "v"(oh[1][0]), "v"(oh[1][7]), "v"(l_h[0]), "v"(l_h[1])); __syncthreads(); return; }
    if (g4 == 0) {
#pragma unroll
        for (int hf = 0; hf < 2; ++hf) { const int rho = (n16 >> 2) * 8 + 4 * hf + (n16 & 3); li_l[rho] = l_h[hf] > 0.f ? g1_l[rho] / l_h[hf] : 0.f; } }
    asm volatile("s_waitcnt lgkmcnt(0)" ::: "memory");
    { unsigned oldw[2][4][4], winw[2][4][4];
#pragma unroll
      for (int hf = 0; hf < 2; ++hf)
#pragma unroll
        for (int j = 0; j < 4; ++j) { const int m = 4 * g4 + j; const size_t trow = (size_t)(b * T + t0 + 8 * wid + 4 * hf + (m & 3)); const int hh = g * 4 + (m >> 2);
#pragma unroll
          for (int k = 0; k < 4; ++k) { const int co = (2 * k + (n16 & 1)) * 16 + (n16 & ~1); oldw[hf][k][j] = *(const unsigned*)(a.ocat + trow * 2048 + hh * 128 + co); winw[hf][k][j] = *(const unsigned*)(a.owin + trow * 1024 + hh * 128 + co); } }
#pragma unroll
      for (int hf = 0; hf < 2; ++hf)
#pragma unroll
        for (int j = 0; j < 4; ++j) { const int m = 4 * g4 + j, rho = (m >> 2) * 8 + 4 * hf + (m & 3); const float cs = li_l[rho], gw = g2_l[rho];
          const size_t trow = (size_t)(b * T + t0 + 8 * wid + 4 * hf + (m & 3)); const int hh = g * 4 + (m >> 2);
#pragma unroll
          for (int k = 0; k < 4; ++k) { const float va = oh[hf][2 * k][j] * cs, vb = oh[hf][2 * k + 1][j] * cs, xa = xl_f<1>(va), xb = xl_f<1>(vb);
              const bool odd = (n16 & 1) != 0; const unsigned old = oldw[hf][k][j], wv = winw[hf][k][j];
              const float x0 = (odd ? xb : va) + __uint_as_float(old << 16) + gw * __uint_as_float(wv << 16), x1 = (odd ? vb : xa) + __uint_as_float(old & 0xffff0000u) + gw * __uint_as_float(wv & 0xffff0000u);
              *(unsigned*)(a.ocat + trow * 2048 + hh * 128 + (2 * k + (n16 & 1)) * 16 + (n16 & ~1)) = cvtpk(x0, x1); } } }
    asm volatile("s_waitcnt lgkmcnt(0)" ::: "memory");
    __syncthreads();
}

__device__ __forceinline__ void compress_task(FA_LAS char* lds, const bf16* src  , const float* pe, const bf16* w1t  , const bf16* w2t  , bf16* dst  , int rb) {
    int tid_ = threadIdx.x; asm volatile("" : "+v"(tid_));
    const int tid = tid_, wid = __builtin_amdgcn_readfirstlane(tid >> 6), lane = tid & 63, r32 = lane & 31, hi = lane >> 5;
    const int m0 = rb * 32, bg = m0 >> 10, c0 = m0 & 1023, b = bg >> 1, g = bg & 1;
    const bf16* arow = src + (size_t)(b * 6 + g) * T * D + (size_t)(c0 + r32) * 2048;
    f32x16 acc[4] = {};
    const int kbeg = wid * 512;
#pragma unroll 4
    for (int ks = 0; ks < 32; ++ks) { const int k = kbeg + ks * 16 + hi * 8;
        const bf16x8 raw = *(const bf16x8*)(arow + k); const f32x4 pe0 = *(const f32x4*)(pe + k), pe1 = *(const f32x4*)(pe + k + 4);
        u32x4 w; w.x = cvtpk(bf2f((unsigned short)raw[0]) + pe0[0], bf2f((unsigned short)raw[1]) + pe0[1]); w.y = cvtpk(bf2f((unsigned short)raw[2]) + pe0[2], bf2f((unsigned short)raw[3]) + pe0[3]);
        w.z = cvtpk(bf2f((unsigned short)raw[4]) + pe1[0], bf2f((unsigned short)raw[5]) + pe1[1]); w.w = cvtpk(bf2f((unsigned short)raw[6]) + pe1[2], bf2f((unsigned short)raw[7]) + pe1[3]);
        const bf16x8 af = *reinterpret_cast<bf16x8*>(&w);
#pragma unroll
        for (int nt = 0; nt < 4; ++nt) { const bf16x8 bfr = *(const bf16x8*)(w1t + (size_t)(nt * 32 + r32) * 4096 + k); acc[nt] = __builtin_amdgcn_mfma_f32_32x32x16_bf16(af, bfr, acc[nt], 0, 0, 0); } }
    FA_LAS float* part = (FA_LAS float*)lds;
#pragma unroll
    for (int nt = 0; nt < 4; ++nt)
#pragma unroll
        for (int r = 0; r < 16; ++r) part[wid * 4096 + crow(r, hi) * 128 + nt * 32 + r32] = acc[nt][r];
    __syncthreads();
    FA_LAS bf16* G = (FA_LAS bf16*)(lds + 131072);
    { const int e = tid * 8, m = e >> 7, n = e & 127; f32x4 s0 = {0.f, 0.f, 0.f, 0.f}, s1 = {0.f, 0.f, 0.f, 0.f};
#pragma unroll
      for (int w = 0; w < 8; ++w) { s0 += *(const FA_LAS f32x4*)(part + w * 4096 + e); s1 += *(const FA_LAS f32x4*)(part + w * 4096 + e + 4); }
      float x[8] = {s0[0], s0[1], s0[2], s0[3], s1[0], s1[1], s1[2], s1[3]};
#pragma unroll
      for (int j = 0; j < 8; ++j) { const float u = 0.7978845608028654f * (x[j] + 0.044715f * x[j] * x[j] * x[j]); const float th = 1.0f - 2.0f / (__expf(2.0f * u) + 1.0f); x[j] = 0.5f * x[j] * (1.0f + th); }
      u32x4 w; w.x = cvtpk(x[0], x[1]); w.y = cvtpk(x[2], x[3]); w.z = cvtpk(x[4], x[5]); w.w = cvtpk(x[6], x[7]);
      *(FA_LAS u32x4*)(G + m * 136 + n) = w; }
    __syncthreads();
    if (wid < 4) { f32x16 c = {};
#pragma unroll
        for (int ks = 0; ks < 8; ++ks) { const bf16x8 af = *(const FA_LAS bf16x8*)(G + r32 * 136 + ks * 16 + hi * 8); const bf16x8 bfr = *(const bf16x8*)(w2t + (size_t)(wid * 32 + r32) * 128 + ks * 16 + hi * 8);
            c = __builtin_amdgcn_mfma_f32_32x32x16_bf16(af, bfr, c, 0, 0, 0); }
#pragma unroll
        for (int r = 0; r < 16; ++r) { const float v = c[r], vn = xl_f<1>(v);
            if ((r32 & 1) == 0) *(unsigned*)(dst + (size_t)(m0 + crow(r, hi)) * 128 + wid * 32 + r32) = cvtpk(v, vn); } }
    __syncthreads();
}

__device__ __forceinline__ void gate_task(const unsigned char* x8, const unsigned char* wg8, float* gates, float dq, int row0) {
    typedef int v8i_ __attribute__((ext_vector_type(8)));
    int tid_ = threadIdx.x; asm volatile("" : "+v"(tid_));
    const int tid = tid_, wid = __builtin_amdgcn_readfirstlane(tid >> 6), lane = tid & 63, i16 = lane & 15, g = lane >> 4;
    { const int r0 = row0 + wid * 16;
        f32x4 c0 = {0.f, 0.f, 0.f, 0.f}, c1 = {0.f, 0.f, 0.f, 0.f};
        const unsigned char* ap = x8 + (size_t)(r0 + i16) * 2048 + 32 * g; const unsigned char* bp0 = wg8 + (size_t)i16 * 2048 + 32 * g; const unsigned char* bp1 = wg8 + (size_t)(16 + (i16 & 7)) * 2048 + 32 * g;
#pragma unroll 4
        for (int ks = 0; ks < 16; ++ks) { const v8i_ a = *(const v8i_*)(ap + ks * 128), b0 = *(const v8i_*)(bp0 + ks * 128), b1 = *(const v8i_*)(bp1 + ks * 128);
            c0 = __builtin_amdgcn_mfma_scale_f32_16x16x128_f8f6f4(a, b0, c0, 0, 0, 0, 0, 0, 0); c1 = __builtin_amdgcn_mfma_scale_f32_16x16x128_f8f6f4(a, b1, c1, 0, 0, 0, 0, 0, 0); }
#pragma unroll
        for (int j = 0; j < 4; ++j) { float* gp = gates + (size_t)(r0 + 4 * g + j) * 24; gp[i16] = __builtin_amdgcn_rcpf(1.0f + __expf(-c0[j] * dq)); if (i16 < 8) gp[16 + i16] = __builtin_amdgcn_rcpf(1.0f + __expf(-c1[j] * dq)); } }
}
#undef FA_PK4
#undef KSWZ
#undef SBAR
}

#ifndef DBG
#define DBG 0
#endif
#if DBG
#ifndef DBG_A
#define DBG_A 0
#endif
#ifndef DBG_B
#define DBG_B 1
#endif
namespace dbg {
constexpr int CW_DBG = 131072;
constexpr size_t WS_STASH = WS_END;
constexpr size_t WS_SELD = WS_STASH + 64 * MiB;
constexpr size_t WS_ODD = WS_SELD + 4 * MiB;
typedef unsigned short bf16;
__device__ __forceinline__ float b2f(bf16 b) { return __uint_as_float(((unsigned)b) << 16); }
__device__ __forceinline__ float blk_max(float v, LAS float* red) { const int tid = threadIdx.x; red[tid] = v; __syncthreads();
    for (int s = 256; s > 0; s >>= 1) { if (tid < s) red[tid] = fmaxf(red[tid], red[tid + s]); __syncthreads(); } const float r = red[0]; __syncthreads(); return r; }
__device__ __forceinline__ float blk_sum(float v, LAS float* red) { const int tid = threadIdx.x; red[tid] = v; __syncthreads();
    for (int s = 256; s > 0; s >>= 1) { if (tid < s) red[tid] += red[tid + s]; __syncthreads(); } const float r = red[0]; __syncthreads(); return r; }
__device__ __forceinline__ float dot128(const bf16* a, const bf16* b) { float s = 0.f; for (int d = 0; d < 128; ++d) s += b2f(a[d]) * b2f(b[d]); return s; }
__device__ __forceinline__ void naive_attn(const bf16* q, const bf16* Kseq, const bf16* Vseq, const LAS int* klist, int n, float extra, LAS float* sc, LAS float* red, LAS float* o, LAS float* ml) {
    const int tid = threadIdx.x; float mx = extra;
    for (int i = tid; i < n; i += 512) { const float s = dot128(q, Kseq + (size_t)klist[i] * 128) * 0.08838834764831845f; sc[i] = s; mx = fmaxf(mx, s); }
    const float m = blk_max(mx, red); float ls = 0.f;
    for (int i = tid; i < n; i += 512) { const float p = __expf(sc[i] - m); sc[i] = p; ls += p; }
    float l = blk_sum(ls, red); if (extra > -1e30f) l += __expf(extra - m);
    if (tid < 128) { float a = 0.f; for (int i = 0; i < n; ++i) a += sc[i] * b2f(Vseq[(size_t)klist[i] * 128 + tid]); o[tid] = l > 0.f ? a / l : 0.f; }
    if (tid == 0) { ml[0] = m; ml[1] = l; }
    __syncthreads();
}
__device__ __forceinline__ void cmp128(const LAS float* nv, const bf16* fast, unsigned* errw, int k, LAS float* red) {
    const int tid = threadIdx.x; float d = 0.f, a = 0.f; if (tid < 128) { d = fabsf(nv[tid] - b2f(fast[tid])); a = fabsf(nv[tid]); }
    const float dm = blk_max(d, red), am = blk_max(a, red);
    if (tid == 0) atomicMax(errw + k, __float_as_uint(dm / fmaxf(am, 1e-20f)));
}
__constant__ int dbg_tt[16] = {0, 7, 30, 31, 63, 64, 200, 1000, 1023, 1024, 1031, 2500, 5000, 9999, 12345, 16383};
__device__ __forceinline__ int sample_t(int s) { return dbg_tt[s]; }
constexpr int NS = 32;

__device__ __forceinline__ void check_even(unsigned char* ws, const float* sinks, const float* pe_k, const float* ck_w1, const float* ck_w2, LAS unsigned char* lds) {
    unsigned* errw = (unsigned*)(ws + WS_CTL) + CW_DBG; const int tid = threadIdx.x;
    LAS float* sc = (LAS float*)lds; LAS float* red = sc + 1024; LAS float* o = red + 512; LAS float* ml = o + 128; LAS int* klist = (LAS int*)(ml + 8);
    LAS float* pc = (LAS float*)(klist + 1024);
    LAS float* imp = pc + 4096; LAS float* ocmp = imp + 256; LAS float* oslc = ocmp + 4 * 128; LAS float* oslc2 = oslc + 4 * 128; LAS float* owin = oslc2 + 4 * 128; LAS int* seln = (LAS int*)(owin + 4 * 128); LAS int* self = seln + 256;
    LAS float* mix = (LAS float*)(self + 256);
    const bf16* QA = (const bf16*)(ws + WS_R + R_QA); const bf16* KA = (const bf16*)(ws + WS_R + R_KA); const bf16* VA = (const bf16*)(ws + WS_R + R_VA);
    const bf16* QB = (const bf16*)(ws + WS_R + R_QB); const bf16* KB = (const bf16*)(ws + WS_R + R_KB); const bf16* VB = (const bf16*)(ws + WS_R + R_VB);
    const bf16* kc = (const bf16*)(ws + WS_KC); const bf16* vc = (const bf16*)(ws + WS_VC); const float* gates = (const float*)(ws + WS_GATES);
    const bf16* OC = (const bf16*)(ws + WS_O); const bf16* OWIN = (const bf16*)(ws + WS_OWIN); const bf16* STASH = (const bf16*)(ws + WS_STASH); const unsigned* SELD = (const unsigned*)(ws + WS_SELD);
    for (int s = blockIdx.x; s < NS; s += gridDim.x) { const int b = s >> 4, t = sample_t(s & 15); const size_t row = (size_t)b * T + t;
        for (int h = 0; h < 8; ++h) { const int n = t + 1 < 128 ? t + 1 : 128; for (int i = tid; i < n; i += 512) klist[i] = t - n + 1 + i; __syncthreads();
            naive_attn(QB + ((size_t)(b * 8 + h) * T + t) * 128, KB + (size_t)(b * 2 + (h >> 2)) * T * 128, VB + (size_t)(b * 2 + (h >> 2)) * T * 128, klist, n, sinks[h], sc, red, o, ml);
            cmp128(o, OC + row * 2048 + (8 + h) * 128, errw, 1, red); }
        for (int g = 0; g < 2; ++g) { const int bg = b * 2 + g; const int cvis = t >= 31 ? ((t - 31) >> 4) : -1, ncv = cvis + 1, cur = t >> 6;
            for (int hh = 0; hh < 4; ++hh) { const int h = g * 4 + hh; const bf16* q = QA + ((size_t)(b * 8 + h) * T + t) * 128;
                { const int n = t + 1 < 512 ? t + 1 : 512; for (int i = tid; i < n; i += 512) klist[i] = t - n + 1 + i; __syncthreads();
                  naive_attn(q, KA + (size_t)(b * 6 + 4 + g) * T * 128, VA + (size_t)(b * 6 + 4 + g) * T * 128, klist, n, -__builtin_inff(), sc, red, o, ml);
                  cmp128(o, OWIN + row * 1024 + h * 128, errw, 0, red); if (tid < 128) owin[hh * 128 + tid] = o[tid]; __syncthreads(); }
                { for (int i = tid; i < ncv; i += 512) klist[i] = i; __syncthreads();
                  naive_attn(q, kc + (size_t)bg * 1024 * 128, vc + (size_t)bg * 1024 * 128, klist, ncv, -__builtin_inff(), sc, red, o, ml);
                  for (int i = tid; i < 1024; i += 512) pc[hh * 1024 + i] = (i < ncv && ml[1] > 0.f) ? sc[i] / ml[1] : 0.f; if (tid < 128) ocmp[hh * 128 + tid] = o[tid]; __syncthreads(); } }
            if (tid < 256) { const int n = tid; float v = 0.f; for (int hh = 0; hh < 4; ++hh) { const LAS float* p = pc + hh * 1024; v += p[4 * n] + p[4 * n + 1] + p[4 * n + 2] + 0.5f * p[4 * n + 3] + (n > 0 ? 0.5f * p[4 * n - 1] : 0.f); }
                imp[n] = (n == 0 || n == cur || n == cur - 1) ? __builtin_inff() : (n <= cur ? v : -__builtin_inff()); }
            __syncthreads();
            if (tid < 256) { const int n = tid; int rank = 0; const float v = imp[n]; for (int m2 = 0; m2 < 256; ++m2) { const float w = imp[m2]; rank += (w > v || (w == v && m2 < n)) ? 1 : 0; }
                seln[n] = (rank < 16 && n <= cur) ? 1 : 0; const unsigned wd = SELD[((size_t)bg * T + t) * 8 + (n >> 5)]; self[n] = ((wd >> (n & 31)) & 1u) ? 1 : 0; }
            __syncthreads();
            { float mism = 0.f; if (tid < 256) mism = (seln[tid] != self[tid]) ? 1.f : 0.f; const float tot = blk_sum(mism, red); if (tid == 0) atomicMax(errw + 2, __float_as_uint(tot)); }
            for (int pass = 0; pass < 2; ++pass) { const LAS int* sel = pass ? self : seln; LAS float* od = pass ? oslc2 : oslc;
                if (tid == 0) { int n = 0; for (int nb = 0; nb < 256; ++nb) if (sel[nb]) for (int k = 0; k < 64; ++k) if (nb * 64 + k <= t) klist[n++] = nb * 64 + k; ((LAS int*)ml)[4] = n; }
                __syncthreads(); const int n = ((LAS int*)ml)[4];
                for (int hh = 0; hh < 4; ++hh) { const int h = g * 4 + hh; naive_attn(QA + ((size_t)(b * 8 + h) * T + t) * 128, KA + (size_t)(b * 6 + 2 + g) * T * 128, VA + (size_t)(b * 6 + 2 + g) * T * 128, klist, n, -__builtin_inff(), sc, red, o, ml);
                    if (tid < 128) od[hh * 128 + tid] = o[tid]; __syncthreads(); } }
            for (int hh = 0; hh < 4; ++hh) { const int h = g * 4 + hh; const float* gp = gates + row * 24 + h * 3;
                if (tid < 128) mix[tid] = gp[0] * ocmp[hh * 128 + tid]; __syncthreads(); cmp128(mix, STASH + row * 1024 + h * 128, errw, 3, red);
                if (tid < 128) mix[tid] = gp[0] * ocmp[hh * 128 + tid] + gp[1] * oslc[hh * 128 + tid] + gp[2] * owin[hh * 128 + tid]; __syncthreads(); cmp128(mix, OC + row * 2048 + h * 128, errw, 4, red);
                if (tid < 128) mix[tid] = gp[0] * ocmp[hh * 128 + tid] + gp[1] * oslc2[hh * 128 + tid] + gp[2] * owin[hh * 128 + tid]; __syncthreads(); cmp128(mix, OC + row * 2048 + h * 128, errw, 5, red); }
        }
        if (t >= 31) { const int c = (t - 31) >> 4; for (int g = 0; g < 2; ++g) { const int bg = b * 2 + g; const bf16* src = KA + (size_t)(b * 6 + g) * T * 128 + (size_t)c * 2048;
            if (tid < 128) { float a = 0.f; for (int k = 0; k < 4096; ++k) a += (b2f(src[k]) + pe_k[k]) * ck_w1[(size_t)k * 128 + tid]; const float u = 0.7978845608028654f * (a + 0.044715f * a * a * a); sc[tid] = 0.5f * a * (1.f + tanhf(u)); }
            __syncthreads();
            if (tid < 128) { float a = 0.f; for (int k = 0; k < 128; ++k) a += sc[k] * ck_w2[k * 128 + tid]; o[tid] = a; } __syncthreads();
            cmp128(o, kc + ((size_t)bg * 1024 + c) * 128, errw, 6, red); } }
    }
}
__device__ __forceinline__ void check_odd(unsigned char* ws, int grp, LAS unsigned char* lds) {
    unsigned* errw = (unsigned*)(ws + WS_CTL) + CW_DBG; const int tid = threadIdx.x;
    LAS float* sc = (LAS float*)lds; LAS float* red = sc + 1024; LAS float* o = red + 512; LAS float* ml = o + 128; LAS int* klist = (LAS int*)(ml + 8); LAS float* mix = (LAS float*)(klist + 1024);
    const bf16* Qg = (const bf16*)(ws + WS_R + R_QG); const bf16* Kg = (const bf16*)(ws + WS_R + R_KG); const bf16* Vg = (const bf16*)(ws + WS_R + R_VG); const bf16* OC = (const bf16*)(ws + WS_O);
    float* OD = (float*)(ws + WS_ODD); const int dsh = 2 * grp, dil = 1 << dsh, Lq = T >> dsh;
    for (int s = blockIdx.x; s < NS; s += gridDim.x) { const int b = s >> 4, t = sample_t(s & 15), c = t & (dil - 1), u = t >> dsh; const size_t row = (size_t)b * T + t;
        for (int h = 0; h < 16; ++h) { const size_t so = ((size_t)(b * 16 + h) * T + (size_t)c * Lq) * 128; const int n = u + 1 < 129 ? u + 1 : 129;
            for (int i = tid; i < n; i += 512) klist[i] = u - n + 1 + i; __syncthreads();
            naive_attn(Qg + so + (size_t)u * 128, Kg + so, Vg + so, klist, n, -__builtin_inff(), sc, red, o, ml);
            float* od = OD + (((size_t)grp * NS + s) * 16 + h) * 132; if (tid < 128) od[tid] = o[tid]; if (tid == 0) od[128] = ml[0] + __logf(ml[1]);
            if (grp == 0) cmp128(o, OC + row * 2048 + h * 128, errw, 7, red);
            if (grp == 2) { __threadfence(); __syncthreads(); const float* o0 = OD + (((size_t)0 * NS + s) * 16 + h) * 132; const float* o1 = OD + (((size_t)1 * NS + s) * 16 + h) * 132;
                const float l0 = o0[128], l1 = o1[128], l2 = ml[0] + __logf(ml[1]), mx = fmaxf(l0, fmaxf(l1, l2)), e0 = __expf(l0 - mx), e1 = __expf(l1 - mx), e2 = __expf(l2 - mx), inv = 1.f / (e0 + e1 + e2);
                if (tid < 128) mix[tid] = (e0 * o0[tid] + e1 * o1[tid] + e2 * o[tid]) * inv; __syncthreads(); cmp128(mix, OC + row * 2048 + h * 128, errw, 8, red); }
            __syncthreads(); }
    }
}
}
#endif

constexpr int NWAVES = 8;
#ifndef MK_PER_PHASE
#define MK_PER_PHASE 0
#endif
constexpr float F8_SX = 32.f, F8_SW = 1024.f;
constexpr int CW_BAR = 4096;
constexpr int LDS_BYTES = 147456, MISC_OFF = LDS_BYTES - 256;
static_assert(fa::ENGINE_BYTES <= MISC_OFF && 131072 + 32 * 136 * 2 <= MISC_OFF && pg8::STAGE_BYTES <= MISC_OFF, "LDS map");

struct Params {
    const float* x; const int* pos; const float* e_w_in; const float* e_w_o; const float* pe_k; const float* pe_v; const float* ck_w1; const float* ck_w2; const float* cv_w1; const float* cv_w2;
    const float* sinks; const float* o_w_in; const float* o_w_o; const float* ln1_g; const float* ln1_b; const float* w1; const float* w2; const float* ln2_g; const float* ln2_b;
    float* out; unsigned char* ws; int ph_lo, ph_hi, li, pad; float inv_freq[64];
};

__device__ __forceinline__ float wave_sum(float v) {
    v += xl_f<1>(v); v += xl_f<2>(v); v += xl_f<4>(v); v += xl_f<8>(v); v += xl_f<16>(v); return x32_sum(v);
}
__device__ __forceinline__ int cphys(int d) { return 32 * ((d >> 4) & 3) + 16 * (d >> 6) + (d & 15); }
__device__ __forceinline__ int dst_row(int kind, int n) {
    if (kind == 0) return n;
    if (kind == 1) return (n & ~127) + cphys(n & 127);
    if (n < 2560) return (n & ~127) + cphys(n & 127);
    if (n < 2584) return 32 * 128 + (n - 2560);
    const int s = n - 2584; return (20 + (s >> 7)) * 128 + cphys(s & 127);
}
__device__ __forceinline__ unsigned pk4_fp8(float a, float b, float c, float d) { unsigned w = 0; w = __builtin_amdgcn_cvt_pk_fp8_f32(a, b, w, false); w = __builtin_amdgcn_cvt_pk_fp8_f32(c, d, w, true); return w; }
struct TrRegs { f32x4 t[8]; };
__device__ __forceinline__ void tr_load(TrRegs& r, const float* W, int K, int N, int item, int lane) {
    const int nblk = (N + 31) / 32, kb = item / nblk, nb = item % nblk, k0 = 64 * kb, n0 = 32 * nb, c4 = (lane & 7) * 4, kr = lane >> 3; const bool okc = (n0 + c4) < N;
#pragma unroll
    for (int i = 0; i < 8; ++i) r.t[i] = okc ? *(const f32x4*)(W + (size_t)(k0 + 8 * i + kr) * N + n0 + c4) : (f32x4){0.f, 0.f, 0.f, 0.f};
}
template <bool F8> __device__ __forceinline__ void tr_store(const TrRegs& r, int K, int N, void* WTv, int kind, float scale, LAS float* scr, int item, int lane) {
    const int nblk = (N + 31) / 32, kb = item / nblk, nb = item % nblk, k0 = 64 * kb, n0 = 32 * nb, c4 = (lane & 7) * 4, kr = lane >> 3;
#pragma unroll
    for (int i = 0; i < 8; ++i) { LAS float* d = scr + (8 * i + kr) * 33 + c4; d[0] = r.t[i].x * scale; d[1] = r.t[i].y * scale; d[2] = r.t[i].z * scale; d[3] = r.t[i].w * scale; }
    asm volatile("s_waitcnt lgkmcnt(0)" ::: "memory");
    const int c = lane & 7;
#pragma unroll
    for (int j = 0; j < 4; ++j) { const int n = (lane >> 3) + 8 * j; const LAS float* s = scr + (8 * c) * 33 + n;
        if (F8) { const unsigned long long o = (unsigned long long)pk4_fp8(s[0 * 33], s[1 * 33], s[2 * 33], s[3 * 33]) | ((unsigned long long)pk4_fp8(s[4 * 33], s[5 * 33], s[6 * 33], s[7 * 33]) << 32);
            if (n0 + n < N) *(unsigned long long*)((unsigned char*)WTv + (size_t)dst_row(kind, n0 + n) * K + k0 + 8 * c) = o; }
        else { v4u o; o.x = pk2(s[0 * 33], s[1 * 33]); o.y = pk2(s[2 * 33], s[3 * 33]); o.z = pk2(s[4 * 33], s[5 * 33]); o.w = pk2(s[6 * 33], s[7 * 33]);
            if (n0 + n < N) *(v4u*)((unsigned short*)WTv + (size_t)dst_row(kind, n0 + n) * K + k0 + 8 * c) = o; } }
    asm volatile("s_waitcnt lgkmcnt(0)" ::: "memory");
}
template <bool F8> __device__ __forceinline__ void convert_matrix_t(const float* W, int K, int N, void* WT, int kind, float scale, LAS float* scr, int gw, int ngw, int lane) {
    const int nitems = (K / 64) * ((N + 31) / 32); if (gw >= nitems) return;
    TrRegs cur, nxt; tr_load(cur, W, K, N, gw, lane);
    for (int it = gw; it < nitems; it += ngw) { const bool more = it + ngw < nitems;
        if (more) tr_load(nxt, W, K, N, it + ngw, lane);
        tr_store<F8>(cur, K, N, WT, kind, scale, scr, it, lane);
        if (more) cur = nxt; }
}
__device__ __forceinline__ void convert_matrix(const float* W, int K, int N, unsigned short* WT, int kind, LAS float* scr, int gw, int ngw, int lane) { convert_matrix_t<false>(W, K, N, WT, kind, 1.0f, scr, gw, ngw, lane); }
__device__ __forceinline__ void convert_matrix_f8(const float* W, int K, int N, unsigned char* WT, int kind, float scale, LAS float* scr, int gw, int ngw, int lane) { convert_matrix_t<true>(W, K, N, WT, kind, scale, scr, gw, ngw, lane); }
template <int R> __device__ __forceinline__ void ln_rows(float* z, unsigned short* xb, unsigned char* xb8  , float* stats, int m0, int rstride, const float* gam, const float* bet, int lane, bool full) {
    f32x4 v[R][8];
#pragma unroll
    for (int r = 0; r < R; ++r) { const f32x4* xr = (const f32x4*)(z + (size_t)(m0 + r * rstride) * DM) + lane;
#pragma unroll
        for (int j = 0; j < 8; ++j) v[r][j] = xr[64 * j]; }
#pragma unroll
    for (int r = 0; r < R; ++r) { const int m = m0 + r * rstride; float s = 0.f;
#pragma unroll
        for (int j = 0; j < 8; ++j) s += (v[r][j].x + v[r][j].y) + (v[r][j].z + v[r][j].w);
        const float mean = wave_sum(s) * (1.f / DM); float s2 = 0.f;
#pragma unroll
        for (int j = 0; j < 8; ++j) { v[r][j] = v[r][j] - mean; s2 += (v[r][j].x * v[r][j].x + v[r][j].y * v[r][j].y) + (v[r][j].z * v[r][j].z + v[r][j].w * v[r][j].w); }
        const float rstd = 1.f / sqrtf(wave_sum(s2) * (1.f / DM) + LN_EPS);
        if (lane == 0) { stats[2 * m] = mean; stats[2 * m + 1] = rstd; }
        f32x4* xw = (f32x4*)(z + (size_t)m * DM) + lane; unsigned long long* o8 = (unsigned long long*)(xb + (size_t)m * DM) + lane; unsigned* o4 = (unsigned*)(xb8 + (size_t)m * DM) + lane;
#pragma unroll
        for (int j = 0; j < 8; ++j) { const f32x4 gm = ((const f32x4*)gam)[lane + 64 * j], bt = ((const f32x4*)bet)[lane + 64 * j]; const f32x4 y = v[r][j] * rstd * gm + bt;
            if (full) xw[64 * j] = y;
            if (xb8) o4[64 * j] = pk4_fp8(y.x * F8_SX, y.y * F8_SX, y.z * F8_SX, y.w * F8_SX); else o8[64 * j] = (unsigned long long)pk2(y.x, y.y) | ((unsigned long long)pk2(y.z, y.w) << 32); } }
}
template <int R> __device__ __forceinline__ void cvt_rows(const float* x, unsigned char* x8, int m0, int rstride, int lane) {
    f32x4 v[R][8];
#pragma unroll
    for (int r = 0; r < R; ++r) { const f32x4* xr = (const f32x4*)(x + (size_t)(m0 + r * rstride) * DM) + lane;
#pragma unroll
        for (int j = 0; j < 8; ++j) v[r][j] = xr[64 * j]; }
#pragma unroll
    for (int r = 0; r < R; ++r) { unsigned* o4 = (unsigned*)(x8 + (size_t)(m0 + r * rstride) * DM) + lane;
#pragma unroll
        for (int j = 0; j < 8; ++j) o4[64 * j] = pk4_fp8(v[r][j].x * F8_SX, v[r][j].y * F8_SX, v[r][j].z * F8_SX, v[r][j].w * F8_SX); }
}
__device__ __forceinline__ void rope_entry(float ang, float& c, float& s) {
    const double a = (double)ang; const double q = rint(a * 0.63661977236758134308); const double y = fma(-q, 1.57079632679489655800, a) - q * 6.12323399573676603587e-17;
    const double y2 = y * y;
    const double sn = y * (1.0 + y2 * (-1.0 / 6 + y2 * (1.0 / 120 + y2 * (-1.0 / 5040 + y2 * (1.0 / 362880 + y2 * (-1.0 / 39916800))))));
    const double cs = 1.0 + y2 * (-0.5 + y2 * (1.0 / 24 + y2 * (-1.0 / 720 + y2 * (1.0 / 40320 + y2 * (-1.0 / 3628800 + y2 * (1.0 / 479001600))))));
    const int qi = ((int)q) & 3;
    const double cc = (qi == 0) ? cs : (qi == 1) ? -sn : (qi == 2) ? -cs : sn;
    const double ss = (qi == 0) ? sn : (qi == 1) ? cs : (qi == 2) ? -sn : -cs;
    c = (float)cc; s = (float)ss;
}

template <class Tp> __device__ __forceinline__ Tp* as_global(Tp* p) { return (Tp*)(GAS Tp*)p; }
#define CAS __attribute__((address_space(4)))
typedef const CAS Params* ParamsPtr;
__device__ __forceinline__ ParamsPtr params_ptr(ParamsPtr kp) { asm volatile("" : "+s"(kp)); return kp; }
__device__ __forceinline__ int opaque_bx() { int v = blockIdx.x; asm volatile("" : "+s"(v)); return v; }
__device__ __forceinline__ int opaque_i(int v) { asm volatile("" : "+s"(v)); return v; }
__device__ __forceinline__ int opaque_g() { int v = gridDim.x; asm volatile("" : "+s"(v)); return v; }
#if DBG
#define DBG_STASH_PTR(ws) ((unsigned short*)((ws) + dbg::WS_STASH))
#define DBG_SEL_PTR(ws) ((unsigned*)((ws) + dbg::WS_SELD))
#else
#define DBG_STASH_PTR(ws) nullptr
#define DBG_SEL_PTR(ws) nullptr
#endif
#ifndef WGM_INPROJ
#define WGM_INPROJ 4
#endif
#ifndef WGM_RESID
#define WGM_RESID 4
#endif
#ifndef WGM_UP
#define WGM_UP 4
#endif
#ifndef REP_MASK
#define REP_MASK 0
#endif
#ifndef DBG_MASK
#define DBG_MASK 0
#endif
#ifndef DBG_LAYER_EVEN
#define DBG_LAYER_EVEN 0
#endif
#ifndef DBG_LAYER_ODD
#define DBG_LAYER_ODD 1
#endif
#ifndef ONLY_PHASE
#define ONLY_PHASE -1
#endif
#define PHASE_ENABLED(k) (ONLY_PHASE < 0 || ONLY_PHASE == (k))

__device__ __forceinline__ void convert_layer(ParamsPtr pp, int L, LAS unsigned char* lds, int gw, int ngw, int lane, int wave) {
    unsigned char* ws = as_global(pp->ws); const int i_ = L >> 1; LAS float* scr = (LAS float*)(lds + wave * 16384);
    unsigned short* Win_t = (unsigned short*)(ws + WS_W + W_WIN); unsigned short* Wo_t = (unsigned short*)(ws + WS_W + W_WO);
    unsigned short* W1_t = (unsigned short*)(ws + WS_W + W_W1); unsigned short* W2_t = (unsigned short*)(ws + WS_W + W_W2);
    if ((L & 1) == 0) { unsigned short* cw = (unsigned short*)(ws + WS_CW);
        convert_matrix_f8(as_global(pp->e_w_in) + (size_t)i_ * DM * EVEN_IN, DM, EVEN_IN, (unsigned char*)Win_t, 2, F8_SW, scr, gw, ngw, lane);
        convert_matrix(as_global(pp->e_w_o) + (size_t)i_ * DM * DM, DM, DM, Wo_t, 0, scr, gw, ngw, lane);
        convert_matrix(as_global(pp->ck_w1) + (size_t)i_ * 4096 * 128, 4096, 128, cw, 0, scr, gw, ngw, lane); convert_matrix(as_global(pp->cv_w1) + (size_t)i_ * 4096 * 128, 4096, 128, cw + 128 * 4096, 0, scr, gw, ngw, lane);
        convert_matrix(as_global(pp->ck_w2) + (size_t)i_ * 128 * 128, 128, 128, cw + 2 * 128 * 4096, 0, scr, gw, ngw, lane); convert_matrix(as_global(pp->cv_w2) + (size_t)i_ * 128 * 128, 128, 128, cw + 2 * 128 * 4096 + 128 * 128, 0, scr, gw, ngw, lane);
    } else {
        convert_matrix_f8(as_global(pp->o_w_in) + (size_t)i_ * DM * ODD_IN, DM, ODD_IN, (unsigned char*)Win_t, 1, F8_SW, scr, gw, ngw, lane);
        convert_matrix(as_global(pp->o_w_o) + (size_t)i_ * DM * DM, DM, DM, Wo_t, 0, scr, gw, ngw, lane); }
    convert_matrix(as_global(pp->w1) + (size_t)L * DM * DFF, DM, DFF, W1_t, 0, scr, gw, ngw, lane);
    convert_matrix(as_global(pp->w2) + (size_t)L * DFF * DM, DFF, DM, W2_t, 0, scr, gw, ngw, lane);
}
__device__ __forceinline__ void phase_prologue(ParamsPtr pp, LAS unsigned char* lds) {
    int tid_ = threadIdx.x; asm volatile("" : "+v"(tid_));
    const int tid = tid_, lane = tid & 63, wave = __builtin_amdgcn_readfirstlane(tid >> 6), G = opaque_g(), bx = opaque_bx(), gw = bx * NWAVES + wave, ngw = G * NWAVES;
    unsigned char* ws = as_global(pp->ws); unsigned* ropet = (unsigned*)(ws + WS_ROPEC); const int* pos = as_global(pp->pos); const float* x = as_global(pp->x);
    for (size_t e = (size_t)bx * 512 + tid; e < (size_t)M * 64; e += (size_t)G * 512) { const int row = (int)(e >> 6), i = (int)(e & 63);
        const float ang = (float)pos[row] * pp->inv_freq[i]; float c, s; rope_entry(ang, c, s);
        ropet[e] = (unsigned)__builtin_bit_cast(unsigned short, (_Float16)c) | ((unsigned)__builtin_bit_cast(unsigned short, (_Float16)s) << 16); }
    if (ngw * 16 == M) { for (int m = gw; m < M; m += 4 * ngw) cvt_rows<4>(x, ws + WS_XB8, m, ngw, lane); }
    else { for (int m = gw; m < M; m += ngw) cvt_rows<1>(x, ws + WS_XB8, m, ngw, lane); }
    convert_layer(pp, 0, lds, gw, ngw, lane, wave);
}
__device__ __forceinline__ void phase_e1(ParamsPtr pp, LAS unsigned char* lds) {
    unsigned char* ws = as_global(pp->ws);
    pg8::Gemm g{(const unsigned short*)(ws + WS_XB8), (const unsigned short*)(ws + WS_W + W_WIN), M, 4096, DM / 2}; pg8::StaticOrder S; S.init(M, 4096, opaque_g(), opaque_bx(), WGM_INPROJ);
    pg8::EpiEven E{ws, 1.0f / (F8_SX * F8_SW)};
    pg8::gemm_phase<pg8::EpiEven, pg8::StaticOrder, true, true, true>(lds, g, S, E);
}
__device__ __forceinline__ fa::BandArgs decode_e2(unsigned char* ws0, const float* sinks, int li, int u0, int G) {
    const int u = (G == 256) ? (u0 & ~255) + ((u0 & 7) << 5) + ((u0 & 255) >> 3) : u0;
    const int kind = u >> 10, r = u & 1023, C = r >> 5, p = r & 31, b = C >> 4, blk = (C & 7) * 8 + (p >> 2), h = ((C >> 3) & 1) * 4 + (p & 3); fa::BandArgs a;
    GAS unsigned char* wsg = (GAS unsigned char*)ws0; asm volatile("" : "+s"(wsg)); unsigned char* ws = (unsigned char*)wsg; unsigned char* R = ws + WS_R;
    if (kind == 0) {
        a.Q = (const unsigned short*)(R + R_QA) + (size_t)(b * 8 + h) * T * 128; a.K = (const unsigned short*)(R + R_KA) + (size_t)(b * 6 + 4 + (h >> 2)) * T * 128; a.V = (const unsigned short*)(R + R_VA) + (size_t)(b * 6 + 4 + (h >> 2)) * T * 128;
        a.O = (unsigned short*)(ws + WS_OWIN) + (size_t)b * T * 1024 + h * 128; a.o_stride = 1024; a.lse = nullptr; a.lse_stride = 0; a.P0 = blk * 256; a.W = 512; a.mode = 0; a.sink = 0.f;
    } else {
        a.Q = (const unsigned short*)(R + R_QB) + (size_t)(b * 8 + h) * T * 128; a.K = (const unsigned short*)(R + R_KB) + (size_t)(b * 2 + (h >> 2)) * T * 128; a.V = (const unsigned short*)(R + R_VB) + (size_t)(b * 2 + (h >> 2)) * T * 128;
        a.O = (unsigned short*)(ws + WS_O) + (size_t)b * T * 2048 + (8 + h) * 128; a.o_stride = 2048; a.lse = nullptr; a.lse_stride = 0; a.P0 = blk * 256; a.W = 128; a.mode = 1; a.sink = sinks[li * 8 + h];
    }
    a.nK = a.K; a.nV = a.V; a.nP0 = a.P0; a.nW = a.W; a.has_next = 0; a.prefetched = 0; return a;
}
__device__ __forceinline__ void phase_e2(ParamsPtr pp, int li, LAS unsigned char* lds) {
    unsigned char* const ws0 = as_global(pp->ws); const int G = opaque_g(), bx = opaque_bx();
    for (int gt = bx; gt < 256; gt += G) { GAS unsigned char* wsg = (GAS unsigned char*)ws0; asm volatile("" : "+s"(wsg)); unsigned char* ws = (unsigned char*)wsg;
        fa::gate_task(ws + WS_XB8, ws + WS_W + W_WIN + (size_t)4096 * DM, (float*)(ws + WS_GATES), 1.0f / (F8_SX * F8_SW), gt * 128); }
    for (int ct = bx; ct < 256; ct += G) { const int z = ct >> 7;
        GAS unsigned char* wsg = (GAS unsigned char*)ws0; asm volatile("" : "+s"(wsg)); unsigned char* ws = (unsigned char*)wsg; unsigned char* R = ws + WS_R; unsigned short* cw = (unsigned short*)(ws + WS_CW);
        fa::compress_task((FA_LAS char*)lds, (const unsigned short*)(R + (z ? R_VA : R_KA)), (z ? as_global(pp->pe_v) : as_global(pp->pe_k)) + (size_t)li * 4096, cw + (z ? 128 * 4096 : 0), cw + 2 * 128 * 4096 + (z ? 128 * 128 : 0),
                          (unsigned short*)(ws + (z ? WS_VC : WS_KC)), ct & 127); }
    int pre = 0;
    for (int u0 = bx; u0 < 2048; u0 += G) { fa::BandArgs a = decode_e2(ws0, as_global(pp->sinks), li, u0, G); const bool hn = u0 + G < 2048;
        if (hn) { const fa::BandArgs n = decode_e2(ws0, as_global(pp->sinks), li, u0 + G, G); a.nK = n.K; a.nV = n.V; a.nP0 = n.P0; a.nW = n.W; }
        a.has_next = hn ? 1 : 0; a.prefetched = pre; pre = a.has_next;
        fa::banded_unit((FA_LAS char*)lds, a); }
}
constexpr int CW_NSAQ = 1024;
__device__ __forceinline__ void nsa_run(unsigned char* ws0, LAS unsigned char* lds, int bg, int tile, int dry) {
    GAS unsigned char* wsg = (GAS unsigned char*)ws0; asm volatile("" : "+s"(wsg)); unsigned char* ws = (unsigned char*)wsg; unsigned char* R = ws + WS_R;
    fa::NsaArgs a{(const unsigned short*)(R + R_QA), (const unsigned short*)(R + R_KA), (const unsigned short*)(R + R_VA), (const unsigned short*)(ws + WS_KC), (const unsigned short*)(ws + WS_VC),
                  (const float*)(ws + WS_GATES), (const unsigned short*)(ws + WS_OWIN), (unsigned short*)(ws + WS_O), bg >> 1, bg & 1, tile * 64, DBG_STASH_PTR(ws), DBG_SEL_PTR(ws), dry};
    fa::nsa_unit((FA_LAS char*)lds, a);
}
__device__ __forceinline__ void phase_e3(ParamsPtr pp, int li, LAS unsigned char* lds, int dry = 0) {
    unsigned char* const ws0 = as_global(pp->ws); const int G = opaque_g(), bx = opaque_bx();
    if (dry == 0 && G == 256) {
        const int bg = bx & 3; int tid = threadIdx.x; asm volatile("" : "+v"(tid));
        volatile LAS unsigned* slot = (volatile LAS unsigned*)(lds + MISC_OFF) + 40;
        GAS unsigned* q = (GAS unsigned*)(ws0 + WS_CTL) + CW_NSAQ + li * 64 + bg * 16;
        unsigned mine = 0u; if (tid == 0) mine = __hip_atomic_fetch_add(q, 1u, __ATOMIC_RELAXED, __HIP_MEMORY_SCOPE_AGENT);
        for (;;) {
            if (tid == 0) slot[0] = mine;
            __syncthreads();
            const int u = __builtin_amdgcn_readfirstlane((int)slot[0]);
            if (u >= 256) break;
            if (tid == 0) mine = __hip_atomic_fetch_add(q, 1u, __ATOMIC_RELAXED, __HIP_MEMORY_SCOPE_AGENT);
            nsa_run(ws0, lds, bg, 255 - u, 0); }
        __syncthreads();
        return; }
    for (int i = bx; i < 1024; i += G) { const int r = i >> 8, k = i & 255, bg = k & 3, idx = k >> 2;
        const int tile = (r == 0) ? 255 - idx : (r == 1) ? idx : (r == 2) ? 191 - idx : 64 + idx;
        nsa_run(ws0, lds, bg, tile, dry); }
}
__device__ __forceinline__ void phase_o1(ParamsPtr pp, int grp, LAS unsigned char* lds, bool nullepi = false, int norope_probe = 0) {
    unsigned char* ws = as_global(pp->ws);
    pg8::Gemm g{(const unsigned short*)(ws + WS_XB8), (const unsigned short*)(ws + WS_W + W_WIN + (size_t)grp * ODD_G * DM), M, ODD_G, DM / 2}; pg8::StaticOrder S; S.init(M, ODD_G, opaque_g(), opaque_bx(), WGM_INPROJ);
    pg8::EpiOdd E{ws, 2 * grp, 1.0f / (F8_SX * F8_SW), norope_probe};
#if REP_MASK & 0x1000
    if (nullepi) { pg8::EpiNull E0; pg8::gemm_phase<pg8::EpiNull, pg8::StaticOrder, true, true, true>(lds, g, S, E0); return; }
#endif
    pg8::gemm_phase<pg8::EpiOdd, pg8::StaticOrder, true, true, true>(lds, g, S, E);
}
__device__ __forceinline__ fa::BandArgs decode_o2(unsigned char* ws0, int grp, int u0, int G, bool dry) {
    const int dsh = 2 * grp, dil = 1 << dsh, Lq = T >> dsh, nblk = Lq >> 8;
    const int u = (G == 256) ? (u0 & ~255) + ((u0 & 7) << 5) + ((u0 & 255) >> 3) : u0;
    const int seq = u / nblk, blk = u - seq * nblk, bh = seq >> dsh, c = seq & (dil - 1), b = bh >> 4, h = bh & 15; fa::BandArgs a;
    const size_t so = ((size_t)bh * T + (size_t)c * Lq) * 128;
    GAS unsigned char* wsg = (GAS unsigned char*)ws0; asm volatile("" : "+s"(wsg)); unsigned char* ws = (unsigned char*)wsg; unsigned char* R = ws + WS_R;
    a.Q = (const unsigned short*)(R + R_QG) + so; a.K = (const unsigned short*)(R + R_KG) + so; a.V = (const unsigned short*)(R + R_VG) + so;
    a.O = (unsigned short*)(ws + WS_O) + ((size_t)b * T + c) * 2048 + h * 128; a.o_stride = (size_t)dil * 2048; a.lse = (float*)(ws + WS_LSE) + ((size_t)b * T + c) * 16 + h; a.lse_stride = (size_t)dil * 16;
    a.P0 = blk * 256; a.W = 129; a.mode = grp == 0 ? 2 : 3; a.sink = 0.f;
    if (dry) { a.O = (unsigned short*)(ws + WS_XB) + ((size_t)b * T + c) * 2048 + h * 128; a.lse = (float*)(ws + WS_GATES) + ((size_t)b * T + c) * 16 + h; a.mode = 2; }
    a.nK = a.K; a.nV = a.V; a.nP0 = a.P0; a.nW = a.W; a.has_next = 0; a.prefetched = 0; return a;
}
__device__ __forceinline__ void phase_o2(ParamsPtr pp, int grp, LAS unsigned char* lds, bool dry = false) {
    unsigned char* const ws0 = as_global(pp->ws); const int G = opaque_g(), bx = opaque_bx();
    int pre = 0;
    for (int u0 = bx; u0 < 2048; u0 += G) { fa::BandArgs a = decode_o2(ws0, grp, u0, G, dry); const bool hn = u0 + G < 2048;
        if (hn) { const fa::BandArgs n = decode_o2(ws0, grp, u0 + G, G, dry); a.nK = n.K; a.nV = n.V; a.nP0 = n.P0; a.nW = n.W; }
        a.has_next = hn ? 1 : 0; a.prefetched = pre; pre = a.has_next;
        fa::banded_unit((FA_LAS char*)lds, a); }
}
__device__ __forceinline__ void phase_resid_gemm(ParamsPtr pp, int which  , int layer, LAS unsigned char* lds) {
    unsigned char* ws = as_global(pp->ws); float* out = as_global(pp->out);
    pg8::Gemm g{(const unsigned short*)(ws + (which ? WS_R : WS_O)), (const unsigned short*)(ws + WS_W + (which ? W_W2 : W_WO)), M, DM, which ? DFF : DM}; pg8::StaticOrder S; S.init(M, DM, opaque_g(), opaque_bx(), WGM_RESID);
    const bool raw = (which == 0 && layer == 0);
    const float* gam = raw ? nullptr : (which ? as_global(pp->ln1_g) + layer * DM : as_global(pp->ln2_g) + (layer - 1) * DM);
    const float* bet = raw ? nullptr : (which ? as_global(pp->ln1_b) + layer * DM : as_global(pp->ln2_b) + (layer - 1) * DM);
    pg8::EpiResid E{raw ? as_global(pp->x) : out, out, DM, DN_ALPHA, (const float*)(ws + WS_STATS), gam, bet};
    pg8::gemm_phase<pg8::EpiResid, pg8::StaticOrder, true, true>(lds, g, S, E);
}
#if REP_MASK & 0x240
__device__ __forceinline__ void phase_probe_gemm(ParamsPtr pp, int which, LAS unsigned char* lds) {
    unsigned char* ws = as_global(pp->ws);
    pg8::Gemm g{(const unsigned short*)(ws + (which ? WS_R : WS_O)), (const unsigned short*)(ws + WS_W + (which ? W_W2 : W_WO)), M, DM, which ? DFF : DM}; pg8::StaticOrder S; S.init(M, DM, opaque_g(), opaque_bx());
    pg8::EpiRelu2 E{(unsigned short*)(ws + WS_XB), DM};
    pg8::gemm_phase<pg8::EpiRelu2, pg8::StaticOrder, true, true>(lds, g, S, E);
}
#endif
__device__ __forceinline__ void phase_ln(ParamsPtr pp, int which, int layer) {
    int tid_ = threadIdx.x; asm volatile("" : "+v"(tid_));
    const int tid = tid_, lane = tid & 63, wave = __builtin_amdgcn_readfirstlane(tid >> 6), gw = opaque_bx() * NWAVES + wave, ngw = opaque_g() * NWAVES;
    float* out = as_global(pp->out); unsigned short* XB = (unsigned short*)(as_global(pp->ws) + WS_XB); const float* gam = (which ? as_global(pp->ln2_g) : as_global(pp->ln1_g)) + layer * DM; const float* bet = (which ? as_global(pp->ln2_b) : as_global(pp->ln1_b)) + layer * DM;
    unsigned char* XB8 = (which == 1 && layer + 1 < DEPTH) ? as_global(pp->ws) + WS_XB8 : nullptr;
    float* stats = (float*)(as_global(pp->ws) + WS_STATS); const bool full = which == 1 && layer == DEPTH - 1;
    if (ngw * 16 == M) { for (int m = gw; m < M; m += 4 * ngw) ln_rows<4>(out, XB, XB8, stats, m, ngw, gam, bet, lane, full); }
    else { for (int m = gw; m < M; m += ngw) ln_rows<1>(out, XB, XB8, stats, m, ngw, gam, bet, lane, full); }
}
__device__ __forceinline__ void phase_up(ParamsPtr pp, LAS unsigned char* lds, bool nullepi = false) {
    unsigned char* ws = as_global(pp->ws);
    pg8::Gemm g{(const unsigned short*)(ws + WS_XB), (const unsigned short*)(ws + WS_W + W_W1), M, DFF, DM}; pg8::StaticOrder S; S.init(M, DFF, opaque_g(), opaque_bx(), WGM_UP);
    pg8::EpiRelu2 E{(unsigned short*)(ws + WS_R), DFF};
#if REP_MASK & 0x2000
    if (nullepi) { pg8::EpiNull E0; pg8::gemm_phase<pg8::EpiNull, pg8::StaticOrder, true, true>(lds, g, S, E0); return; }
#endif
    pg8::gemm_phase<pg8::EpiRelu2, pg8::StaticOrder, true, true>(lds, g, S, E);
}

#define PH_ON (pc >= lo && pc < hi)
#if DBG
#define T_BEGIN() do { if (blockIdx.x == 0 && threadIdx.x == 0) { const unsigned long long t_ = wall_clock64(); MISC[16] = (unsigned)t_; MISC[17] = (unsigned)(t_ >> 32); } } while (0)
#define T_END(cat) do { if (blockIdx.x == 0 && threadIdx.x == 0) { const unsigned long long t0_ = ((unsigned long long)MISC[17] << 32) | MISC[16]; unsigned* w_ = (unsigned*)(as_global(P.ws) + WS_CTL) + dbg::CW_DBG + 32 + (cat); *w_ += (unsigned)((wall_clock64() - t0_) / 100ull); } } while (0)
#define DBG_BAR() do { XcdBarrier b_ = bar; GAS unsigned* bg_ = (GAS unsigned*)b_.bar; asm volatile("" : "+s"(bg_)); b_.bar = (unsigned*)bg_; xcd_barrier(b_); } while (0)
#else
#define T_BEGIN() do {} while (0)
#define T_END(cat) do {} while (0)
#endif
#define SEAM() do { if (pc >= lo && pc + 1 < hi) { XcdBarrier b_ = bar; GAS unsigned* bg_ = (GAS unsigned*)b_.bar; asm volatile("" : "+s"(bg_)); b_.bar = (unsigned*)bg_; xcd_barrier(b_); if (REP_MASK & 0x4000) xcd_barrier(b_); } ++pc; } while (0)
template <int layer> __device__ __forceinline__ void run_layer(Params& P, ParamsPtr kp, LAS unsigned char* lds, volatile LAS unsigned* MISC, const XcdBarrier& bar, int lo, int hi, int& pc) {
        if ((layer & 1) == 0) {
            T_BEGIN(); if (PH_ON && PHASE_ENABLED(1)) { phase_e1(params_ptr(kp), lds); if (REP_MASK & 2) phase_e1(params_ptr(kp), lds); }
            SEAM(); T_END(1);
            T_BEGIN(); if (PH_ON && PHASE_ENABLED(2)) { phase_e2(params_ptr(kp), layer >> 1, lds); if (REP_MASK & 4) phase_e2(params_ptr(kp), layer >> 1, lds); }
            SEAM(); T_END(2);
            T_BEGIN(); if (PH_ON && PHASE_ENABLED(3)) { phase_e3(params_ptr(kp), layer >> 1, lds); if (REP_MASK & 0x800) phase_e3(params_ptr(kp), layer >> 1, lds, 1); if (REP_MASK & 0x20000) phase_e3(params_ptr(kp), layer >> 1, lds, 2); if (REP_MASK & 0x40000) phase_e3(params_ptr(kp), layer >> 1, lds, 3); if (REP_MASK & 0x80000) phase_e3(params_ptr(kp), layer >> 1, lds, 4); }
            SEAM(); T_END(3);
        } else {
            for (int grp = 0; grp < 3; ++grp) {
                T_BEGIN(); if (PH_ON && PHASE_ENABLED(4)) { phase_o1(params_ptr(kp), grp, lds); if (REP_MASK & 16) phase_o1(params_ptr(kp), grp, lds); if (REP_MASK & 0x1000) phase_o1(params_ptr(kp), grp, lds, true); if (REP_MASK & 0x8000) { phase_o1(params_ptr(kp), grp, lds, false, 1); phase_o1(params_ptr(kp), grp, lds); } if (REP_MASK & 0x10000) { phase_o1(params_ptr(kp), grp, lds, false, 2); phase_o1(params_ptr(kp), grp, lds); } }
                SEAM(); T_END(4);
                T_BEGIN(); if (PH_ON && PHASE_ENABLED(5)) { phase_o2(params_ptr(kp), grp, lds); if (REP_MASK & 32) phase_o2(params_ptr(kp), grp, lds, true); }
                SEAM(); T_END(5);
            }
        }
        T_BEGIN(); if (PH_ON && PHASE_ENABLED(6)) {
#if REP_MASK & 0x40
            phase_probe_gemm(params_ptr(kp), 0, lds);
#endif
            phase_resid_gemm(params_ptr(kp), 0, layer, lds); }
        SEAM(); T_END(6);
        T_BEGIN(); if (PH_ON && PHASE_ENABLED(7)) { phase_ln(params_ptr(kp), 0, layer); if (REP_MASK & 0x80) phase_ln(params_ptr(kp), 0, layer); }
        SEAM(); T_END(7);
        T_BEGIN(); if (PH_ON && PHASE_ENABLED(8)) { phase_up(params_ptr(kp), lds); if (REP_MASK & 256) phase_up(params_ptr(kp), lds); if (REP_MASK & 0x2000) phase_up(params_ptr(kp), lds, true); }
        SEAM(); T_END(8);
        T_BEGIN(); if (PH_ON && PHASE_ENABLED(9)) {
#if REP_MASK & 0x200
            phase_probe_gemm(params_ptr(kp), 1, lds);
#endif
            phase_resid_gemm(params_ptr(kp), 1, layer, lds); }
        SEAM(); T_END(9);
        T_BEGIN(); if (PH_ON && PHASE_ENABLED(10)) {
            phase_ln(params_ptr(kp), 1, layer); if ((REP_MASK & 0x80) && layer + 1 < DEPTH) phase_ln(params_ptr(kp), 1, layer);
            if (layer + 1 < DEPTH) { int tid = threadIdx.x; asm volatile("" : "+v"(tid)); const int wave = __builtin_amdgcn_readfirstlane(tid >> 6); convert_layer(params_ptr(kp), layer + 1, lds, opaque_bx() * NWAVES + wave, opaque_g() * NWAVES, tid & 63, wave);
                if (REP_MASK & 0x400) convert_layer(params_ptr(kp), layer + 1, lds, opaque_bx() * NWAVES + wave, opaque_g() * NWAVES, tid & 63, wave); }
        }
        SEAM(); T_END(10);

}
__global__ void __launch_bounds__(NWAVES * 64, 2) fwd_kernel(Params P) {
    extern __shared__ __attribute__((aligned(16))) unsigned char lds_raw[];
    LAS unsigned char* lds = (LAS unsigned char*)lds_raw;
    volatile LAS unsigned* MISC = (volatile LAS unsigned*)(lds + MISC_OFF);
    ParamsPtr kp = (ParamsPtr)__builtin_amdgcn_kernarg_segment_ptr();
    if (threadIdx.x < 64) MISC[threadIdx.x] = 0u;
    __syncthreads();
    XcdBarrier bar = xcd_barrier_post((unsigned*)(as_global(P.ws) + WS_CTL) + CW_BAR + P.li * XCD_BAR_WORDS, MISC + 8);
    const int lo = P.ph_lo, hi = P.ph_hi; int pc = 0;
    T_BEGIN(); if (PH_ON && PHASE_ENABLED(0)) phase_prologue(params_ptr(kp), lds);
    SEAM(); T_END(0);
    run_layer<0>(P, kp, lds, MISC, bar, lo, hi, pc); run_layer<1>(P, kp, lds, MISC, bar, lo, hi, pc); run_layer<2>(P, kp, lds, MISC, bar, lo, hi, pc); run_layer<3>(P, kp, lds, MISC, bar, lo, hi, pc);
#undef PH_ON
#undef SEAM
}
#if DBG
__global__ void __launch_bounds__(512) dbg_even_kernel(Params P) { extern __shared__ __attribute__((aligned(16))) unsigned char l_[]; const int li_ = DBG_LAYER_EVEN >> 1;
    dbg::check_even(P.ws, P.sinks + li_ * 8, P.pe_k + (size_t)li_ * 4096, P.ck_w1 + (size_t)li_ * 4096 * 128, P.ck_w2 + (size_t)li_ * 128 * 128, (LAS unsigned char*)l_); }
__global__ void __launch_bounds__(512) dbg_odd_kernel(Params P, int grp) { extern __shared__ __attribute__((aligned(16))) unsigned char l_[]; dbg::check_odd(P.ws, grp, (LAS unsigned char*)l_); }
__global__ void __launch_bounds__(512) dbg_report_kernel(Params P) { const unsigned* w_ = (const unsigned*)(P.ws + WS_CTL) + dbg::CW_DBG; float* o_ = P.out;
#if DBG == 1
    unsigned us = 0; for (int c = 0; c < 16; ++c) if ((DBG_MASK >> c) & 1) us += w_[32 + c];
    const float v = 0.1f * rintf((float)us * 1e-2f); for (int i = 1 + blockIdx.x * 512 + threadIdx.x; i <= 100000; i += gridDim.x * 512) o_[i] = v;
#else
    if (blockIdx.x == 0) { const unsigned wa = w_[DBG_A], wb = w_[DBG_B]; const float va = __uint_as_float(wa) * 1e5f, vb = __uint_as_float(wb) * 1e4f;
    for (int i = threadIdx.x; i <= 10000; i += 512) o_[i] = (i == 0) ? va : vb; }
#endif
}
#endif
constexpr int N_PHASES = 1 + 2 * (3 + 5) + 2 * (6 + 5);

extern "C" void kernel_launch(void* const* d_in, const int* in_sizes, int n_in, void* d_out, int out_size, void* d_ws, size_t ws_size, hipStream_t stream) {
    static int grid = 0;
    if (grid == 0) {
        if (n_in != 19 || in_sizes[0] != M * DM || out_size != M * DM || ws_size < WS_END) { fprintf(stderr, "kernel_launch: unexpected problem (n_in %d, in0 %d, out %d, ws %zu < %zu); nothing launched\n", n_in, n_in > 0 ? in_sizes[0] : -1, out_size, ws_size, (size_t)WS_END); grid = -1; return; }
        int dev = 0, cus = 0, per_cu = 0;
        if (hipGetDevice(&dev) != hipSuccess || hipDeviceGetAttribute(&cus, hipDeviceAttributeMultiprocessorCount, dev) != hipSuccess) { grid = -1; return; }
        if (hipFuncSetAttribute((const void*)fwd_kernel, hipFuncAttributeMaxDynamicSharedMemorySize, LDS_BYTES) != hipSuccess) { fprintf(stderr, "kernel_launch: hipFuncSetAttribute failed\n"); grid = -1; return; }
        if (hipOccupancyMaxActiveBlocksPerMultiprocessor(&per_cu, (const void*)fwd_kernel, NWAVES * 64, LDS_BYTES) != hipSuccess || per_cu < 1) { fprintf(stderr, "kernel_launch: occupancy query reports %d workgroups per CU\n", per_cu); }
        (void)hipGetLastError();
        grid = cus;
    }
    if (grid < 0) return;
    if (hipMemsetAsync((char*)d_ws + WS_CTL, 0, CTL_ZERO_BYTES, stream) != hipSuccess) return;
    Params p{};
    p.x = (const float*)d_in[0]; p.pos = (const int*)d_in[1]; p.e_w_in = (const float*)d_in[2]; p.e_w_o = (const float*)d_in[3]; p.pe_k = (const float*)d_in[4]; p.pe_v = (const float*)d_in[5];
    p.ck_w1 = (const float*)d_in[6]; p.ck_w2 = (const float*)d_in[7]; p.cv_w1 = (const float*)d_in[8]; p.cv_w2 = (const float*)d_in[9]; p.sinks = (const float*)d_in[10];
    p.o_w_in = (const float*)d_in[11]; p.o_w_o = (const float*)d_in[12]; p.ln1_g = (const float*)d_in[13]; p.ln1_b = (const float*)d_in[14]; p.w1 = (const float*)d_in[15]; p.w2 = (const float*)d_in[16];
    p.ln2_g = (const float*)d_in[17]; p.ln2_b = (const float*)d_in[18]; p.out = (float*)d_out; p.ws = (unsigned char*)d_ws;
    for (int i = 0; i < 64; ++i) p.inv_freq[i] = (float)pow(10000.0, -(double)(2 * i) / 128.0);
#if DBG == 2
    {
        const int pe_ = 1 + (DBG_LAYER_EVEN / 2) * 19 + 3;
        const int po_ = 1 + (DBG_LAYER_ODD / 2) * 19 + 8;
        int li = 0;
#define RUN_MAIN(a_, b_) do { p.ph_lo = (a_); p.ph_hi = (b_); p.li = li++; hipLaunchKernelGGL(fwd_kernel, dim3(grid), dim3(NWAVES * 64), LDS_BYTES, stream, p); } while (0)
        RUN_MAIN(0, pe_); hipLaunchKernelGGL(dbg_even_kernel, dim3(dbg::NS), dim3(512), 49152, stream, p);
        RUN_MAIN(pe_, po_ + 2); hipLaunchKernelGGL(dbg_odd_kernel, dim3(dbg::NS), dim3(512), 49152, stream, p, 0);
        RUN_MAIN(po_ + 2, po_ + 4); hipLaunchKernelGGL(dbg_odd_kernel, dim3(dbg::NS), dim3(512), 49152, stream, p, 1);
        RUN_MAIN(po_ + 4, po_ + 6); hipLaunchKernelGGL(dbg_odd_kernel, dim3(dbg::NS), dim3(512), 49152, stream, p, 2);
        RUN_MAIN(po_ + 6, N_PHASES);
        hipLaunchKernelGGL(dbg_report_kernel, dim3(1), dim3(512), 0, stream, p);
    }
#elif DBG == 1
    p.ph_lo = 0; p.ph_hi = N_PHASES;
    hipLaunchKernelGGL(fwd_kernel, dim3(grid), dim3(NWAVES * 64), LDS_BYTES, stream, p);
    hipLaunchKernelGGL(dbg_report_kernel, dim3(256), dim3(512), 0, stream, p);
#elif MK_PER_PHASE
    for (int ph = 0; ph < N_PHASES; ++ph) { p.ph_lo = ph; p.ph_hi = ph + 1; hipLaunchKernelGGL(fwd_kernel, dim3(grid), dim3(NWAVES * 64), LDS_BYTES, stream, p); }
#else
    p.ph_lo = 0; p.ph_hi = N_PHASES;
    hipLaunchKernelGGL(fwd_kernel, dim3(grid), dim3(NWAVES * 64), LDS_BYTES, stream, p);
#endif
    const hipError_t le = hipPeekAtLastError();
    if (le != hipSuccess) fprintf(stderr, "kernel_launch: launch failed: %s\n", hipGetErrorName(le));
}
```

```cpp
#include <hip/hip_runtime.h>
#include <cstdio>
#include <cstdint>
#include <cmath>

constexpr int BATCH = 2, T = 16384, DM = 2048, DEPTH = 4, HD = 128, DFF = 8192;
constexpr int M = BATCH * T;
constexpr int EVEN_IN = 4120, EVEN_NPAD = 4352, ODD_IN = 18432, ODD_G = 6144;
constexpr float LN_EPS = 1e-5f;
constexpr float DN_ALPHA = 1.6817928305074290f;

constexpr size_t MiB = 1u << 20;
constexpr size_t WS_CTL = 0, CTL_ZERO_BYTES = 1 * MiB;
constexpr size_t WS_ROPEC = 1 * MiB, WS_ROPES = 9 * MiB;
constexpr size_t WS_GATES = 17 * MiB;
constexpr size_t WS_KC = 20 * MiB, WS_VC = 21 * MiB;
constexpr size_t WS_LSE = 22 * MiB;
constexpr size_t WS_STATS = 30 * MiB;
constexpr size_t WS_CW = 24 * MiB;
constexpr size_t WS_W = 32 * MiB;
constexpr size_t W_WIN = 0, W_WO = (size_t)ODD_IN * DM * 2, W_W1 = W_WO + (size_t)DM * DM * 2, W_W2 = W_W1 + (size_t)DFF * DM * 2, W_END = W_W2 + (size_t)DM * DFF * 2;
constexpr size_t WS_XB = 248 * MiB;
constexpr size_t WS_R = 376 * MiB;
constexpr size_t WS_O = 760 * MiB;
constexpr size_t WS_OWIN = 888 * MiB;
constexpr size_t WS_XB8 = 952 * MiB;
constexpr size_t WS_END = 1016 * MiB;
static_assert(WS_W + W_END <= WS_XB && WS_R + 384 * MiB == WS_O && WS_O + 128 * MiB == WS_OWIN, "d_ws map");
constexpr size_t R_QA = 0, R_KA = 64 * MiB, R_VA = 112 * MiB, R_QB = 160 * MiB, R_KB = 224 * MiB, R_VB = 240 * MiB;
constexpr size_t R_QG = 0, R_KG = 128 * MiB, R_VG = 256 * MiB;


template <int K> __device__ __forceinline__ unsigned xl_u(unsigned v) { return (unsigned)__builtin_amdgcn_ds_swizzle((int)v, (K << 10) | 0x1f); }
template <int K> __device__ __forceinline__ float xl_f(float v) { return __uint_as_float(xl_u<K>(__float_as_uint(v))); }
__device__ __forceinline__ unsigned x32_u(unsigned v, int hi) { auto rr = __builtin_amdgcn_permlane32_swap(v, v, false, false); return hi ? rr[0] : rr[1]; }
__device__ __forceinline__ float x32_sum(float v) { auto rr = __builtin_amdgcn_permlane32_swap(__float_as_uint(v), __float_as_uint(v), false, false); return __uint_as_float(rr[0]) + __uint_as_float(rr[1]); }
__device__ __forceinline__ unsigned x32_or(unsigned v) { auto rr = __builtin_amdgcn_permlane32_swap(v, v, false, false); return rr[0] | rr[1]; }
namespace pg8 {
#define PG8_LAS __attribute__((address_space(3)))
typedef unsigned short bf16_t;
typedef short bf16x8 __attribute__((ext_vector_type(8)));
typedef float f32x4 __attribute__((ext_vector_type(4)));
typedef unsigned u32x4 __attribute__((ext_vector_type(4)));
constexpr int BM = 256, BK = 64, HALF = 128, HTB = HALF * BK * 2  , STAGE_BYTES = 8 * HTB, NXCD = 8, WGM = 8;

__host__ __device__ __forceinline__ int lds_byte(int r, int c) { const int st = (r >> 4) * 2 + (c >> 5), rr = r & 15, cc = c & 31, ob = rr * 64 + cc * 2; return st * 1024 + (ob ^ (((ob >> 9) & 1) << 5)); }
__host__ __device__ __forceinline__ void stage_rc(int b, int& R, int& C) { const int st = b / 1024, sb = b % 1024, swz = sb ^ (((sb >> 9) & 1) << 5); R = (st >> 1) * 16 + swz / 64; C = (st & 1) * 32 + (swz % 64) / 2; }
__host__ __device__ __forceinline__ int perm32(int rho) { const int n = rho >> 4, i = rho & 15; return 8 * (i >> 2) + 4 * n + (i & 3); }

struct Unit { int pm, pn; };
struct Gemm { const bf16_t* A; const bf16_t* Bt; int M, N, K; };

struct StaticOrder {
    int nM, nN, nwg, G, c, wgm;
    __host__ __device__ void init(int M, int N, int G_, int c_, int wgm_ = WGM) { nM = M / BM; nN = N / BM; nwg = nM * nN; G = G_; c = c_; wgm = wgm_; }
    __host__ __device__ bool next(int i, Unit& u) const {
        const long L = (long)i * G + c; if (L >= nwg) return false;
        int wgid = (int)L; { const int q = nwg / NXCD, r = nwg % NXCD, xcd = wgid % NXCD, off = wgid / NXCD; wgid = (xcd < r ? xcd * (q + 1) : r * (q + 1) + (xcd - r) * q) + off; }
        const int nig = wgm * nN, gid = wgid / nig, fm = gid * wgm, gsz = (nM - fm) < wgm ? (nM - fm) : wgm;
        u.pm = fm + ((wgid % nig) % gsz); u.pn = (wgid % nig) / gsz; return true;
    }
    __device__ __forceinline__ void a_ready(const Unit&) const {}
    __device__ __forceinline__ void done(const Unit&) const {}
};

__device__ __forceinline__ unsigned cvt_pk_bf16(float lo, float hi) { unsigned r; asm volatile("v_cvt_pk_bf16_f32 %0, %1, %2" : "=v"(r) : "v"(lo), "v"(hi)); return r; }
typedef float f32x2 __attribute__((ext_vector_type(2)));

typedef unsigned u32x2 __attribute__((ext_vector_type(2)));
template <class V> __device__ __forceinline__ V ldg_(const void* sbase, unsigned boff) { return *(const V*)((const char*)sbase + boff); }
template <class V> __device__ __forceinline__ void stg_(void* sbase, unsigned boff, V v) { *(V*)((char*)sbase + boff) = v; }
__device__ __forceinline__ void rope_load(const void* sbase, unsigned boff, float dq, f32x4& cs, f32x4& sn) {
    const u32x4 w = ldg_<u32x4>(sbase, boff);
#pragma unroll
    for (int i = 0; i < 4; ++i) { cs[i] = (float)__builtin_bit_cast(_Float16, (unsigned short)(w[i] & 0xffffu)) * dq; sn[i] = (float)__builtin_bit_cast(_Float16, (unsigned short)(w[i] >> 16)) * dq; }
}
__device__ __forceinline__ void rope_store(const f32x4 a0, const f32x4 a1, const f32x4 cs, const f32x4 sn, void* sbase, unsigned boff) {
    const f32x4 o0 = a0 * cs - a1 * sn, o1 = a1 * cs + a0 * sn;
    u32x2 w0, w1; w0.x = cvt_pk_bf16(o0[0], o0[1]); w0.y = cvt_pk_bf16(o0[2], o0[3]); w1.x = cvt_pk_bf16(o1[0], o1[1]); w1.y = cvt_pk_bf16(o1[2], o1[3]);
    stg_<u32x2>(sbase, boff, w0); stg_<u32x2>(sbase, boff + 128, w1);
}
struct EpiNull { static constexpr bool PERM = false, AFTER_DRAIN = false;
    __device__ __forceinline__ void operator()(const f32x4 (&acc)[2][2][4][2], const Unit& u, int wr, int wc, int fr, int fq) const {
#pragma unroll
        for (int ai = 0; ai < 2; ++ai)
#pragma unroll
            for (int bj = 0; bj < 2; ++bj) asm volatile("" :: "v"(acc[ai][bj][0][0]), "v"(acc[ai][bj][0][1]), "v"(acc[ai][bj][1][0]), "v"(acc[ai][bj][1][1]), "v"(acc[ai][bj][2][0]), "v"(acc[ai][bj][2][1]), "v"(acc[ai][bj][3][0]), "v"(acc[ai][bj][3][1])); } };
__device__ __forceinline__ void rope_store16(const f32x4 a0, const f32x4 a1, const f32x4 cs, const f32x4 sn, void* sbase, unsigned boff) {
    const f32x4 o0 = a0 * cs - a1 * sn, o1 = a1 * cs + a0 * sn;
    u32x4 w; w.x = cvt_pk_bf16(o0[0], o0[1]); w.y = cvt_pk_bf16(o0[2], o0[3]); w.z = cvt_pk_bf16(o1[0], o1[1]); w.w = cvt_pk_bf16(o1[2], o1[3]);
    stg_<u32x4>(sbase, boff, w);
}
struct EpiEven {
    static constexpr bool PERM = false, AFTER_DRAIN = false;
    unsigned char* ws; float dq;
    __device__ __forceinline__ void operator()(const f32x4 (&acc)[2][2][4][2], const Unit& u, int wr, int wc, int fr, int fq) const {
        int tl_ = threadIdx.x; asm volatile("" : "+v"(tl_));
        wr = (tl_ >> 8) & 1; wc = (tl_ >> 6) & 3; fr = tl_ & 15; fq = (tl_ >> 4) & 3;
        const unsigned rl = (unsigned)(wr * 64 + fr);
        const int b = u.pm >> 6, tb = (u.pm & 63) * 256;
        unsigned char* dst[2]; bool rope = true;
#pragma unroll
        for (int bj = 0; bj < 2; ++bj) { const int cb = 2 * u.pn + bj; size_t base; int nH, hh;
            if (cb < 8) { base = R_QA; nH = 8; hh = cb; } else if (cb < 14) { base = R_KA; nH = 6; hh = cb - 8; } else if (cb < 20) { base = R_VA; nH = 6; hh = cb - 14; rope = false; }
            else if (cb < 28) { base = R_QB; nH = 8; hh = cb - 20; } else if (cb < 30) { base = R_KB; nH = 2; hh = cb - 28; } else { base = R_VB; nH = 2; hh = cb - 30; rope = false; }
            dst[bj] = ws + WS_R + base + ((size_t)(b * nH + hh) * T + tb) * 256; }
        const unsigned so = (rl * 128 + 16 * wc + 4 * fq) * 2, ro_ = (rl * 64 + 16 * wc + 4 * fq) * 4;
        const unsigned char* rc = ws + WS_ROPEC + (size_t)u.pm * 256 * 256;
#pragma unroll
        for (int ai = 0; ai < 2; ++ai) {
            f32x4 cs[4], sn[4];
#pragma unroll
            for (int m = 0; m < 4; ++m) { const int ro = ai * 128 + m * 16; cs[m] = (f32x4){dq, dq, dq, dq}; sn[m] = (f32x4){0.f, 0.f, 0.f, 0.f};
                if (rope) rope_load(rc, ro_ + ro * 256, dq, cs[m], sn[m]); }
#pragma unroll
            for (int m = 0; m < 4; ++m) { const int ro = ai * 128 + m * 16;
#pragma unroll
                for (int bj = 0; bj < 2; ++bj) rope_store(acc[ai][bj][m][0], acc[ai][bj][m][1], cs[m], sn[m], dst[bj], so + ro * 256); }
            asm volatile("" ::: "memory"); }
    }
};
struct EpiOdd {
    static constexpr bool PERM = false, AFTER_DRAIN = false;
    unsigned char* ws; int dsh;    float dq;    int norope;
    __device__ __forceinline__ void operator()(const f32x4 (&acc)[2][2][4][2], const Unit& u, int wr, int wc, int fr, int fq) const {
        int tl_ = threadIdx.x; asm volatile("" : "+v"(tl_));
        wr = (tl_ >> 8) & 1; wc = (tl_ >> 6) & 3; fr = tl_ & 15; fq = (tl_ >> 4) & 3;
        const unsigned rl = (unsigned)(wr * 64 + fr);
        const int b = u.pm >> 6, tb = (u.pm & 63) * 256;
        const bool rope = u.pn < 16 && norope != 1; const int lsh = 14 - dsh, dmask = (1 << dsh) - 1;
        unsigned char* dst[2];
#pragma unroll
        for (int bj = 0; bj < 2; ++bj) { const int cb = 2 * u.pn + bj, which = cb >> 4, h = cb & 15;
            dst[bj] = ws + WS_R + (which == 0 ? R_QG : (which == 1 ? R_KG : R_VG)) + (size_t)(b * 16 + h) * T * 256; }
        const unsigned co = (16 * wc + 4 * fq) * 2, ro_ = (rl * 64 + 16 * wc + 4 * fq) * 4;
        const unsigned char* rc = ws + WS_ROPEC + (size_t)u.pm * 256 * 256;
#pragma unroll
        for (int ai = 0; ai < 2; ++ai) {
            f32x4 cs[4], sn[4];
#pragma unroll
            for (int m = 0; m < 4; ++m) { const int ro = ai * 128 + m * 16; cs[m] = (f32x4){dq, dq, dq, dq}; sn[m] = (f32x4){0.f, 0.f, 0.f, 0.f};
                if (rope) rope_load(rc, ro_ + ro * 256, dq, cs[m], sn[m]); }
#pragma unroll
            for (int m = 0; m < 4; ++m) { const int ro = ai * 128 + m * 16; const unsigned t = (unsigned)tb + rl + ro, row = ((t & dmask) << lsh) + (t >> dsh);
#pragma unroll
                for (int bj = 0; bj < 2; ++bj) { if (norope == 2) rope_store16(acc[ai][bj][m][0], acc[ai][bj][m][1], cs[m], sn[m], dst[bj], row * 256 + 2 * co); else rope_store(acc[ai][bj][m][0], acc[ai][bj][m][1], cs[m], sn[m], dst[bj], row * 256 + co); } }
            asm volatile("" ::: "memory"); }
    }
};
struct EpiResid {
    static constexpr bool PERM = false, AFTER_DRAIN = false;
    const float* base; float* out; int ldc; float alpha; const float* stats; const float* gam; const float* bet;
    __device__ __forceinline__ void operator()(const f32x4 (&acc)[2][2][4][2], const Unit& u, int wr, int wc, int fr, int fq) const {
        int tl_ = threadIdx.x; asm volatile("" : "+v"(tl_));
        wr = (tl_ >> 8) & 1; wc = (tl_ >> 6) & 3; fr = tl_ & 15; fq = (tl_ >> 4) & 3;
        const size_t tile = ((size_t)u.pm * BM * ldc + (size_t)u.pn * BM) * 4;
        const unsigned lo_ = ((unsigned)(wr * 64 + fr) * (unsigned)ldc + wc * 32 + 4 * fq) * 4;
        unsigned char* op = (unsigned char*)out + tile; const bool ln = gam != nullptr;
        const unsigned char* bp = ln ? op : (const unsigned char*)base + tile;
        const unsigned char* sp = (const unsigned char*)stats + (size_t)u.pm * BM * 8; const unsigned so_ = (unsigned)(wr * 64 + fr) * 8;
        const unsigned char* gp = (const unsigned char*)gam + (size_t)u.pn * BM * 4; const unsigned char* tp = (const unsigned char*)bet + (size_t)u.pn * BM * 4; const unsigned co_ = (wc * 32 + 4 * fq) * 4;
#pragma unroll
        for (int ai = 0; ai < 2; ++ai)
#pragma unroll
            for (int mp = 0; mp < 2; ++mp) {
                f32x4 bs[2][2][2]; typedef float f32x2_ __attribute__((ext_vector_type(2))); f32x2_ st[2] = {{0.f, 1.f}, {0.f, 1.f}};
#pragma unroll
                for (int mm = 0; mm < 2; ++mm) { const int rg = ai * HALF + (2 * mp + mm) * 16; const unsigned ro = lo_ + (unsigned)rg * (unsigned)ldc * 4;
                    if (ln) st[mm] = ldg_<f32x2_>(sp, so_ + rg * 8);
#pragma unroll
                    for (int bj = 0; bj < 2; ++bj)
#pragma unroll
                        for (int n = 0; n < 2; ++n) bs[mm][bj][n] = ldg_<f32x4>(bp, ro + (bj * HALF + n * 16) * 4); }
#pragma unroll
                for (int bj = 0; bj < 2; ++bj)
#pragma unroll
                    for (int n = 0; n < 2; ++n) { f32x4 g4 = {1.f, 1.f, 1.f, 1.f}, b4 = {0.f, 0.f, 0.f, 0.f};
                        if (ln) { g4 = ldg_<f32x4>(gp, co_ + (bj * HALF + n * 16) * 4); b4 = ldg_<f32x4>(tp, co_ + (bj * HALF + n * 16) * 4); }
#pragma unroll
                        for (int mm = 0; mm < 2; ++mm) { const unsigned ro = lo_ + (unsigned)(ai * HALF + (2 * mp + mm) * 16) * (unsigned)ldc * 4;
                            const f32x4 x = ln ? (bs[mm][bj][n] - st[mm].x) * st[mm].y * g4 + b4 : bs[mm][bj][n];
                            stg_<f32x4>(op, ro + (bj * HALF + n * 16) * 4, x * alpha + acc[ai][bj][2 * mp + mm][n]); } }
                asm volatile("" ::: "memory");
            }
    }
};
struct EpiRelu2 {
    static constexpr bool PERM = true, AFTER_DRAIN = false;
    bf16_t* O; int ldc;
    __device__ __forceinline__ void operator()(const f32x4 (&acc)[2][2][4][2], const Unit& u, int wr, int wc, int fr, int fq) const {
        int tl_ = threadIdx.x; asm volatile("" : "+v"(tl_));
        wr = (tl_ >> 8) & 1; wc = (tl_ >> 6) & 3; fr = tl_ & 15; fq = (tl_ >> 4) & 3;
        unsigned char* op = (unsigned char*)O + ((size_t)u.pm * BM * ldc + (size_t)u.pn * BM) * 2;
        const unsigned lo_ = ((unsigned)(wr * 64 + fr) * (unsigned)ldc + wc * 32 + 8 * fq) * 2;
#pragma unroll
        for (int ai = 0; ai < 2; ++ai)
#pragma unroll
            for (int m = 0; m < 4; ++m) { const unsigned ro = lo_ + (unsigned)(ai * HALF + m * 16) * (unsigned)ldc * 2;
#pragma unroll
                for (int bj = 0; bj < 2; ++bj) { f32x4 v0 = acc[ai][bj][m][0], v1 = acc[ai][bj][m][1];
#pragma unroll
                    for (int j = 0; j < 4; ++j) { const float a = fmaxf(v0[j], 0.f), c = fmaxf(v1[j], 0.f); v0[j] = a * a; v1[j] = c * c; }
                    u32x4 w; w.x = cvt_pk_bf16(v0[0], v0[1]); w.y = cvt_pk_bf16(v0[2], v0[3]); w.z = cvt_pk_bf16(v1[0], v1[1]); w.w = cvt_pk_bf16(v1[2], v1[3]);
                    stg_<u32x4>(op, ro + bj * HALF * 2, w); } }
    }
};

template <class Epi, class Sched, bool ALIGN_EPI = false, bool SP2 = false, bool FP8 = false>
__device__ __forceinline__ void gemm_phase(PG8_LAS unsigned char* lds, const Gemm g, const Sched& S, const Epi& E) {
    int tid_ = threadIdx.x; asm volatile("" : "+v"(tid_));
    const int tid = tid_, wid = __builtin_amdgcn_readfirstlane(tid >> 6), lane = tid & 63, wr = wid >> 2, wc = wid & 3, fr = lane & 15, fq = lane >> 4;
    const int K = g.K, nt = K / BK;
    unsigned voffA[2], voffB[2];
#pragma unroll
    for (int i = 0; i < 2; ++i) { int R, C; stage_rc(tid * 16 + i * 8192, R, C); const int Rb = Epi::PERM ? ((R & ~31) + perm32(R & 31)) : R;
        voffA[i] = (unsigned)(R * K + C) * 2u; voffB[i] = (unsigned)(Rb * K + C) * 2u; }
    const size_t rstep64 = (size_t)64 * K * 2;
    const size_t kstep = (size_t)(BK * 2);
    const size_t hstep = (size_t)HALF * K * 2;
    const size_t tstep = 2 * hstep;
    const unsigned ldsw = (unsigned)wid * 1024u;
    const int aoff = lds_byte(wr * 64 + fr, fq * 8), boff = lds_byte(wc * 32 + fr, fq * 8);
#define PG8_SA(b, h) (((b) * 2 + (h)) * HTB)
#define PG8_SB(b, h) ((4 + (b) * 2 + (h)) * HTB)
#define PG8_STAGE(bufoff, gbase, voff) do { _Pragma("unroll") for (int _i = 0; _i < 2; ++_i)   \
        __builtin_amdgcn_global_load_lds((const unsigned*)((const char*)(gbase) + (size_t)_i * rstep64 + (voff)[0]), (PG8_LAS unsigned*)(lds + (bufoff) + ldsw + _i * 8192), 16, 0, 0); } while (0)
#define PG8_LDA(dst, b, h) do { _Pragma("unroll") for (int m = 0; m < 4; ++m) _Pragma("unroll") for (int k = 0; k < 2; ++k) dst[m][k] = *(const PG8_LAS bf16x8*)(lds + PG8_SA(b, h) + aoff + m * 2048 + k * 1024); } while (0)
#define PG8_LDB(dst, b, h) do { _Pragma("unroll") for (int n = 0; n < 2; ++n) _Pragma("unroll") for (int k = 0; k < 2; ++k) dst[n][k] = *(const PG8_LAS bf16x8*)(lds + PG8_SB(b, h) + boff + n * 2048 + k * 1024); } while (0)
#define PG8_MMA(ai, bj, At, Bt) do { __builtin_amdgcn_s_setprio(1); _Pragma("unroll") for (int m = 0; m < 4; ++m) _Pragma("unroll") for (int n = 0; n < 2; ++n) { \
        if constexpr (FP8) { typedef int v4i_ __attribute__((ext_vector_type(4))); typedef int v8i_ __attribute__((ext_vector_type(8))); \
            const v8i_ b8 = __builtin_shufflevector(__builtin_bit_cast(v4i_, Bt[n][0]), __builtin_bit_cast(v4i_, Bt[n][1]), 0, 1, 2, 3, 4, 5, 6, 7), a8 = __builtin_shufflevector(__builtin_bit_cast(v4i_, At[m][0]), __builtin_bit_cast(v4i_, At[m][1]), 0, 1, 2, 3, 4, 5, 6, 7); \
            acc[ai][bj][m][n] = __builtin_amdgcn_mfma_scale_f32_16x16x128_f8f6f4(b8, a8, acc[ai][bj][m][n], 0, 0, 0, 0, 0, 0); } \
        else { _Pragma("unroll") for (int k = 0; k < 2; ++k) acc[ai][bj][m][n] = __builtin_amdgcn_mfma_f32_16x16x32_bf16(Bt[n][k], At[m][k], acc[ai][bj][m][n], 0, 0, 0); } } __builtin_amdgcn_s_setprio(0); } while (0)
#define PG8_WAIT_V(n) asm volatile("s_waitcnt vmcnt(" #n ")" ::: "memory")
#define PG8_WAIT_L(n) asm volatile("s_waitcnt lgkmcnt(" #n ")" ::: "memory")
#define PG8_BAR __builtin_amdgcn_s_barrier()
#define PG8_SCHED __builtin_amdgcn_sched_barrier(0)
    Unit cur, nxt; int ui = 0;
    if (!S.next(0, cur)) return;
    f32x4 acc[2][2][4][2];
#pragma unroll
    for (int a = 0; a < 2; ++a)
#pragma unroll
        for (int b = 0; b < 2; ++b)
#pragma unroll
            for (int m = 0; m < 4; ++m)
#pragma unroll
                for (int n = 0; n < 2; ++n) acc[a][b][m][n] = (f32x4){0.f, 0.f, 0.f, 0.f};
    bf16x8 At[4][2], B0[2][2], B1[2][2];
    const char* cA = (const char*)g.A + (size_t)cur.pm * tstep; const char* cB = (const char*)g.Bt + (size_t)cur.pn * tstep;
    S.a_ready(cur);
    if constexpr (SP2) {
        PG8_STAGE(PG8_SB(0, 0), cB, voffB); PG8_STAGE(PG8_SB(0, 1), cB + hstep, voffB); PG8_STAGE(PG8_SA(0, 0), cA, voffA); PG8_STAGE(PG8_SA(0, 1), cA + hstep, voffA);
        if (wr == 1) PG8_BAR;
        PG8_WAIT_V(2); PG8_BAR;
        PG8_STAGE(PG8_SB(1, 0), cB + kstep, voffB); PG8_STAGE(PG8_SA(1, 0), cA + kstep, voffA); PG8_STAGE(PG8_SB(1, 1), cB + hstep + kstep, voffB);
        PG8_WAIT_V(6); PG8_BAR;
    } else {
        PG8_STAGE(PG8_SB(0, 0), cB, voffB); PG8_STAGE(PG8_SA(0, 0), cA, voffA); PG8_STAGE(PG8_SB(0, 1), cB + hstep, voffB); PG8_STAGE(PG8_SA(0, 1), cA + hstep, voffA);
        if (wr == 1) PG8_BAR;
        PG8_WAIT_V(4); PG8_BAR;
        PG8_STAGE(PG8_SB(1, 0), cB + kstep, voffB); PG8_STAGE(PG8_SA(1, 0), cA + kstep, voffA); PG8_STAGE(PG8_SB(1, 1), cB + hstep + kstep, voffB);
        PG8_WAIT_V(6); PG8_BAR;
    }
    for (;;) {
        const bool has_next = S.next(ui + 1, nxt);
        const char* nA = has_next ? (const char*)g.A + (size_t)nxt.pm * tstep : cA; const char* nB = has_next ? (const char*)g.Bt + (size_t)nxt.pn * tstep : cB;
        for (int t = 0; t < nt; t += 2) {
            const bool last = (t == nt - 2);
            const char* a1 = cA + (size_t)(t + 1) * kstep;
            const char* a2 = last ? nA : cA + (size_t)(t + 2) * kstep; const char* b2 = last ? nB : cB + (size_t)(t + 2) * kstep;
            const char* a3 = a2 + kstep; const char* b3 = b2 + kstep;
            if (last && has_next) S.a_ready(nxt);
            if constexpr (SP2) {
            PG8_LDB(B0, 0, 0); PG8_LDB(B1, 0, 1); PG8_SCHED; PG8_LDA(At, 0, 0); PG8_STAGE(PG8_SA(1, 1), a1 + hstep, voffA);
            PG8_WAIT_V(8); PG8_WAIT_L(0); PG8_BAR; PG8_MMA(0, 0, At, B0); PG8_MMA(0, 1, At, B1); PG8_BAR; PG8_SCHED;
            PG8_LDA(At, 0, 1); PG8_STAGE(PG8_SB(0, 0), b2, voffB); PG8_STAGE(PG8_SB(0, 1), b2 + hstep, voffB); PG8_STAGE(PG8_SA(0, 0), a2, voffA);
            PG8_WAIT_V(8); PG8_WAIT_L(0); PG8_BAR; PG8_MMA(1, 0, At, B0); PG8_MMA(1, 1, At, B1); PG8_BAR; PG8_SCHED;
            PG8_LDB(B0, 1, 0); PG8_LDB(B1, 1, 1); PG8_SCHED; PG8_LDA(At, 1, 0); PG8_STAGE(PG8_SA(0, 1), a2 + hstep, voffA);
            PG8_WAIT_V(8); PG8_WAIT_L(0); PG8_BAR; PG8_MMA(0, 0, At, B0); PG8_MMA(0, 1, At, B1); PG8_BAR; PG8_SCHED;
            PG8_LDA(At, 1, 1); PG8_STAGE(PG8_SB(1, 0), b3, voffB); PG8_STAGE(PG8_SB(1, 1), b3 + hstep, voffB); PG8_STAGE(PG8_SA(1, 0), a3, voffA);
            PG8_WAIT_V(8); PG8_WAIT_L(0); PG8_BAR; PG8_MMA(1, 0, At, B0); PG8_MMA(1, 1, At, B1); PG8_BAR; PG8_SCHED;
            } else {
            PG8_LDB(B0, 0, 0); PG8_SCHED; PG8_LDA(At, 0, 0); PG8_STAGE(PG8_SA(1, 1), a1 + hstep, voffA);
            PG8_WAIT_L(8); PG8_BAR; PG8_WAIT_L(0); PG8_MMA(0, 0, At, B0); PG8_BAR; PG8_SCHED;
            PG8_LDB(B1, 0, 1); PG8_STAGE(PG8_SB(0, 0), b2, voffB);
            PG8_BAR; PG8_WAIT_L(0); PG8_MMA(0, 1, At, B1); PG8_BAR;
            PG8_LDA(At, 0, 1); PG8_STAGE(PG8_SA(0, 0), a2, voffA);
            PG8_BAR; PG8_WAIT_L(0); PG8_MMA(1, 0, At, B0); PG8_BAR; PG8_SCHED;
            PG8_STAGE(PG8_SB(0, 1), b2 + hstep, voffB);
            PG8_WAIT_V(6); PG8_BAR; PG8_MMA(1, 1, At, B1); PG8_BAR;
            PG8_LDB(B0, 1, 0); PG8_SCHED; PG8_LDA(At, 1, 0); PG8_STAGE(PG8_SA(0, 1), a2 + hstep, voffA);
            PG8_WAIT_L(8); PG8_BAR; PG8_WAIT_L(0); PG8_MMA(0, 0, At, B0); PG8_BAR; PG8_SCHED;
            PG8_LDB(B1, 1, 1); PG8_STAGE(PG8_SB(1, 0), b3, voffB);
            PG8_BAR; PG8_WAIT_L(0); PG8_MMA(0, 1, At, B1); PG8_BAR;
            PG8_LDA(At, 1, 1); PG8_STAGE(PG8_SA(1, 0), a3, voffA);
            PG8_BAR; PG8_WAIT_L(0); PG8_MMA(1, 0, At, B0); PG8_BAR; PG8_SCHED;
            PG8_STAGE(PG8_SB(1, 1), b3 + hstep, voffB);
            PG8_WAIT_V(6); PG8_BAR; PG8_MMA(1, 1, At, B1); PG8_BAR;
            }
        }
        if constexpr (ALIGN_EPI) { if (wr == 0) PG8_BAR; }
        if constexpr (!Epi::AFTER_DRAIN) { E(acc, cur, wr, wc, fr, fq); S.done(cur); }
        if (!has_next) break;
#pragma unroll
        for (int a = 0; a < 2; ++a)
#pragma unroll
            for (int b = 0; b < 2; ++b)
#pragma unroll
                for (int m = 0; m < 4; ++m)
#pragma unroll
                    for (int n = 0; n < 2; ++n) acc[a][b][m][n] = (f32x4){0.f, 0.f, 0.f, 0.f};
        cur = nxt; cA = nA; cB = nB; ++ui;
        if constexpr (ALIGN_EPI) { if (wr == 1) PG8_BAR; }
    }
    PG8_WAIT_V(0);
    if constexpr (!ALIGN_EPI) { if (wr == 0) PG8_BAR; }
    PG8_BAR;
    if constexpr (Epi::AFTER_DRAIN) { E.fused(acc, cur, wr, wc, fr, fq, lds, wid, lane); S.done(cur); }
#undef PG8_SA
#undef PG8_SB
#undef PG8_STAGE
#undef PG8_LDA
#undef PG8_LDB
#undef PG8_MMA
#undef PG8_WAIT_V
#undef PG8_WAIT_L
#undef PG8_BAR
#undef PG8_SCHED
}
}
#define GAS __attribute__((address_space(1)))
#define LAS __attribute__((address_space(3)))
typedef unsigned short bf16;
typedef unsigned v4u __attribute__((ext_vector_type(4)));
typedef float f32x4 __attribute__((ext_vector_type(4)));
typedef short bf16x8 __attribute__((ext_vector_type(8)));
typedef GAS unsigned gu32;
typedef GAS unsigned long long gu64;
#define RLX_AGENT __ATOMIC_RELAXED, __HIP_MEMORY_SCOPE_AGENT
#define LDS_WAIT() asm volatile("s_waitcnt lgkmcnt(0)" ::: "memory")
#define VM_WAIT() asm volatile("s_waitcnt vmcnt(0)" ::: "memory")
__device__ __forceinline__ unsigned long long rt() { return __builtin_amdgcn_s_memrealtime(); }
__device__ __forceinline__ unsigned f2bf(float f) { unsigned u = __builtin_bit_cast(unsigned, f); return (u + 0x7fffu + ((u >> 16) & 1u)) >> 16; }
__device__ __forceinline__ unsigned pk2(float lo, float hi) { return f2bf(lo) | (f2bf(hi) << 16); }

#define XB_TMO      128
#define XB_XCNT(j)  (256  + 64 * (j))
#define XB_XSUB(j)  (1280 + 64 * (j))
#define XB_XGEN(j)  (2304 + 64 * (j))
#define XB_TOP      3328
#define XB_TOPGEN   3392
#define XCD_BAR_WORDS 3456
#define XB_SPIN_CAP (1u << 18)

__device__ __forceinline__ unsigned xb_ld(unsigned* p)              { return __hip_atomic_load(p, __ATOMIC_RELAXED, __HIP_MEMORY_SCOPE_AGENT); }
__device__ __forceinline__ unsigned xb_add(unsigned* p, unsigned v) { return __hip_atomic_fetch_add(p, v, __ATOMIC_RELAXED, __HIP_MEMORY_SCOPE_AGENT); }
__device__ __forceinline__ unsigned xb_xcc_id() { return (unsigned)__builtin_amdgcn_s_getreg((3 << 11) | 20) & 0xFu; }
#define XB_SPIN(cond, bar) do { unsigned _sp = 0; while (cond) { __builtin_amdgcn_s_sleep(1); \
    if ((++_sp & 255u) == 0u) { if (xb_ld(&(bar)[XB_TMO])) break; if (_sp > XB_SPIN_CAP) { atomicAdd(&(bar)[XB_TMO], 1u); break; } } } } while (0)

struct XcdBarrier {
    unsigned* bar; unsigned x;
    volatile LAS unsigned* st;
};

__device__ __forceinline__ XcdBarrier xcd_barrier_post(unsigned* bar, volatile LAS unsigned* st) {
    XcdBarrier b; b.bar = bar; b.x = xb_xcc_id(); b.st = st;
    if (threadIdx.x == 0) (void)xb_add(&bar[XB_XCNT(b.x)], 1u);
    return b;
}
__device__ __forceinline__ void xcd_barrier_complete(unsigned* bar, unsigned x, unsigned& nloc, unsigned& nx) {
    const unsigned G = gridDim.x * gridDim.y * gridDim.z;
    unsigned sum, cnt, mine, sp = 0u;
    for (;;) {
        sum = 0u; cnt = 0u; mine = 0u;
#pragma unroll
        for (unsigned j = 0; j < 16; ++j) { const unsigned c = xb_ld(&bar[XB_XCNT(j)]); sum += c; cnt += (c > 0u) ? 1u : 0u; mine = (j == x) ? c : mine; }
        if (sum == G) break;
        __builtin_amdgcn_s_sleep(1);
        if ((++sp & 255u) == 0u) { if (xb_ld(&bar[XB_TMO])) break; if (sp > XB_SPIN_CAP) { atomicAdd(&bar[XB_TMO], 1u); break; } }
    }
    nloc = mine > 0u ? mine : 1u; nx = cnt > 0u ? cnt : 1u;
}

__device__ __forceinline__ void xcd_barrier(const XcdBarrier& b) {
    asm volatile("s_waitcnt vmcnt(0)" ::: "memory");
    __syncthreads();
    if (threadIdx.x == 0) {
        unsigned* bar = b.bar;
        __builtin_amdgcn_s_waitcnt(0);
        unsigned nloc = b.st[0], nx = b.st[1];
        if (nloc == 0u) { xcd_barrier_complete(bar, b.x, nloc, nx); b.st[0] = nloc; b.st[1] = nx; }
        const unsigned old = xb_add(&bar[XB_XSUB(b.x)], 1u);
        const unsigned gen = old / nloc;
        if (old + 1u == (gen + 1u) * nloc) {
            __builtin_amdgcn_fence(__ATOMIC_RELEASE, "agent");
            asm volatile("s_waitcnt vmcnt(0)" ::: "memory");
            const unsigned og = xb_add(&bar[XB_TOP], 1u);
            const unsigned tg = og / nx;
            if (og + 1u == (tg + 1u) * nx) xb_add(&bar[XB_TOPGEN], 1u);
            else XB_SPIN(xb_ld(&bar[XB_TOPGEN]) == tg, bar);
            __builtin_amdgcn_fence(__ATOMIC_ACQUIRE, "agent");
            xb_add(&bar[XB_XGEN(b.x)], 1u);
            asm volatile("s_waitcnt vmcnt(0)" ::: "memory");
        } else {
            XB_SPIN(xb_ld(&bar[XB_XGEN(b.x)]) == gen, bar);
            __builtin_amdgcn_fence(__ATOMIC_ACQUIRE, "agent");
            asm volatile("s_waitcnt vmcnt(0)" ::: "memory");
        }
    }
    __syncthreads();
}

namespace fa {
#define FA_LAS __attribute__((address_space(3)))
typedef unsigned short bf16;
typedef short bf16x8 __attribute__((ext_vector_type(8)));
typedef short s16x4 __attribute__((ext_vector_type(4)));
typedef float f32x16 __attribute__((ext_vector_type(16)));
typedef float f32x4 __attribute__((ext_vector_type(4)));
typedef unsigned u32x4 __attribute__((ext_vector_type(4)));
constexpr int D = 128, KVBLK = 64, SHM_V = KVBLK * D * 2, SHM_K = KVBLK * D * 2;
constexpr int OFF_V = 0, OFF_K = 2 * SHM_V, SLOT = 2 * SHM_V + 2 * SHM_K, OFF_WS = 135168, WS_PER_WAVE = 512, ENGINE_BYTES = OFF_WS + 8 * WS_PER_WAVE;
constexpr float SCALE = 0.08838834764831845f;
constexpr float THR = 8.f;
constexpr float C2 = 1.4426950408889634f * SCALE;
#define KSWZ(row, colB) ((row) * 256 + ((colB) ^ (((row) & 7) << 4)))
#define SBAR() __builtin_amdgcn_sched_barrier(0)
__device__ __forceinline__ int v_st(int k, int c) { const int kk = (k & ~0xC) | ((k & 4) << 1) | ((k & 8) >> 1); return ((kk >> 3) * 4 + (c >> 5)) * 512 + ((kk & 7) * 32 + (c & 31)) * 2; }
__device__ __forceinline__ int v_rd_base(int lane) { return ((lane & 3) << 3) | (((lane >> 2) & 3) << 6) | (((lane >> 4) & 1) << 5) | (((lane >> 5) & 1) << 8); }
constexpr int v_rd_off(int d0, int ks, int half) { return d0 * 512 + ks * 4096 + half * 2048; }
__device__ __forceinline__ int crow(int r, int hi) { return (r & 3) + 8 * (r >> 2) + 4 * hi; }
typedef float f32x2_t __attribute__((ext_vector_type(2))); typedef __bf16 bf16x2_t __attribute__((ext_vector_type(2)));
__device__ __forceinline__ unsigned cvtpk(float lo, float hi) { f32x2_t v = {lo, hi}; bf16x2_t b = __builtin_convertvector(v, bf16x2_t); return __builtin_bit_cast(unsigned, b); }
__device__ __forceinline__ float bf2f(unsigned short b) { return __uint_as_float(((unsigned)b) << 16); }
__device__ __forceinline__ void mask_tile(f32x16& p0, f32x16& p1, int dq, unsigned W) {
    const float NEG = -__builtin_inff();
#pragma unroll
    for (int r = 0; r < 16; ++r) { const int c = (r & 3) + 8 * (r >> 2);
        if ((unsigned)(dq - c) >= W) p0[r] = NEG;
        if ((unsigned)(dq - c - 32) >= W) p1[r] = NEG; }
}
__device__ __forceinline__ void mask_gt(f32x16& p0, f32x16& p1, int lim, int hi) {
    const float NEG = -__builtin_inff();
#pragma unroll
    for (int r = 0; r < 16; ++r) { const int c = (r & 3) + 8 * (r >> 2) + 4 * hi;
        if (c > lim) p0[r] = NEG;
        if (c + 32 > lim) p1[r] = NEG; }
}
__device__ __forceinline__ void partialSM(f32x16& p0, f32x16& p1, float& m_reg, float& mn, float& alpha) {
    float pmax = p0[0];
#pragma unroll
    for (int r = 1; r < 16; ++r) pmax = fmaxf(pmax, p0[r]);
#pragma unroll
    for (int r = 0; r < 16; ++r) pmax = fmaxf(pmax, p1[r]);
    { auto rr = __builtin_amdgcn_permlane32_swap(__float_as_uint(pmax), __float_as_uint(pmax), false, false);
      pmax = fmaxf(__uint_as_float(rr[0]), __uint_as_float(rr[1])); }
    if (__builtin_expect(__all((pmax - m_reg) * SCALE <= THR), 1)) { mn = m_reg; alpha = 1.f; }
    else { mn = fmaxf(m_reg, pmax); alpha = __builtin_amdgcn_exp2f((m_reg - mn) * C2); m_reg = mn; }
    const float mnL = -mn * C2;
#pragma unroll
    for (int r = 0; r < 16; ++r) p0[r] = fmaf(p0[r], C2, mnL);
#pragma unroll
    for (int r = 0; r < 16; ++r) p1[r] = fmaf(p1[r], C2, mnL);
#pragma unroll
    for (int r = 0; r < 16; ++r) p0[r] = __builtin_amdgcn_exp2f(p0[r]);
}
__device__ __forceinline__ void partialSM_sel(f32x16& p0, f32x16& p1, float& m_reg, float& mn, float& alpha, bool rowsel) {
    float pmax = p0[0];
#pragma unroll
    for (int r = 1; r < 16; ++r) pmax = fmaxf(pmax, p0[r]);
#pragma unroll
    for (int r = 0; r < 16; ++r) pmax = fmaxf(pmax, p1[r]);
    { auto rr = __builtin_amdgcn_permlane32_swap(__float_as_uint(pmax), __float_as_uint(pmax), false, false);
      pmax = fmaxf(__uint_as_float(rr[0]), __uint_as_float(rr[1])); }
    if (__builtin_expect(__all((pmax - m_reg) * SCALE <= THR), 1)) { mn = m_reg; alpha = 1.f; }
    else { mn = fmaxf(m_reg, pmax); alpha = __builtin_amdgcn_exp2f((m_reg - mn) * C2); m_reg = mn; }
    const float mnL = rowsel ? -mn * C2 : -__builtin_inff();
#pragma unroll
    for (int r = 0; r < 16; ++r) p0[r] = fmaf(p0[r], C2, mnL);
#pragma unroll
    for (int r = 0; r < 16; ++r) p1[r] = fmaf(p1[r], C2, mnL);
#pragma unroll
    for (int r = 0; r < 16; ++r) p0[r] = __builtin_amdgcn_exp2f(p0[r]);
}
#define FA_PK4(P, B_, OUT) do { unsigned a0 = cvtpk(P[B_+0], P[B_+1]), a1 = cvtpk(P[B_+2], P[B_+3]);                          \
        unsigned b0 = cvtpk(P[B_+4], P[B_+5]), b1 = cvtpk(P[B_+6], P[B_+7]);                                             \
        auto r0 = __builtin_amdgcn_permlane32_swap(a0, b0, false, false); auto r1 = __builtin_amdgcn_permlane32_swap(a1, b1, false, false); \
        u32x4 w = {r0[0], r1[0], r0[1], r1[1]}; OUT = *reinterpret_cast<bf16x8*>(&w); } while (0)
__device__ __forceinline__ void packP(const f32x16& p0, const f32x16& p1, bf16x8& pa0, bf16x8& pa1, bf16x8& pa2, bf16x8& pa3) {
    FA_PK4(p0, 0, pa0); FA_PK4(p0, 8, pa1); FA_PK4(p1, 0, pa2); FA_PK4(p1, 8, pa3);
}
__device__ __forceinline__ void finishSM(f32x16& p0, f32x16& p1, float alpha, float& l_reg, bf16x8& pa0, bf16x8& pa1, bf16x8& pa2, bf16x8& pa3) {
#pragma unroll
    for (int r = 0; r < 16; ++r) p1[r] = __builtin_amdgcn_exp2f(p1[r]);
    float ps = 0;
#pragma unroll
    for (int r = 0; r < 16; ++r) ps += p0[r];
#pragma unroll
    for (int r = 0; r < 16; ++r) ps += p1[r];
    { auto rr = __builtin_amdgcn_permlane32_swap(__float_as_uint(ps), __float_as_uint(ps), false, false);
      ps = __uint_as_float(rr[0]) + __uint_as_float(rr[1]); }
    l_reg = l_reg * alpha + ps;
    packP(p0, p1, pa0, pa1, pa2, pa3);
}
#define FA_K4(F, B_, A0, A1, O0, O1) asm volatile("ds_read_b128 %0, %4 offset:" O0 "\n\tds_read_b128 %1, %4 offset:" O1 "\n\tds_read_b128 %2, %5 offset:" O0 "\n\tds_read_b128 %3, %5 offset:" O1 \
                                      : "=&v"(F[B_ + 0]), "=&v"(F[B_ + 1]), "=&v"(F[B_ + 2]), "=&v"(F[B_ + 3]) : "v"(A0), "v"(A1) : "memory")
#define FA_W4(F, B_, N_) asm volatile("s_waitcnt lgkmcnt(" #N_ ")" : "+v"(F[B_ + 0]), "+v"(F[B_ + 1]), "+v"(F[B_ + 2]), "+v"(F[B_ + 3]) :: "memory")
#define FA_W8(F, B_, N_) asm volatile("s_waitcnt lgkmcnt(" #N_ ")" : "+v"(F[B_ + 0]), "+v"(F[B_ + 1]), "+v"(F[B_ + 2]), "+v"(F[B_ + 3]), "+v"(F[B_ + 4]), "+v"(F[B_ + 5]), "+v"(F[B_ + 6]), "+v"(F[B_ + 7]) :: "memory")
#define FA_QK2(F, B_, d0) do { p0 = __builtin_amdgcn_mfma_f32_32x32x16_bf16(F[B_ + 0], qr[d0], p0, 0, 0, 0); p1 = __builtin_amdgcn_mfma_f32_32x32x16_bf16(F[B_ + 1], qr[d0], p1, 0, 0, 0); \
                               p0 = __builtin_amdgcn_mfma_f32_32x32x16_bf16(F[B_ + 2], qr[d0 + 1], p0, 0, 0, 0); p1 = __builtin_amdgcn_mfma_f32_32x32x16_bf16(F[B_ + 3], qr[d0 + 1], p1, 0, 0, 0); } while (0)
__device__ __forceinline__ void qkt(f32x16& p0, f32x16& p1, const FA_LAS char* Kt, int r32, int hi, const bf16x8* qr) {
    p0 = f32x16{}; p1 = f32x16{};
    int ka[4];
#pragma unroll
    for (int dd = 0; dd < 4; ++dd) ka[dd] = (int)(unsigned)(uintptr_t)(Kt + KSWZ(r32, (dd * 16 + hi * 8) * 2));
    bf16x8 f[16];
    FA_K4(f, 0, ka[0], ka[1], "0", "8192"); FA_K4(f, 4, ka[2], ka[3], "0", "8192"); FA_K4(f, 8, ka[0], ka[1], "128", "8320");
    FA_W4(f, 0, 8); FA_QK2(f, 0, 0);
    SBAR();
    FA_W4(f, 4, 4); FA_K4(f, 12, ka[2], ka[3], "128", "8320"); FA_QK2(f, 4, 2);
    SBAR();
    FA_W4(f, 8, 4); FA_QK2(f, 8, 4);
    SBAR();
    FA_W4(f, 12, 0); FA_QK2(f, 12, 6);
}
struct VPre { s16x4 v[16]; };
#define FA_V8(F, B_, d0) do { constexpr int b_ = v_rd_off(d0, 0, 0); \
        asm volatile("ds_read_b64_tr_b16 %0, %8 offset:%9\n\tds_read_b64_tr_b16 %1, %8 offset:%10\n\tds_read_b64_tr_b16 %2, %8 offset:%11\n\tds_read_b64_tr_b16 %3, %8 offset:%12\n\t" \
                     "ds_read_b64_tr_b16 %4, %8 offset:%13\n\tds_read_b64_tr_b16 %5, %8 offset:%14\n\tds_read_b64_tr_b16 %6, %8 offset:%15\n\tds_read_b64_tr_b16 %7, %8 offset:%16" \
                     : "=&v"(F[B_ + 0]), "=&v"(F[B_ + 1]), "=&v"(F[B_ + 2]), "=&v"(F[B_ + 3]), "=&v"(F[B_ + 4]), "=&v"(F[B_ + 5]), "=&v"(F[B_ + 6]), "=&v"(F[B_ + 7]) \
                     : "v"(vb0), "i"(b_), "i"(b_ + 2048), "i"(b_ + 4096), "i"(b_ + 6144), "i"(b_ + 8192), "i"(b_ + 10240), "i"(b_ + 12288), "i"(b_ + 14336) : "memory"); } while (0)
__device__ __forceinline__ void pv_issue(int vb0, VPre& f) { FA_V8(f.v, 0, 0); FA_V8(f.v, 8, 1); }
#define FA_PVM(d0, F, B_) do { \
        o[d0] = __builtin_amdgcn_mfma_f32_32x32x16_bf16(pa0, (bf16x8){F[B_+0][0], F[B_+0][1], F[B_+0][2], F[B_+0][3], F[B_+1][0], F[B_+1][1], F[B_+1][2], F[B_+1][3]}, o[d0], 0, 0, 0);   \
        o[d0] = __builtin_amdgcn_mfma_f32_32x32x16_bf16(pa1, (bf16x8){F[B_+2][0], F[B_+2][1], F[B_+2][2], F[B_+2][3], F[B_+3][0], F[B_+3][1], F[B_+3][2], F[B_+3][3]}, o[d0], 0, 0, 0);   \
        o[d0] = __builtin_amdgcn_mfma_f32_32x32x16_bf16(pa2, (bf16x8){F[B_+4][0], F[B_+4][1], F[B_+4][2], F[B_+4][3], F[B_+5][0], F[B_+5][1], F[B_+5][2], F[B_+5][3]}, o[d0], 0, 0, 0);   \
        o[d0] = __builtin_amdgcn_mfma_f32_32x32x16_bf16(pa3, (bf16x8){F[B_+6][0], F[B_+6][1], F[B_+6][2], F[B_+6][3], F[B_+7][0], F[B_+7][1], F[B_+7][2], F[B_+7][3]}, o[d0], 0, 0, 0); } while (0)
__device__ __forceinline__ void pv_tile(f32x16* o, int vb0, bf16x8 pa0, bf16x8 pa1, bf16x8 pa2, bf16x8 pa3, VPre& f) {
    s16x4 g[16];
    FA_W8(f.v, 0, 0); FA_W8(f.v, 8, 0);
    FA_V8(g, 0, 2);
    SBAR();
    FA_PVM(0, f.v, 0);
    SBAR();
    FA_V8(g, 8, 3);
    SBAR();
    FA_PVM(1, f.v, 8);
    SBAR();
    FA_W8(g, 0, 8); FA_PVM(2, g, 0);
    SBAR();
    FA_W8(g, 8, 0); FA_PVM(3, g, 8);
}
#define FA_K4S(F, B_, A, O0, O1, O2, O3) asm volatile("ds_read_b128 %0, %4 offset:" O0 "\n\tds_read_b128 %1, %4 offset:" O1 "\n\tds_read_b128 %2, %4 offset:" O2 "\n\tds_read_b128 %3, %4 offset:" O3 \
                                      : "=&v"(F[B_ + 0]), "=&v"(F[B_ + 1]), "=&v"(F[B_ + 2]), "=&v"(F[B_ + 3]) : "v"(A) : "memory")
#define FA_QK16(F, B_, ks) do { s[0] = __builtin_amdgcn_mfma_f32_16x16x32_bf16(F[B_ + 0], qh[ks], s[0], 0, 0, 0); s[1] = __builtin_amdgcn_mfma_f32_16x16x32_bf16(F[B_ + 1], qh[ks], s[1], 0, 0, 0); \
                                 s[2] = __builtin_amdgcn_mfma_f32_16x16x32_bf16(F[B_ + 2], qh[ks], s[2], 0, 0, 0); s[3] = __builtin_amdgcn_mfma_f32_16x16x32_bf16(F[B_ + 3], qh[ks], s[3], 0, 0, 0); } while (0)
__device__ __forceinline__ void qk16(f32x4* s, int a0, int a1, const bf16x8* qh) {
    s[0] = f32x4{0.f, 0.f, 0.f, 0.f}; s[1] = s[0]; s[2] = s[0]; s[3] = s[0];
    bf16x8 f[16];
    FA_K4S(f, 0, a0, "0", "4096", "8192", "12288"); FA_K4S(f, 4, a1, "0", "4096", "8192", "12288"); FA_K4S(f, 8, a0, "128", "4224", "8320", "12416");
    FA_W4(f, 0, 8); FA_QK16(f, 0, 0);
    SBAR();
    FA_W4(f, 4, 4); FA_K4S(f, 12, a1, "128", "4224", "8320", "12416"); FA_QK16(f, 4, 1);
    SBAR();
    FA_W4(f, 8, 4); FA_QK16(f, 8, 2);
    SBAR();
    FA_W4(f, 12, 0); FA_QK16(f, 12, 3);
}
__device__ __forceinline__ int v16_rd_base(int lane) { const int g4 = lane >> 4, q = (lane & 15) >> 2, p = lane & 3, k0 = 4 * g4 + q, kk0 = (k0 & ~0xC) | ((k0 & 4) << 1) | ((k0 & 8) >> 1); return ((kk0 >> 3) * 4) * 512 + ((kk0 & 7) * 32 + 4 * p) * 2; }
#define FA_V8H(F, B_, dbp) do { constexpr int b_ = (dbp) * 512; \
        asm volatile("ds_read_b64_tr_b16 %0, %8 offset:%9\n\tds_read_b64_tr_b16 %1, %8 offset:%10\n\tds_read_b64_tr_b16 %2, %8 offset:%11\n\tds_read_b64_tr_b16 %3, %8 offset:%12\n\t" \
                     "ds_read_b64_tr_b16 %4, %8 offset:%13\n\tds_read_b64_tr_b16 %5, %8 offset:%14\n\tds_read_b64_tr_b16 %6, %8 offset:%15\n\tds_read_b64_tr_b16 %7, %8 offset:%16" \
                     : "=&v"(F[B_ + 0]), "=&v"(F[B_ + 1]), "=&v"(F[B_ + 2]), "=&v"(F[B_ + 3]), "=&v"(F[B_ + 4]), "=&v"(F[B_ + 5]), "=&v"(F[B_ + 6]), "=&v"(F[B_ + 7]) \
                     : "v"(vb0), "i"(b_), "i"(b_ + 4096), "i"(b_ + 8192), "i"(b_ + 12288), "i"(b_ + 32), "i"(b_ + 32 + 4096), "i"(b_ + 32 + 8192), "i"(b_ + 32 + 12288) : "memory"); } while (0)
__device__ __forceinline__ void pv16_issue(int vb0, VPre& f) { FA_V8H(f.v, 0, 0); FA_V8H(f.v, 8, 1); }
#define FA_PVM16(db, F, B_) do { \
        o[db] = __builtin_amdgcn_mfma_f32_16x16x32_bf16(pa0, (bf16x8){F[B_+0][0], F[B_+0][1], F[B_+0][2], F[B_+0][3], F[B_+1][0], F[B_+1][1], F[B_+1][2], F[B_+1][3]}, o[db], 0, 0, 0);   \
        o[db] = __builtin_amdgcn_mfma_f32_16x16x32_bf16(pa1, (bf16x8){F[B_+2][0], F[B_+2][1], F[B_+2][2], F[B_+2][3], F[B_+3][0], F[B_+3][1], F[B_+3][2], F[B_+3][3]}, o[db], 0, 0, 0); } while (0)
__device__ __forceinline__ void pv16(f32x4* o, int vb0, bf16x8 pa0, bf16x8 pa1, VPre& f) {
    s16x4 g[16];
    FA_W8(f.v, 0, 0); FA_W8(f.v, 8, 0);
    FA_V8H(g, 0, 2); FA_V8H(g, 8, 3);
    SBAR();
    FA_PVM16(0, f.v, 0); FA_PVM16(1, f.v, 4); FA_PVM16(2, f.v, 8); FA_PVM16(3, f.v, 12);
    SBAR();
    FA_W8(g, 0, 8); FA_PVM16(4, g, 0); FA_PVM16(5, g, 4);
    SBAR();
    FA_W8(g, 8, 0); FA_PVM16(6, g, 8); FA_PVM16(7, g, 12);
}
__device__ __forceinline__ void sm16_max(const f32x4* s, float& m_reg, float& mn, float& alpha) {
    float pmax = fmaxf(fmaxf(s[0][0], s[0][1]), fmaxf(s[0][2], s[0][3]));
#pragma unroll
    for (int mb = 1; mb < 4; ++mb) pmax = fmaxf(pmax, fmaxf(fmaxf(s[mb][0], s[mb][1]), fmaxf(s[mb][2], s[mb][3])));
    pmax = fmaxf(pmax, xl_f<16>(pmax));
    { auto rr = __builtin_amdgcn_permlane32_swap(__float_as_uint(pmax), __float_as_uint(pmax), false, false); pmax = fmaxf(__uint_as_float(rr[0]), __uint_as_float(rr[1])); }
    if (__builtin_expect(__all((pmax - m_reg) * SCALE <= THR), 1)) { mn = m_reg; alpha = 1.f; }
    else { mn = fmaxf(m_reg, pmax); alpha = __builtin_amdgcn_exp2f((m_reg - mn) * C2); m_reg = mn; }
}
__device__ __forceinline__ void sm16_fin(f32x4* s, float mn, float alpha, bool rowsel, float& l_reg, bf16x8& pa0, bf16x8& pa1) {
    const float mnL = rowsel ? -mn * C2 : -__builtin_inff();
    float ps = 0.f;
#pragma unroll
    for (int mb = 0; mb < 4; ++mb)
#pragma unroll
        for (int j = 0; j < 4; ++j) { s[mb][j] = __builtin_amdgcn_exp2f(fmaf(s[mb][j], C2, mnL)); ps += s[mb][j]; }
    ps += xl_f<16>(ps); ps = x32_sum(ps);
    l_reg = l_reg * alpha + ps;
    { u32x4 w = {cvtpk(s[0][0], s[0][1]), cvtpk(s[0][2], s[0][3]), cvtpk(s[1][0], s[1][1]), cvtpk(s[1][2], s[1][3])}; pa0 = *reinterpret_cast<bf16x8*>(&w); }
    { u32x4 w = {cvtpk(s[2][0], s[2][1]), cvtpk(s[2][2], s[2][3]), cvtpk(s[3][0], s[3][1]), cvtpk(s[3][2], s[3][3])}; pa1 = *reinterpret_cast<bf16x8*>(&w); }
}
__device__ __forceinline__ void rescale16(f32x4* o, float alpha, float l_prev, volatile FA_LAS float* al16, int n16, int g4) {
    if (__any(alpha < 1.f && l_prev > 0.f)) { if (g4 == 0) al16[n16] = alpha; asm volatile("s_waitcnt lgkmcnt(0)" ::: "memory");
        const float a0 = al16[4 * g4], a1 = al16[4 * g4 + 1], a2 = al16[4 * g4 + 2], a3 = al16[4 * g4 + 3];
#pragma unroll
        for (int db = 0; db < 8; ++db) { o[db][0] *= a0; o[db][1] *= a1; o[db][2] *= a2; o[db][3] *= a3; }
        asm volatile("s_waitcnt lgkmcnt(0)" ::: "memory"); }
}
struct DmaOff { unsigned k0, k1, v0, v1; };
__device__ __forceinline__ DmaOff dma_offsets(int wid, int lane) {
    DmaOff d; unsigned ko[2], vo[2];
#pragma unroll
    for (int i = 0; i < 2; ++i) { const int q = (2 * wid + i) * 64 + lane;
        { const int row = q >> 4, c16 = (q & 15) ^ (row & 7); ko[i] = (unsigned)(row * 256 + c16 * 16); }
        { const int sub = q >> 5, kk = (sub >> 2) * 8 + ((q & 31) >> 2), c = (sub & 3) * 32 + (q & 3) * 8, k = (kk & ~0xC) | ((kk & 4) << 1) | ((kk & 8) >> 1); vo[i] = (unsigned)(k * 256 + c * 2); } }
    d.k0 = ko[0]; d.k1 = ko[1]; d.v0 = vo[0]; d.v1 = vo[1]; return d;
}
__device__ __forceinline__ void dma_k(const char* src_tile, FA_LAS char* img, int wid, const DmaOff& d) {
    __builtin_amdgcn_global_load_lds((const unsigned*)(src_tile + d.k0), (FA_LAS unsigned*)(img + (2 * wid) * 1024), 16, 0, 0);
    __builtin_amdgcn_global_load_lds((const unsigned*)(src_tile + d.k1), (FA_LAS unsigned*)(img + (2 * wid + 1) * 1024), 16, 0, 0);
}
__device__ __forceinline__ void dma_v(const char* src_tile, FA_LAS char* img, int wid, const DmaOff& d) {
    __builtin_amdgcn_global_load_lds((const unsigned*)(src_tile + d.v0), (FA_LAS unsigned*)(img + (2 * wid) * 1024), 16, 0, 0);
    __builtin_amdgcn_global_load_lds((const unsigned*)(src_tile + d.v1), (FA_LAS unsigned*)(img + (2 * wid + 1) * 1024), 16, 0, 0);
}
#define FA_DMA_SYNC() do { asm volatile("s_waitcnt vmcnt(0)" ::: "memory"); __syncthreads(); } while (0)
__device__ __forceinline__ void rescale_o(f32x16* o, float alpha, float l_prev, volatile FA_LAS float* al_l, int r32, int hi) {
    if (__any(alpha < 1.f && l_prev > 0.f)) { if (hi == 0) al_l[r32] = alpha; asm volatile("s_waitcnt lgkmcnt(0)" ::: "memory");
#pragma unroll
        for (int d_ = 0; d_ < 4; ++d_)
#pragma unroll
            for (int r = 0; r < 16; ++r) o[d_][r] *= al_l[crow(r, hi)];
        asm volatile("s_waitcnt lgkmcnt(0)" ::: "memory"); }
}

struct BandArgs { const bf16* Q; const bf16* K; const bf16* V; bf16* O; size_t o_stride; float* lse; size_t lse_stride; int P0, W, mode; float sink;
                  const bf16* nK; const bf16* nV; int nP0, nW, has_next, prefetched; };
__device__ __forceinline__ void banded_unit(FA_LAS char* lds, const BandArgs& a) {
    int tid_ = threadIdx.x; asm volatile("" : "+v"(tid_));
    const int tid = tid_, wid = __builtin_amdgcn_readfirstlane(tid >> 6), lane = tid & 63, r32 = lane & 31, hi = lane >> 5;
    const int P0 = a.P0, W = a.W;
    const int lowk = P0 - W + 1, j_lo = lowk > 0 ? (lowk >> 6) : 0, j_hi = (P0 >> 6) + 4, NT = j_hi - j_lo;
    const int qlo = P0 + wid * 32, qm = qlo + r32 - 4 * hi;
    const FA_LAS char* V_lds = lds + OFF_V; const FA_LAS char* K_lds = lds + OFF_K;
    volatile FA_LAS float* ws = (volatile FA_LAS float*)(lds + OFF_WS + wid * WS_PER_WAVE); volatile FA_LAS float* li_l = ws; volatile FA_LAS float* al_l = ws + 32; volatile FA_LAS float* co_l = ws + 64;
    const int vb0 = (int)(unsigned)(uintptr_t)V_lds + v_rd_base(lane);
    const DmaOff dof = dma_offsets(wid, lane);
    bf16x8 qr[8];
#pragma unroll
    for (int d0 = 0; d0 < 8; ++d0) qr[d0] = *(const bf16x8*)(a.Q + (size_t)(qlo + r32) * D + d0 * 16 + hi * 8);
    float m_reg = -1e30f, l_reg = 0.f; f32x16 o[4] = {};
#define FA_DMA_PAIR(K_, V_, kbA_, kbB_, off_) do { const char* ka_ = (const char*)(K_) + (size_t)(kbA_) * (D * 2); const char* kb_ = (const char*)(K_) + (size_t)(kbB_) * (D * 2); \
        const char* va_ = (const char*)(V_) + (size_t)(kbA_) * (D * 2); const char* vb_ = (const char*)(V_) + (size_t)(kbB_) * (D * 2); \
        dma_k(ka_, lds + (off_) + OFF_K, wid, dof); dma_k(kb_, lds + (off_) + OFF_K + SHM_K, wid, dof); dma_v(va_, lds + (off_) + OFF_V, wid, dof); dma_v(vb_, lds + (off_) + OFF_V + SHM_V, wid, dof); } while (0)
#define FA_BAND_TILE(kb, off_) do { const bool act = ((kb) <= qlo + 31) && ((kb) + 63 >= qlo - W + 1);     \
        if (act) { f32x16 p0, p1; float mn, alpha; bf16x8 pa0, pa1, pa2, pa3; \
            qkt(p0, p1, K_lds + (off_), r32, hi, qr); VPre vf_; pv_issue(vb0 + (off_), vf_); \
            if ((kb) + 63 > qlo || (kb) <= qlo + 31 - W) mask_tile(p0, p1, qm - (kb), (unsigned)W); \
            partialSM(p0, p1, m_reg, mn, alpha); rescale_o(o, alpha, l_reg, al_l, r32, hi); finishSM(p0, p1, alpha, l_reg, pa0, pa1, pa2, pa3); \
            pv_tile(o, vb0 + (off_), pa0, pa1, pa2, pa3, vf_); } } while (0)
    const int NP = NT >> 1;
    if (!a.prefetched) FA_DMA_PAIR(a.K, a.V, j_lo * 64, (j_lo + NP) * 64, 0);
    FA_DMA_SYNC();
    for (int ip = 0; ip < NP; ++ip) {
        const int so = (ip & 1) * SLOT, kbA = (j_lo + ip) * 64, kbB = (j_lo + ip + NP) * 64;
        if (ip + 1 < NP && !(ip == 0 && a.prefetched)) FA_DMA_PAIR(a.K, a.V, kbA + 64, kbB + 64, so ^ SLOT);
        { FA_BAND_TILE(kbA, so); FA_BAND_TILE(kbB, so + SHM_K); }
        FA_DMA_SYNC();
    }
#undef FA_BAND_TILE
    const int mode = a.mode; float coef, cold = 0.f;
    const size_t urow = (size_t)(qlo + r32);
    if (mode == 1) { coef = 1.0f / (l_reg + __builtin_amdgcn_exp2f(a.sink * 1.4426950408889634f - m_reg * C2)); }
    else if (mode == 2) { coef = 1.0f / l_reg; if (hi == 0) a.lse[urow * a.lse_stride] = m_reg * SCALE + __logf(l_reg); }
    else if (mode == 3) { const float lg = m_reg * SCALE + __logf(l_reg), lo_ = a.lse[urow * a.lse_stride], mx = fmaxf(lg, lo_), e0 = __expf(lo_ - mx), e1 = __expf(lg - mx), inv = 1.0f / (e0 + e1);
        cold = e0 * inv; coef = e1 * inv / l_reg; if (hi == 0) a.lse[urow * a.lse_stride] = mx + __logf(e0 + e1); }
    else coef = 1.0f / l_reg;
    if (hi == 0) { li_l[r32] = coef; co_l[r32] = cold; }
    asm volatile("s_waitcnt lgkmcnt(0)" ::: "memory");
    unsigned oldw[16][2];
    if (mode == 3) {
#pragma unroll
        for (int r = 0; r < 16; ++r) { const bf16* Ow = a.O + (size_t)(qlo + crow(r, hi)) * a.o_stride;
#pragma unroll
            for (int dp = 0; dp < 2; ++dp) oldw[r][dp] = *(const unsigned*)(Ow + (2 * dp + (r32 & 1)) * 32 + (r32 & ~1)); } }
    if (a.has_next) {
        const int nlow = a.nP0 - a.nW + 1, njl = nlow > 0 ? (nlow >> 6) : 0, nNP = (((a.nP0 >> 6) + 4) - njl) >> 1;
        FA_DMA_PAIR(a.nK, a.nV, njl * 64, (njl + nNP) * 64, 0); FA_DMA_PAIR(a.nK, a.nV, njl * 64 + 64, (njl + nNP) * 64 + 64, SLOT); }
#undef FA_DMA_PAIR
#pragma unroll
    for (int r = 0; r < 16; ++r) { const int orow = crow(r, hi); const float cf = li_l[orow], co = co_l[orow];
        bf16* Ow = a.O + (size_t)(qlo + orow) * a.o_stride;
#pragma unroll
        for (int dp = 0; dp < 2; ++dp) {
            const float va = o[2 * dp][r] * cf, vb = o[2 * dp + 1][r] * cf, xa = xl_f<1>(va), xb = xl_f<1>(vb);
            const bool odd = (r32 & 1) != 0; float x0 = odd ? xb : va, x1 = odd ? vb : xa;
            if (mode == 3) { const unsigned old = oldw[r][dp]; x0 += co * __uint_as_float(old << 16); x1 += co * __uint_as_float(old & 0xffff0000u); }
            *(unsigned*)(Ow + (2 * dp + (r32 & 1)) * 32 + (r32 & ~1)) = cvtpk(x0, x1); } }
    asm volatile("s_waitcnt lgkmcnt(0)" ::: "memory");
    if (!a.has_next) __syncthreads();
}

constexpr int NSA_OFF_IMP = SLOT;
constexpr int NSA_OFF_SEL = 2 * SLOT;
constexpr int NSA_OFF_UNI = NSA_OFF_SEL + 2048;
constexpr int NSA_OFF_LIST = NSA_OFF_UNI + 64;
constexpr int NSA_OFF_WUN = NSA_OFF_LIST + 1024;
constexpr int NSA_OFF_AM = NSA_OFF_WUN + 256;
constexpr int NSA_BYTES = ENGINE_BYTES;
static_assert(NSA_OFF_AM + 256 <= OFF_WS, "NSA LDS map");
struct NsaArgs { const bf16* QA; const bf16* KA; const bf16* VA; const bf16* kc; const bf16* vc; const float* gates; const bf16* owin; bf16* ocat; int b, g, t0; bf16* dbg_stash; unsigned* dbg_sel; int dry;   };
__device__ __forceinline__ void nsa_unit(FA_LAS char* lds, const NsaArgs& a) {
    int tid_ = threadIdx.x; asm volatile("" : "+v"(tid_));
    const int tid = tid_, wid = __builtin_amdgcn_readfirstlane(tid >> 6), lane = tid & 63, r32 = lane & 31, hi = lane >> 5;
    const int b = a.b, g = a.g, t0 = a.t0, bg = b * 2 + g;
    const int hq = r32 >> 3, qq = r32 & 7, tq = t0 + 8 * wid + qq, head = g * 4 + hq;
    const int cur = t0 >> 6;
    const FA_LAS char* V_lds = lds + OFF_V; const FA_LAS char* K_lds = lds + OFF_K;
    volatile FA_LAS float* ws = (volatile FA_LAS float*)(lds + OFF_WS + wid * WS_PER_WAVE); volatile FA_LAS float* li_l = ws; volatile FA_LAS float* al_l = ws + 32; volatile FA_LAS float* g1_l = ws + 64; volatile FA_LAS float* g2_l = ws + 96;
    FA_LAS float* impw = (FA_LAS float*)(lds + NSA_OFF_IMP + wid * 8192);
    FA_LAS unsigned* selw = (FA_LAS unsigned*)(lds + NSA_OFF_SEL + wid * 256);
    FA_LAS unsigned* uni = (FA_LAS unsigned*)(lds + NSA_OFF_UNI);
    FA_LAS int* blist = (FA_LAS int*)(lds + NSA_OFF_LIST);
    const int vb0 = (int)(unsigned)(uintptr_t)V_lds + v_rd_base(lane);
    const DmaOff dof = dma_offsets(wid, lane);
    bf16x8 qr[8];
#pragma unroll
    for (int d0 = 0; d0 < 8; ++d0) qr[d0] = *(const bf16x8*)(a.QA + ((size_t)(b * 8 + head) * T + tq) * D + d0 * 16 + hi * 8);
    if (tid < 16) uni[tid] = 0u;
    const bf16* Kc = a.kc + (size_t)bg * 1024 * D; const bf16* Vc = a.vc + (size_t)bg * 1024 * D;
    const int n_ct = ((t0 + 32) >> 10) + 1;
    const int cvis = tq >= 31 ? ((tq - 31) >> 4) : -1;
#define FA_DMA_KT(P, kb0, bf) dma_k((const char*)(P) + (size_t)(kb0) * (D * 2), lds + OFF_K + (bf) * SHM_K, wid, dof)
#define FA_DMA_VT(P, kb0, bf) dma_v((const char*)(P) + (size_t)(kb0) * (D * 2), lds + OFF_V + (bf) * SHM_V, wid, dof)
    float m_reg = -1e30f, l_reg = 0.f;
    FA_DMA_KT(Kc, 0, 0);
    FA_DMA_SYNC();
    for (int j = 0; j < n_ct; ++j) {
        const int buf = j & 1;
        if (j + 1 < n_ct) FA_DMA_KT(Kc, (j + 1) * 64, buf ^ 1);
        { f32x16 p0, p1; float mn, alpha; bf16x8 pa0, pa1, pa2, pa3;
          qkt(p0, p1, K_lds + buf * SHM_K, r32, hi, qr);
          mask_gt(p0, p1, cvis - j * 64, hi);
          partialSM(p0, p1, m_reg, mn, alpha);
          finishSM(p0, p1, alpha, l_reg, pa0, pa1, pa2, pa3); }
        FA_DMA_SYNC();
    }
    const float inv_l = l_reg > 0.f ? 1.0f / l_reg : 0.f, mnL = -m_reg * C2;
    f32x16 o[4] = {};
    float carry = 0.f;
    FA_DMA_KT(Kc, 0, 0); FA_DMA_VT(Vc, 0, 0);
    FA_DMA_SYNC();
    for (int j = 0; j < n_ct; ++j) {
        const int buf = j & 1;
        if (j + 1 < n_ct) { FA_DMA_KT(Kc, (j + 1) * 64, buf ^ 1); FA_DMA_VT(Vc, (j + 1) * 64, buf ^ 1); }
        { f32x16 p0, p1; bf16x8 pa0, pa1, pa2, pa3;
          qkt(p0, p1, K_lds + buf * SHM_K, r32, hi, qr);
          mask_gt(p0, p1, cvis - j * 64, hi);
#pragma unroll
          for (int r = 0; r < 16; ++r) { p0[r] = __builtin_amdgcn_exp2f(fmaf(p0[r], C2, mnL)) * inv_l; p1[r] = __builtin_amdgcn_exp2f(fmaf(p1[r], C2, mnL)) * inv_l; }
          float Av[8], Xv[8];
#pragma unroll
          for (int i = 0; i < 4; ++i) { Av[i] = (p0[4 * i] + p0[4 * i + 1]) + (p0[4 * i + 2] + 0.5f * p0[4 * i + 3]); Xv[i] = 0.5f * p0[4 * i + 3];
                                        Av[4 + i] = (p1[4 * i] + p1[4 * i + 1]) + (p1[4 * i + 2] + 0.5f * p1[4 * i + 3]); Xv[4 + i] = 0.5f * p1[4 * i + 3]; }
#pragma unroll
          for (int i = 0; i < 8; ++i) Xv[i] = __uint_as_float(x32_u(__float_as_uint(Xv[i]), hi));
#pragma unroll
          for (int i = 0; i < 8; ++i) { float v = Av[i] + (hi ? Xv[i] : (i > 0 ? Xv[i - 1] : carry));
              v += xl_f<8>(v); v += xl_f<16>(v);
              if (r32 < 8) impw[r32 * 256 + 16 * j + 2 * i + hi] = v; }
          carry = Xv[7];
          packP(p0, p1, pa0, pa1, pa2, pa3);
          VPre vf_; pv_issue(vb0 + buf * SHM_V, vf_); pv_tile(o, vb0 + buf * SHM_V, pa0, pa1, pa2, pa3, vf_); }
        FA_DMA_SYNC();
    }
    { const float* gp = a.gates + ((size_t)(b * T + tq)) * 24 + head * 3; if (hi == 0) { li_l[r32] = gp[0]; g1_l[r32] = gp[1]; g2_l[r32] = gp[2]; } }
    asm volatile("s_waitcnt lgkmcnt(0)" ::: "memory");
#pragma unroll
    for (int r = 0; r < 16; ++r) { const int rho = crow(r, hi); const float gc = li_l[rho];
        const size_t trow = (size_t)(b * T + t0 + 8 * wid + (rho & 7)); const int hh = g * 4 + (rho >> 3);
        bf16* Ow = a.ocat + trow * 2048 + hh * 128;
#pragma unroll
        for (int dp = 0; dp < 2; ++dp) {
            const float va = o[2 * dp][r] * gc, vb = o[2 * dp + 1][r] * gc, xa = xl_f<1>(va), xb = xl_f<1>(vb);
            const bool odd = (r32 & 1) != 0; const unsigned w = cvtpk(odd ? xb : va, odd ? vb : xa); const int co = (2 * dp + (r32 & 1)) * 32 + (r32 & ~1);
            if (!a.dry) *(unsigned*)(Ow + co) = w;
            if (a.dbg_stash) *(unsigned*)(a.dbg_stash + trow * 1024 + hh * 128 + co) = w; } }
    asm volatile("s_waitcnt lgkmcnt(0)" ::: "memory");
    unsigned selbits = 0u;
    { const int qq8 = lane >> 3, sub = lane & 7;
      if (cur + 1 <= 16) { selbits = (sub == 0) ? ((cur + 1 >= 32) ? 0xffffffffu : ((1u << (cur + 1)) - 1u)) : 0u; }
      else {
        float v[32];
#pragma unroll
        for (int i4 = 0; i4 < 8; ++i4) { const f32x4 x = *(const FA_LAS f32x4*)(impw + qq8 * 256 + sub * 32 + i4 * 4); v[4 * i4] = x[0]; v[4 * i4 + 1] = x[1]; v[4 * i4 + 2] = x[2]; v[4 * i4 + 3] = x[3]; }
#pragma unroll
        for (int i = 0; i < 32; ++i) { const int n = sub * 32 + i; v[i] = (n == 0 || n == cur || n == cur - 1) ? __builtin_inff() : (n <= cur ? v[i] : -__builtin_inff()); }
        for (int round = 0; round < 16; ++round) {
            float bv = -__builtin_inff(); int bn = sub * 32;
#pragma unroll
            for (int i = 0; i < 32; ++i) { const bool take = (((selbits >> i) & 1u) == 0u) && (v[i] > bv); bv = take ? v[i] : bv; bn = take ? sub * 32 + i : bn; }
#define TOPK_STEP(S_) do { const float ov = xl_f<S_>(bv); const int on = (int)xl_u<S_>((unsigned)bn); const bool better = (ov > bv) || (ov == bv && on < bn); bv = better ? ov : bv; bn = better ? on : bn; } while (0)
            TOPK_STEP(1); TOPK_STEP(2); TOPK_STEP(4);
#undef TOPK_STEP
            if ((bn >> 5) == sub) selbits |= 1u << (bn & 31);
        }
      }
      selw[qq8 * 8 + sub] = selbits; if (a.dbg_sel) a.dbg_sel[((size_t)bg * T + t0 + 8 * wid + qq8) * 8 + sub] = selbits; }
    if (a.dry == 1) { __syncthreads(); return; }
    unsigned wh = selbits; wh |= xl_u<8>(wh); wh |= xl_u<16>(wh);
    unsigned wuni = x32_or(wh);
    FA_LAS unsigned* wun = (FA_LAS unsigned*)(lds + NSA_OFF_WUN); FA_LAS unsigned char* am = (FA_LAS unsigned char*)(lds + NSA_OFF_AM);
    if (lane < 8) { __hip_atomic_fetch_or(uni + lane, wuni, __ATOMIC_RELAXED, __HIP_MEMORY_SCOPE_WORKGROUP); wun[wid * 8 + lane] = wuni; }
    __syncthreads();
    { unsigned w8[8]; int tot = 0;
#pragma unroll
      for (int k = 0; k < 8; ++k) w8[k] = uni[k];
#pragma unroll
      for (int k = 0; k < 8; ++k) tot += __popc(w8[k]);
      const bool greedy = cur + 1 >= 150;
      if (tid < 256) { const int n = tid; int pos = 0; unsigned mine = 0, msk = 0;
#pragma unroll
          for (int k = 0; k < 8; ++k) { if (k < (n >> 5)) pos += __popc(w8[k]); if (k == (n >> 5)) mine = w8[k]; }
#pragma unroll
          for (int w = 0; w < 8; ++w) msk |= ((wun[w * 8 + (n >> 5)] >> (n & 31)) & 1u) << w;
          am[n] = (unsigned char)msk;
          if (!greedy && ((mine >> (n & 31)) & 1u)) { pos += __popc(mine & ((1u << (n & 31)) - 1u)); blist[pos] = n; } }
      if (!greedy) { if (tid == 0) { uni[8] = (unsigned)((tot + 1) >> 1); if (tot & 1) blist[tot] = -1; } }
      __syncthreads();
      if (greedy && wid == 0) {
          const unsigned m4 = ((const FA_LAS unsigned*)am)[lane];
          unsigned alive = ((m4 & 0xffu) ? 1u : 0u) | ((m4 & 0xff00u) ? 2u : 0u) | ((m4 & 0xff0000u) ? 4u : 0u) | ((m4 & 0xff000000u) ? 8u : 0u);
          int np = 0;
          for (;;) {
              const unsigned long long bal = __ballot(alive != 0u); if (bal == 0ull) break;
              const int Lx = __builtin_ctzll(bal); const int fj = alive ? __builtin_ctz(alive) : 0;
              const unsigned mx = (unsigned)__builtin_amdgcn_readlane((int)((m4 >> (8 * fj)) & 0xffu), Lx); const int nx = __builtin_amdgcn_readlane(4 * lane + fj, Lx);
              if (lane == Lx) alive &= ~(1u << fj);
              unsigned cand = 0u;
#pragma unroll
              for (int j = 0; j < 4; ++j) if (((alive >> j) & 1u) && ((((m4 >> (8 * j)) & 0xffu) & mx) == 0u)) cand |= 1u << j;
              unsigned long long bal2 = __ballot(cand != 0u); unsigned pick = cand;
              if (bal2 == 0ull) { bal2 = __ballot(alive != 0u); pick = alive; }
              int ny = -1;
              if (bal2 != 0ull) { const int Ly = __builtin_ctzll(bal2); const int cj = pick ? __builtin_ctz(pick) : 0; ny = __builtin_amdgcn_readlane(4 * lane + cj, Ly); if (lane == Ly) alive &= ~(1u << cj); }
              if (lane == 0) { blist[2 * np] = nx; blist[2 * np + 1] = ny; }
              ++np; }
          if (lane == 0) uni[8] = (unsigned)np; } }
    __syncthreads();
    const int npair = __builtin_amdgcn_readfirstlane((int)uni[8]);
    const bf16* Ks = a.KA + (size_t)(b * 6 + 2 + g) * T * D; const bf16* Vs = a.VA + (size_t)(b * 6 + 2 + g) * T * D;
    const int n16 = lane & 15, g4 = lane >> 4;
    bf16x8 qh[2][4];
#pragma unroll
    for (int hf = 0; hf < 2; ++hf)
#pragma unroll
        for (int ks = 0; ks < 4; ++ks) qh[hf][ks] = *(const bf16x8*)(a.QA + ((size_t)(b * 8 + g * 4 + (n16 >> 2)) * T + (t0 + 8 * wid + 4 * hf + (n16 & 3))) * D + ks * 32 + 8 * g4);
    float m_h[2] = {-1e30f, -1e30f}, l_h[2] = {0.f, 0.f};
    f32x4 oh[2][8];
#pragma unroll
    for (int hf = 0; hf < 2; ++hf)
#pragma unroll
        for (int db = 0; db < 8; ++db) oh[hf][db] = f32x4{0.f, 0.f, 0.f, 0.f};
    const int kx = ((g4 * 16) ^ ((n16 & 7) << 4)), kt0 = (int)(unsigned)(uintptr_t)K_lds + n16 * 256, ka0 = kt0 + kx, ka1 = kt0 + (kx ^ 64);
    const int vb16 = (int)(unsigned)(uintptr_t)V_lds + v16_rd_base(lane);
#define FA_DMA_BLK(n_, off_) do { const char* kb_ = (const char*)Ks + (size_t)(n_) * 64 * (D * 2); const char* vb_ = (const char*)Vs + (size_t)(n_) * 64 * (D * 2); \
        dma_k(kb_, lds + (off_) + OFF_K, wid, dof); dma_v(vb_, lds + (off_) + OFF_V, wid, dof); } while (0)
#define FA_SEL_HALF(hf, n_, off_) do { const unsigned hword = (unsigned)__builtin_amdgcn_readlane((int)wh, (hf) * 32 + ((n_) >> 5)); \
        if ((hword >> ((n_) & 31)) & 1u) { f32x4 s[4]; float mn, alpha; bf16x8 pa0, pa1; \
            qk16(s, ka0 + (off_), ka1 + (off_), qh[hf]); VPre vf_; pv16_issue(vb16 + (off_), vf_); \
            const unsigned myw = selw[(4 * (hf) + (n16 & 3)) * 8 + ((n_) >> 5)]; \
            const bool rowsel = ((myw >> ((n_) & 31)) & 1u) != 0u;                          \
            if ((n_) == cur) { const int lim = 8 * wid + 4 * (hf) + (n16 & 3);               \
                _Pragma("unroll") for (int mb = 0; mb < 4; ++mb) _Pragma("unroll") for (int j = 0; j < 4; ++j) if (mb * 16 + 4 * g4 + j > lim) s[mb][j] = -__builtin_inff(); } \
            sm16_max(s, m_h[hf], mn, alpha); rescale16(oh[hf], alpha, l_h[hf], al_l + 16 * (hf), n16, g4); sm16_fin(s, mn, alpha, rowsel, l_h[hf], pa0, pa1); \
            pv16(oh[hf], vb16 + (off_), pa0, pa1, vf_); } } while (0)
#define FA_SEL_TILE(n_, off_) do { FA_SEL_HALF(0, n_, off_); FA_SEL_HALF(1, n_, off_); } while (0)
    int na = __builtin_amdgcn_readfirstlane(blist[0]), nb = __builtin_amdgcn_readfirstlane(blist[1]);
    FA_DMA_BLK(na, 0); FA_DMA_BLK(nb >= 0 ? nb : na, SHM_K);
    FA_DMA_SYNC();
    for (int ip = 0; ip < npair; ++ip) {
        const int so = (ip & 1) * SLOT; int ma = na, mb = nb;
        if (ip + 1 < npair) { ma = __builtin_amdgcn_readfirstlane(blist[2 * ip + 2]); mb = __builtin_amdgcn_readfirstlane(blist[2 * ip + 3]); if (a.dry != 2) { FA_DMA_BLK(ma, so ^ SLOT); FA_DMA_BLK(mb >= 0 ? mb : ma, (so ^ SLOT) + SHM_K); } }
        if (a.dry != 3) { FA_SEL_TILE(na, so);
        if (nb >= 0) FA_SEL_TILE(nb, so + SHM_K); }
        na = ma; nb = mb;
        FA_DMA_SYNC();
    }
#undef FA_DMA_BLK
#undef FA_SEL_TILE
#undef FA_SEL_HALF
#undef FA_DMA_KT
#undef FA_DMA_VT
    if (a.dry) { asm volatile("" :: "v"(oh[0][0]), "v"(oh[0][7]), "v"(oh[1][0]), "v"(oh[1][7]), "v"(l_h[0]), "v"(l_h[1])); __syncthreads(); return; }
    if (g4 == 0) {
#pragma unroll
        for (int hf = 0; hf < 2; ++hf) { const int rho = (n16 >> 2) * 8 + 4 * hf + (n16 & 3); li_l[rho] = l_h[hf] > 0.f ? g1_l[rho] / l_h[hf] : 0.f; } }
    asm volatile("s_waitcnt lgkmcnt(0)" ::: "memory");
    { unsigned oldw[2][4][4], winw[2][4][4];
#pragma unroll
      for (int hf = 0; hf < 2; ++hf)
#pragma unroll
        for (int j = 0; j < 4; ++j) { const int m = 4 * g4 + j; const size_t trow = (size_t)(b * T + t0 + 8 * wid + 4 * hf + (m & 3)); const int hh = g * 4 + (m >> 2);
#pragma unroll
          for (int k = 0; k < 4; ++k) { const int co = (2 * k + (n16 & 1)) * 16 + (n16 & ~1); oldw[hf][k][j] = *(const unsigned*)(a.ocat + trow * 2048 + hh * 128 + co); winw[hf][k][j] = *(const unsigned*)(a.owin + trow * 1024 + hh * 128 + co); } }
#pragma unroll
      for (int hf = 0; hf < 2; ++hf)
#pragma unroll
        for (int j = 0; j < 4; ++j) { const int m = 4 * g4 + j, rho = (m >> 2) * 8 + 4 * hf + (m & 3); const float cs = li_l[rho], gw = g2_l[rho];
          const size_t trow = (size_t)(b * T + t0 + 8 * wid + 4 * hf + (m & 3)); const int hh = g * 4 + (m >> 2);
#pragma unroll
          for (int k = 0; k < 4; ++k) { const float va = oh[hf][2 * k][j] * cs, vb = oh[hf][2 * k + 1][j] * cs, xa = xl_f<1>(va), xb = xl_f<1>(vb);
              const bool odd = (n16 & 1) != 0; const unsigned old = oldw[hf][k][j], wv = winw[hf][k][j];
              const float x0 = (odd ? xb : va) + __uint_as_float(old << 16) + gw * __uint_as_float(wv << 16), x1 = (odd ? vb : xa) + __uint_as_float(old & 0xffff0000u) + gw * __uint_as_float(wv & 0xffff0000u);
              *(unsigned*)(a.ocat + trow * 2048 + hh * 128 + (2 * k + (n16 & 1)) * 16 + (n16 & ~1)) = cvtpk(x0, x1); } } }
    asm volatile("s_waitcnt lgkmcnt(0)" ::: "memory");
    __syncthreads();
}

__device__ __forceinline__ void compress_task(FA_LAS char* lds, const bf16* src  , const float* pe, const bf16* w1t  , const bf16* w2t  , bf16* dst  , int rb) {
    int tid_ = threadIdx.x; asm volatile("" : "+v"(tid_));
    const int tid = tid_, wid = __builtin_amdgcn_readfirstlane(tid >> 6), lane = tid & 63, r32 = lane & 31, hi = lane >> 5;
    const int m0 = rb * 32, bg = m0 >> 10, c0 = m0 & 1023, b = bg >> 1, g = bg & 1;
    const bf16* arow = src + (size_t)(b * 6 + g) * T * D + (size_t)(c0 + r32) * 2048;
    f32x16 acc[4] = {};
    const int kbeg = wid * 512;
#pragma unroll 4
    for (int ks = 0; ks < 32; ++ks) { const int k = kbeg + ks * 16 + hi * 8;
        const bf16x8 raw = *(const bf16x8*)(arow + k); const f32x4 pe0 = *(const f32x4*)(pe + k), pe1 = *(const f32x4*)(pe + k + 4);
        u32x4 w; w.x = cvtpk(bf2f((unsigned short)raw[0]) + pe0[0], bf2f((unsigned short)raw[1]) + pe0[1]); w.y = cvtpk(bf2f((unsigned short)raw[2]) + pe0[2], bf2f((unsigned short)raw[3]) + pe0[3]);
        w.z = cvtpk(bf2f((unsigned short)raw[4]) + pe1[0], bf2f((unsigned short)raw[5]) + pe1[1]); w.w = cvtpk(bf2f((unsigned short)raw[6]) + pe1[2], bf2f((unsigned short)raw[7]) + pe1[3]);
        const bf16x8 af = *reinterpret_cast<bf16x8*>(&w);
#pragma unroll
        for (int nt = 0; nt < 4; ++nt) { const bf16x8 bfr = *(const bf16x8*)(w1t + (size_t)(nt * 32 + r32) * 4096 + k); acc[nt] = __builtin_amdgcn_mfma_f32_32x32x16_bf16(af, bfr, acc[nt], 0, 0, 0); } }
    FA_LAS float* part = (FA_LAS float*)lds;
#pragma unroll
    for (int nt = 0; nt < 4; ++nt)
#pragma unroll
        for (int r = 0; r < 16; ++r) part[wid * 4096 + crow(r, hi) * 128 + nt * 32 + r32] = acc[nt][r];
    __syncthreads();
    FA_LAS bf16* G = (FA_LAS bf16*)(lds + 131072);
    { const int e = tid * 8, m = e >> 7, n = e & 127; f32x4 s0 = {0.f, 0.f, 0.f, 0.f}, s1 = {0.f, 0.f, 0.f, 0.f};
#pragma unroll
      for (int w = 0; w < 8; ++w) { s0 += *(const FA_LAS f32x4*)(part + w * 4096 + e); s1 += *(const FA_LAS f32x4*)(part + w * 4096 + e + 4); }
      float x[8] = {s0[0], s0[1], s0[2], s0[3], s1[0], s1[1], s1[2], s1[3]};
#pragma unroll
      for (int j = 0; j < 8; ++j) { const float u = 0.7978845608028654f * (x[j] + 0.044715f * x[j] * x[j] * x[j]); const float th = 1.0f - 2.0f / (__expf(2.0f * u) + 1.0f); x[j] = 0.5f * x[j] * (1.0f + th); }
      u32x4 w; w.x = cvtpk(x[0], x[1]); w.y = cvtpk(x[2], x[3]); w.z = cvtpk(x[4], x[5]); w.w = cvtpk(x[6], x[7]);
      *(FA_LAS u32x4*)(G + m * 136 + n) = w; }
    __syncthreads();
    if (wid < 4) { f32x16 c = {};
#pragma unroll
        for (int ks = 0; ks < 8; ++ks) { const bf16x8 af = *(const FA_LAS bf16x8*)(G + r32 * 136 + ks * 16 + hi * 8); const bf16x8 bfr = *(const bf16x8*)(w2t + (size_t)(wid * 32 + r32) * 128 + ks * 16 + hi * 8);
            c = __builtin_amdgcn_mfma_f32_32x32x16_bf16(af, bfr, c, 0, 0, 0); }
#pragma unroll
        for (int r = 0; r < 16; ++r) { const float v = c[r], vn = xl_f<1>(v);
            if ((r32 & 1) == 0) *(unsigned*)(dst + (size_t)(m0 + crow(r, hi)) * 128 + wid * 32 + r32) = cvtpk(v, vn); } }
    __syncthreads();
}

__device__ __forceinline__ void gate_task(const unsigned char* x8, const unsigned char* wg8, float* gates, float dq, int row0) {
    typedef int v8i_ __attribute__((ext_vector_type(8)));
    int tid_ = threadIdx.x; asm volatile("" : "+v"(tid_));
    const int tid = tid_, wid = __builtin_amdgcn_readfirstlane(tid >> 6), lane = tid & 63, i16 = lane & 15, g = lane >> 4;
    { const int r0 = row0 + wid * 16;
        f32x4 c0 = {0.f, 0.f, 0.f, 0.f}, c1 = {0.f, 0.f, 0.f, 0.f};
        const unsigned char* ap = x8 + (size_t)(r0 + i16) * 2048 + 32 * g; const unsigned char* bp0 = wg8 + (size_t)i16 * 2048 + 32 * g; const unsigned char* bp1 = wg8 + (size_t)(16 + (i16 & 7)) * 2048 + 32 * g;
#pragma unroll 4
        for (int ks = 0; ks < 16; ++ks) { const v8i_ a = *(const v8i_*)(ap + ks * 128), b0 = *(const v8i_*)(bp0 + ks * 128), b1 = *(const v8i_*)(bp1 + ks * 128);
            c0 = __builtin_amdgcn_mfma_scale_f32_16x16x128_f8f6f4(a, b0, c0, 0, 0, 0, 0, 0, 0); c1 = __builtin_amdgcn_mfma_scale_f32_16x16x128_f8f6f4(a, b1, c1, 0, 0, 0, 0, 0, 0); }
#pragma unroll
        for (int j = 0; j < 4; ++j) { float* gp = gates + (size_t)(r0 + 4 * g + j) * 24; gp[i16] = __builtin_amdgcn_rcpf(1.0f + __expf(-c0[j] * dq)); if (i16 < 8) gp[16 + i16] = __builtin_amdgcn_rcpf(1.0f + __expf(-c1[j] * dq)); } }
}
#undef FA_PK4
#undef KSWZ
#undef SBAR
}

#ifndef DBG
#define DBG 0
#endif
#if DBG
#ifndef DBG_A
#define DBG_A 0
#endif
#ifndef DBG_B
#define DBG_B 1
#endif
namespace dbg {
constexpr int CW_DBG = 131072;
constexpr size_t WS_STASH = WS_END;
constexpr size_t WS_SELD = WS_STASH + 64 * MiB;
constexpr size_t WS_ODD = WS_SELD + 4 * MiB;
typedef unsigned short bf16;
__device__ __forceinline__ float b2f(bf16 b) { return __uint_as_float(((unsigned)b) << 16); }
__device__ __forceinline__ float blk_max(float v, LAS float* red) { const int tid = threadIdx.x; red[tid] = v; __syncthreads();
    for (int s = 256; s > 0; s >>= 1) { if (tid < s) red[tid] = fmaxf(red[tid], red[tid + s]); __syncthreads(); } const float r = red[0]; __syncthreads(); return r; }
__device__ __forceinline__ float blk_sum(float v, LAS float* red) { const int tid = threadIdx.x; red[tid] = v; __syncthreads();
    for (int s = 256; s > 0; s >>= 1) { if (tid < s) red[tid] += red[tid + s]; __syncthreads(); } const float r = red[0]; __syncthreads(); return r; }
__device__ __forceinline__ float dot128(const bf16* a, const bf16* b) { float s = 0.f; for (int d = 0; d < 128; ++d) s += b2f(a[d]) * b2f(b[d]); return s; }
__device__ __forceinline__ void naive_attn(const bf16* q, const bf16* Kseq, const bf16* Vseq, const LAS int* klist, int n, float extra, LAS float* sc, LAS float* red, LAS float* o, LAS float* ml) {
    const int tid = threadIdx.x; float mx = extra;
    for (int i = tid; i < n; i += 512) { const float s = dot128(q, Kseq + (size_t)klist[i] * 128) * 0.08838834764831845f; sc[i] = s; mx = fmaxf(mx, s); }
    const float m = blk_max(mx, red); float ls = 0.f;
    for (int i = tid; i < n; i += 512) { const float p = __expf(sc[i] - m); sc[i] = p; ls += p; }
    float l = blk_sum(ls, red); if (extra > -1e30f) l += __expf(extra - m);
    if (tid < 128) { float a = 0.f; for (int i = 0; i < n; ++i) a += sc[i] * b2f(Vseq[(size_t)klist[i] * 128 + tid]); o[tid] = l > 0.f ? a / l : 0.f; }
    if (tid == 0) { ml[0] = m; ml[1] = l; }
    __syncthreads();
}
__device__ __forceinline__ void cmp128(const LAS float* nv, const bf16* fast, unsigned* errw, int k, LAS float* red) {
    const int tid = threadIdx.x; float d = 0.f, a = 0.f; if (tid < 128) { d = fabsf(nv[tid] - b2f(fast[tid])); a = fabsf(nv[tid]); }
    const float dm = blk_max(d, red), am = blk_max(a, red);
    if (tid == 0) atomicMax(errw + k, __float_as_uint(dm / fmaxf(am, 1e-20f)));
}
__constant__ int dbg_tt[16] = {0, 7, 30, 31, 63, 64, 200, 1000, 1023, 1024, 1031, 2500, 5000, 9999, 12345, 16383};
__device__ __forceinline__ int sample_t(int s) { return dbg_tt[s]; }
constexpr int NS = 32;

__device__ __forceinline__ void check_even(unsigned char* ws, const float* sinks, const float* pe_k, const float* ck_w1, const float* ck_w2, LAS unsigned char* lds) {
    unsigned* errw = (unsigned*)(ws + WS_CTL) + CW_DBG; const int tid = threadIdx.x;
    LAS float* sc = (LAS float*)lds; LAS float* red = sc + 1024; LAS float* o = red + 512; LAS float* ml = o + 128; LAS int* klist = (LAS int*)(ml + 8);
    LAS float* pc = (LAS float*)(klist + 1024);
    LAS float* imp = pc + 4096; LAS float* ocmp = imp + 256; LAS float* oslc = ocmp + 4 * 128; LAS float* oslc2 = oslc + 4 * 128; LAS float* owin = oslc2 + 4 * 128; LAS int* seln = (LAS int*)(owin + 4 * 128); LAS int* self = seln + 256;
    LAS float* mix = (LAS float*)(self + 256);
    const bf16* QA = (const bf16*)(ws + WS_R + R_QA); const bf16* KA = (const bf16*)(ws + WS_R + R_KA); const bf16* VA = (const bf16*)(ws + WS_R + R_VA);
    const bf16* QB = (const bf16*)(ws + WS_R + R_QB); const bf16* KB = (const bf16*)(ws + WS_R + R_KB); const bf16* VB = (const bf16*)(ws + WS_R + R_VB);
    const bf16* kc = (const bf16*)(ws + WS_KC); const bf16* vc = (const bf16*)(ws + WS_VC); const float* gates = (const float*)(ws + WS_GATES);
    const bf16* OC = (const bf16*)(ws + WS_O); const bf16* OWIN = (const bf16*)(ws + WS_OWIN); const bf16* STASH = (const bf16*)(ws + WS_STASH); const unsigned* SELD = (const unsigned*)(ws + WS_SELD);
    for (int s = blockIdx.x; s < NS; s += gridDim.x) { const int b = s >> 4, t = sample_t(s & 15); const size_t row = (size_t)b * T + t;
        for (int h = 0; h < 8; ++h) { const int n = t + 1 < 128 ? t + 1 : 128; for (int i = tid; i < n; i += 512) klist[i] = t - n + 1 + i; __syncthreads();
            naive_attn(QB + ((size_t)(b * 8 + h) * T + t) * 128, KB + (size_t)(b * 2 + (h >> 2)) * T * 128, VB + (size_t)(b * 2 + (h >> 2)) * T * 128, klist, n, sinks[h], sc, red, o, ml);
            cmp128(o, OC + row * 2048 + (8 + h) * 128, errw, 1, red); }
        for (int g = 0; g < 2; ++g) { const int bg = b * 2 + g; const int cvis = t >= 31 ? ((t - 31) >> 4) : -1, ncv = cvis + 1, cur = t >> 6;
            for (int hh = 0; hh < 4; ++hh) { const int h = g * 4 + hh; const bf16* q = QA + ((size_t)(b * 8 + h) * T + t) * 128;
                { const int n = t + 1 < 512 ? t + 1 : 512; for (int i = tid; i < n; i += 512) klist[i] = t - n + 1 + i; __syncthreads();
                  naive_attn(q, KA + (size_t)(b * 6 + 4 + g) * T * 128, VA + (size_t)(b * 6 + 4 + g) * T * 128, klist, n, -__builtin_inff(), sc, red, o, ml);
                  cmp128(o, OWIN + row * 1024 + h * 128, errw, 0, red); if (tid < 128) owin[hh * 128 + tid] = o[tid]; __syncthreads(); }
                { for (int i = tid; i < ncv; i += 512) klist[i] = i; __syncthreads();
                  naive_attn(q, kc + (size_t)bg * 1024 * 128, vc + (size_t)bg * 1024 * 128, klist, ncv, -__builtin_inff(), sc, red, o, ml);
                  for (int i = tid; i < 1024; i += 512) pc[hh * 1024 + i] = (i < ncv && ml[1] > 0.f) ? sc[i] / ml[1] : 0.f; if (tid < 128) ocmp[hh * 128 + tid] = o[tid]; __syncthreads(); } }
            if (tid < 256) { const int n = tid; float v = 0.f; for (int hh = 0; hh < 4; ++hh) { const LAS float* p = pc + hh * 1024; v += p[4 * n] + p[4 * n + 1] + p[4 * n + 2] + 0.5f * p[4 * n + 3] + (n > 0 ? 0.5f * p[4 * n - 1] : 0.f); }
                imp[n] = (n == 0 || n == cur || n == cur - 1) ? __builtin_inff() : (n <= cur ? v : -__builtin_inff()); }
            __syncthreads();
            if (tid < 256) { const int n = tid; int rank = 0; const float v = imp[n]; for (int m2 = 0; m2 < 256; ++m2) { const float w = imp[m2]; rank += (w > v || (w == v && m2 < n)) ? 1 : 0; }
                seln[n] = (rank < 16 && n <= cur) ? 1 : 0; const unsigned wd = SELD[((size_t)bg * T + t) * 8 + (n >> 5)]; self[n] = ((wd >> (n & 31)) & 1u) ? 1 : 0; }
            __syncthreads();
            { float mism = 0.f; if (tid < 256) mism = (seln[tid] != self[tid]) ? 1.f : 0.f; const float tot = blk_sum(mism, red); if (tid == 0) atomicMax(errw + 2, __float_as_uint(tot)); }
            for (int pass = 0; pass < 2; ++pass) { const LAS int* sel = pass ? self : seln; LAS float* od = pass ? oslc2 : oslc;
                if (tid == 0) { int n = 0; for (int nb = 0; nb < 256; ++nb) if (sel[nb]) for (int k = 0; k < 64; ++k) if (nb * 64 + k <= t) klist[n++] = nb * 64 + k; ((LAS int*)ml)[4] = n; }
                __syncthreads(); const int n = ((LAS int*)ml)[4];
                for (int hh = 0; hh < 4; ++hh) { const int h = g * 4 + hh; naive_attn(QA + ((size_t)(b * 8 + h) * T + t) * 128, KA + (size_t)(b * 6 + 2 + g) * T * 128, VA + (size_t)(b * 6 + 2 + g) * T * 128, klist, n, -__builtin_inff(), sc, red, o, ml);
                    if (tid < 128) od[hh * 128 + tid] = o[tid]; __syncthreads(); } }
            for (int hh = 0; hh < 4; ++hh) { const int h = g * 4 + hh; const float* gp = gates + row * 24 + h * 3;
                if (tid < 128) mix[tid] = gp[0] * ocmp[hh * 128 + tid]; __syncthreads(); cmp128(mix, STASH + row * 1024 + h * 128, errw, 3, red);
                if (tid < 128) mix[tid] = gp[0] * ocmp[hh * 128 + tid] + gp[1] * oslc[hh * 128 + tid] + gp[2] * owin[hh * 128 + tid]; __syncthreads(); cmp128(mix, OC + row * 2048 + h * 128, errw, 4, red);
                if (tid < 128) mix[tid] = gp[0] * ocmp[hh * 128 + tid] + gp[1] * oslc2[hh * 128 + tid] + gp[2] * owin[hh * 128 + tid]; __syncthreads(); cmp128(mix, OC + row * 2048 + h * 128, errw, 5, red); }
        }
        if (t >= 31) { const int c = (t - 31) >> 4; for (int g = 0; g < 2; ++g) { const int bg = b * 2 + g; const bf16* src = KA + (size_t)(b * 6 + g) * T * 128 + (size_t)c * 2048;
            if (tid < 128) { float a = 0.f; for (int k = 0; k < 4096; ++k) a += (b2f(src[k]) + pe_k[k]) * ck_w1[(size_t)k * 128 + tid]; const float u = 0.7978845608028654f * (a + 0.044715f * a * a * a); sc[tid] = 0.5f * a * (1.f + tanhf(u)); }
            __syncthreads();
            if (tid < 128) { float a = 0.f; for (int k = 0; k < 128; ++k) a += sc[k] * ck_w2[k * 128 + tid]; o[tid] = a; } __syncthreads();
            cmp128(o, kc + ((size_t)bg * 1024 + c) * 128, errw, 6, red); } }
    }
}
__device__ __forceinline__ void check_odd(unsigned char* ws, int grp, LAS unsigned char* lds) {
    unsigned* errw = (unsigned*)(ws + WS_CTL) + CW_DBG; const int tid = threadIdx.x;
    LAS float* sc = (LAS float*)lds; LAS float* red = sc + 1024; LAS float* o = red + 512; LAS float* ml = o + 128; LAS int* klist = (LAS int*)(ml + 8); LAS float* mix = (LAS float*)(klist + 1024);
    const bf16* Qg = (const bf16*)(ws + WS_R + R_QG); const bf16* Kg = (const bf16*)(ws + WS_R + R_KG); const bf16* Vg = (const bf16*)(ws + WS_R + R_VG); const bf16* OC = (const bf16*)(ws + WS_O);
    float* OD = (float*)(ws + WS_ODD); const int dsh = 2 * grp, dil = 1 << dsh, Lq = T >> dsh;
    for (int s = blockIdx.x; s < NS; s += gridDim.x) { const int b = s >> 4, t = sample_t(s & 15), c = t & (dil - 1), u = t >> dsh; const size_t row = (size_t)b * T + t;
        for (int h = 0; h < 16; ++h) { const size_t so = ((size_t)(b * 16 + h) * T + (size_t)c * Lq) * 128; const int n = u + 1 < 129 ? u + 1 : 129;
            for (int i = tid; i < n; i += 512) klist[i] = u - n + 1 + i; __syncthreads();
            naive_attn(Qg + so + (size_t)u * 128, Kg + so, Vg + so, klist, n, -__builtin_inff(), sc, red, o, ml);
            float* od = OD + (((size_t)grp * NS + s) * 16 + h) * 132; if (tid < 128) od[tid] = o[tid]; if (tid == 0) od[128] = ml[0] + __logf(ml[1]);
            if (grp == 0) cmp128(o, OC + row * 2048 + h * 128, errw, 7, red);
            if (grp == 2) { __threadfence(); __syncthreads(); const float* o0 = OD + (((size_t)0 * NS + s) * 16 + h) * 132; const float* o1 = OD + (((size_t)1 * NS + s) * 16 + h) * 132;
                const float l0 = o0[128], l1 = o1[128], l2 = ml[0] + __logf(ml[1]), mx = fmaxf(l0, fmaxf(l1, l2)), e0 = __expf(l0 - mx), e1 = __expf(l1 - mx), e2 = __expf(l2 - mx), inv = 1.f / (e0 + e1 + e2);
                if (tid < 128) mix[tid] = (e0 * o0[tid] + e1 * o1[tid] + e2 * o[tid]) * inv; __syncthreads(); cmp128(mix, OC + row * 2048 + h * 128, errw, 8, red); }
            __syncthreads(); }
    }
}
}
#endif

constexpr int NWAVES = 8;
#ifndef MK_PER_PHASE
#define MK_PER_PHASE 0
#endif
constexpr float F8_SX = 32.f, F8_SW = 1024.f;
constexpr int CW_BAR = 4096;
constexpr int LDS_BYTES = 147456, MISC_OFF = LDS_BYTES - 256;
static_assert(fa::ENGINE_BYTES <= MISC_OFF && 131072 + 32 * 136 * 2 <= MISC_OFF && pg8::STAGE_BYTES <= MISC_OFF, "LDS map");

struct Params {
    const float* x; const int* pos; const float* e_w_in; const float* e_w_o; const float* pe_k; const float* pe_v; const float* ck_w1; const float* ck_w2; const float* cv_w1; const float* cv_w2;
    const float* sinks; const float* o_w_in; const float* o_w_o; const float* ln1_g; const float* ln1_b; const float* w1; const float* w2; const float* ln2_g; const float* ln2_b;
    float* out; unsigned char* ws; int ph_lo, ph_hi, li, pad; float inv_freq[64];
};

__device__ __forceinline__ float wave_sum(float v) {
    v += xl_f<1>(v); v += xl_f<2>(v); v += xl_f<4>(v); v += xl_f<8>(v); v += xl_f<16>(v); return x32_sum(v);
}
__device__ __forceinline__ int cphys(int d) { return 32 * ((d >> 4) & 3) + 16 * (d >> 6) + (d & 15); }
__device__ __forceinline__ int dst_row(int kind, int n) {
    if (kind == 0) return n;
    if (kind == 1) return (n & ~127) + cphys(n & 127);
    if (n < 2560) return (n & ~127) + cphys(n & 127);
    if (n < 2584) return 32 * 128 + (n - 2560);
    const int s = n - 2584; return (20 + (s >> 7)) * 128 + cphys(s & 127);
}
__device__ __forceinline__ unsigned pk4_fp8(float a, float b, float c, float d) { unsigned w = 0; w = __builtin_amdgcn_cvt_pk_fp8_f32(a, b, w, false); w = __builtin_amdgcn_cvt_pk_fp8_f32(c, d, w, true); return w; }
struct TrRegs { f32x4 t[8]; };
__device__ __forceinline__ void tr_load(TrRegs& r, const float* W, int K, int N, int item, int lane) {
    const int nblk = (N + 31) / 32, kb = item / nblk, nb = item % nblk, k0 = 64 * kb, n0 = 32 * nb, c4 = (lane & 7) * 4, kr = lane >> 3; const bool okc = (n0 + c4) < N;
#pragma unroll
    for (int i = 0; i < 8; ++i) r.t[i] = okc ? *(const f32x4*)(W + (size_t)(k0 + 8 * i + kr) * N + n0 + c4) : (f32x4){0.f, 0.f, 0.f, 0.f};
}
template <bool F8> __device__ __forceinline__ void tr_store(const TrRegs& r, int K, int N, void* WTv, int kind, float scale, LAS float* scr, int item, int lane) {
    const int nblk = (N + 31) / 32, kb = item / nblk, nb = item % nblk, k0 = 64 * kb, n0 = 32 * nb, c4 = (lane & 7) * 4, kr = lane >> 3;
#pragma unroll
    for (int i = 0; i < 8; ++i) { LAS float* d = scr + (8 * i + kr) * 33 + c4; d[0] = r.t[i].x * scale; d[1] = r.t[i].y * scale; d[2] = r.t[i].z * scale; d[3] = r.t[i].w * scale; }
    asm volatile("s_waitcnt lgkmcnt(0)" ::: "memory");
    const int c = lane & 7;
#pragma unroll
    for (int j = 0; j < 4; ++j) { const int n = (lane >> 3) + 8 * j; const LAS float* s = scr + (8 * c) * 33 + n;
        if (F8) { const unsigned long long o = (unsigned long long)pk4_fp8(s[0 * 33], s[1 * 33], s[2 * 33], s[3 * 33]) | ((unsigned long long)pk4_fp8(s[4 * 33], s[5 * 33], s[6 * 33], s[7 * 33]) << 32);
            if (n0 + n < N) *(unsigned long long*)((unsigned char*)WTv + (size_t)dst_row(kind, n0 + n) * K + k0 + 8 * c) = o; }
        else { v4u o; o.x = pk2(s[0 * 33], s[1 * 33]); o.y = pk2(s[2 * 33], s[3 * 33]); o.z = pk2(s[4 * 33], s[5 * 33]); o.w = pk2(s[6 * 33], s[7 * 33]);
            if (n0 + n < N) *(v4u*)((unsigned short*)WTv + (size_t)dst_row(kind, n0 + n) * K + k0 + 8 * c) = o; } }
    asm volatile("s_waitcnt lgkmcnt(0)" ::: "memory");
}
template <bool F8> __device__ __forceinline__ void convert_matrix_t(const float* W, int K, int N, void* WT, int kind, float scale, LAS float* scr, int gw, int ngw, int lane) {
    const int nitems = (K / 64) * ((N + 31) / 32); if (gw >= nitems) return;
    TrRegs cur, nxt; tr_load(cur, W, K, N, gw, lane);
    for (int it = gw; it < nitems; it += ngw) { const bool more = it + ngw < nitems;
        if (more) tr_load(nxt, W, K, N, it + ngw, lane);
        tr_store<F8>(cur, K, N, WT, kind, scale, scr, it, lane);
        if (more) cur = nxt; }
}
__device__ __forceinline__ void convert_matrix(const float* W, int K, int N, unsigned short* WT, int kind, LAS float* scr, int gw, int ngw, int lane) { convert_matrix_t<false>(W, K, N, WT, kind, 1.0f, scr, gw, ngw, lane); }
__device__ __forceinline__ void convert_matrix_f8(const float* W, int K, int N, unsigned char* WT, int kind, float scale, LAS float* scr, int gw, int ngw, int lane) { convert_matrix_t<true>(W, K, N, WT, kind, scale, scr, gw, ngw, lane); }
template <int R> __device__ __forceinline__ void ln_rows(float* z, unsigned short* xb, unsigned char* xb8  , float* stats, int m0, int rstride, const float* gam, const float* bet, int lane, bool full) {
    f32x4 v[R][8];
#pragma unroll
    for (int r = 0; r < R; ++r) { const f32x4* xr = (const f32x4*)(z + (size_t)(m0 + r * rstride) * DM) + lane;
#pragma unroll
        for (int j = 0; j < 8; ++j) v[r][j] = xr[64 * j]; }
#pragma unroll
    for (int r = 0; r < R; ++r) { const int m = m0 + r * rstride; float s = 0.f;
#pragma unroll
        for (int j = 0; j < 8; ++j) s += (v[r][j].x + v[r][j].y) + (v[r][j].z + v[r][j].w);
        const float mean = wave_sum(s) * (1.f / DM); float s2 = 0.f;
#pragma unroll
        for (int j = 0; j < 8; ++j) { v[r][j] = v[r][j] - mean; s2 += (v[r][j].x * v[r][j].x + v[r][j].y * v[r][j].y) + (v[r][j].z * v[r][j].z + v[r][j].w * v[r][j].w); }
        const float rstd = 1.f / sqrtf(wave_sum(s2) * (1.f / DM) + LN_EPS);
        if (lane == 0) { stats[2 * m] = mean; stats[2 * m + 1] = rstd; }
        f32x4* xw = (f32x4*)(z + (size_t)m * DM) + lane; unsigned long long* o8 = (unsigned long long*)(xb + (size_t)m * DM) + lane; unsigned* o4 = (unsigned*)(xb8 + (size_t)m * DM) + lane;
#pragma unroll
        for (int j = 0; j < 8; ++j) { const f32x4 gm = ((const f32x4*)gam)[lane + 64 * j], bt = ((const f32x4*)bet)[lane + 64 * j]; const f32x4 y = v[r][j] * rstd * gm + bt;
            if (full) xw[64 * j] = y;
            if (xb8) o4[64 * j] = pk4_fp8(y.x * F8_SX, y.y * F8_SX, y.z * F8_SX, y.w * F8_SX); else o8[64 * j] = (unsigned long long)pk2(y.x, y.y) | ((unsigned long long)pk2(y.z, y.w) << 32); } }
}
template <int R> __device__ __forceinline__ void cvt_rows(const float* x, unsigned char* x8, int m0, int rstride, int lane) {
    f32x4 v[R][8];
#pragma unroll
    for (int r = 0; r < R; ++r) { const f32x4* xr = (const f32x4*)(x + (size_t)(m0 + r * rstride) * DM) + lane;
#pragma unroll
        for (int j = 0; j < 8; ++j) v[r][j] = xr[64 * j]; }
#pragma unroll
    for (int r = 0; r < R; ++r) { unsigned* o4 = (unsigned*)(x8 + (size_t)(m0 + r * rstride) * DM) + lane;
#pragma unroll
        for (int j = 0; j < 8; ++j) o4[64 * j] = pk4_fp8(v[r][j].x * F8_SX, v[r][j].y * F8_SX, v[r][j].z * F8_SX, v[r][j].w * F8_SX); }
}
__device__ __forceinline__ void rope_entry(float ang, float& c, float& s) {
    const double a = (double)ang; const double q = rint(a * 0.63661977236758134308); const double y = fma(-q, 1.57079632679489655800, a) - q * 6.12323399573676603587e-17;
    const double y2 = y * y;
    const double sn = y * (1.0 + y2 * (-1.0 / 6 + y2 * (1.0 / 120 + y2 * (-1.0 / 5040 + y2 * (1.0 / 362880 + y2 * (-1.0 / 39916800))))));
    const double cs = 1.0 + y2 * (-0.5 + y2 * (1.0 / 24 + y2 * (-1.0 / 720 + y2 * (1.0 / 40320 + y2 * (-1.0 / 3628800 + y2 * (1.0 / 479001600))))));
    const int qi = ((int)q) & 3;
    const double cc = (qi == 0) ? cs : (qi == 1) ? -sn : (qi == 2) ? -cs : sn;
    const double ss = (qi == 0) ? sn : (qi == 1) ? cs : (qi == 2) ? -sn : -cs;
    c = (float)cc; s = (float)ss;
}

template <class Tp> __device__ __forceinline__ Tp* as_global(Tp* p) { return (Tp*)(GAS Tp*)p; }
#define CAS __attribute__((address_space(4)))
typedef const CAS Params* ParamsPtr;
__device__ __forceinline__ ParamsPtr params_ptr(ParamsPtr kp) { asm volatile("" : "+s"(kp)); return kp; }
__device__ __forceinline__ int opaque_bx() { int v = blockIdx.x; asm volatile("" : "+s"(v)); return v; }
__device__ __forceinline__ int opaque_i(int v) { asm volatile("" : "+s"(v)); return v; }
__device__ __forceinline__ int opaque_g() { int v = gridDim.x; asm volatile("" : "+s"(v)); return v; }
#if DBG
#define DBG_STASH_PTR(ws) ((unsigned short*)((ws) + dbg::WS_STASH))
#define DBG_SEL_PTR(ws) ((unsigned*)((ws) + dbg::WS_SELD))
#else
#define DBG_STASH_PTR(ws) nullptr
#define DBG_SEL_PTR(ws) nullptr
#endif
#ifndef WGM_INPROJ
#define WGM_INPROJ 4
#endif
#ifndef WGM_RESID
#define WGM_RESID 4
#endif
#ifndef WGM_UP
#define WGM_UP 4
#endif
#ifndef REP_MASK
#define REP_MASK 0
#endif
#ifndef DBG_MASK
#define DBG_MASK 0
#endif
#ifndef DBG_LAYER_EVEN
#define DBG_LAYER_EVEN 0
#endif
#ifndef DBG_LAYER_ODD
#define DBG_LAYER_ODD 1
#endif
#ifndef ONLY_PHASE
#define ONLY_PHASE -1
#endif
#define PHASE_ENABLED(k) (ONLY_PHASE < 0 || ONLY_PHASE == (k))

__device__ __forceinline__ void convert_layer(ParamsPtr pp, int L, LAS unsigned char* lds, int gw, int ngw, int lane, int wave) {
    unsigned char* ws = as_global(pp->ws); const int i_ = L >> 1; LAS float* scr = (LAS float*)(lds + wave * 16384);
    unsigned short* Win_t = (unsigned short*)(ws + WS_W + W_WIN); unsigned short* Wo_t = (unsigned short*)(ws + WS_W + W_WO);
    unsigned short* W1_t = (unsigned short*)(ws + WS_W + W_W1); unsigned short* W2_t = (unsigned short*)(ws + WS_W + W_W2);
    if ((L & 1) == 0) { unsigned short* cw = (unsigned short*)(ws + WS_CW);
        convert_matrix_f8(as_global(pp->e_w_in) + (size_t)i_ * DM * EVEN_IN, DM, EVEN_IN, (unsigned char*)Win_t, 2, F8_SW, scr, gw, ngw, lane);
        convert_matrix(as_global(pp->e_w_o) + (size_t)i_ * DM * DM, DM, DM, Wo_t, 0, scr, gw, ngw, lane);
        convert_matrix(as_global(pp->ck_w1) + (size_t)i_ * 4096 * 128, 4096, 128, cw, 0, scr, gw, ngw, lane); convert_matrix(as_global(pp->cv_w1) + (size_t)i_ * 4096 * 128, 4096, 128, cw + 128 * 4096, 0, scr, gw, ngw, lane);
        convert_matrix(as_global(pp->ck_w2) + (size_t)i_ * 128 * 128, 128, 128, cw + 2 * 128 * 4096, 0, scr, gw, ngw, lane); convert_matrix(as_global(pp->cv_w2) + (size_t)i_ * 128 * 128, 128, 128, cw + 2 * 128 * 4096 + 128 * 128, 0, scr, gw, ngw, lane);
    } else {
        convert_matrix_f8(as_global(pp->o_w_in) + (size_t)i_ * DM * ODD_IN, DM, ODD_IN, (unsigned char*)Win_t, 1, F8_SW, scr, gw, ngw, lane);
        convert_matrix(as_global(pp->o_w_o) + (size_t)i_ * DM * DM, DM, DM, Wo_t, 0, scr, gw, ngw, lane); }
    convert_matrix(as_global(pp->w1) + (size_t)L * DM * DFF, DM, DFF, W1_t, 0, scr, gw, ngw, lane);
    convert_matrix(as_global(pp->w2) + (size_t)L * DFF * DM, DFF, DM, W2_t, 0, scr, gw, ngw, lane);
}
__device__ __forceinline__ void phase_prologue(ParamsPtr pp, LAS unsigned char* lds) {
    int tid_ = threadIdx.x; asm volatile("" : "+v"(tid_));
    const int tid = tid_, lane = tid & 63, wave = __builtin_amdgcn_readfirstlane(tid >> 6), G = opaque_g(), bx = opaque_bx(), gw = bx * NWAVES + wave, ngw = G * NWAVES;
    unsigned char* ws = as_global(pp->ws); unsigned* ropet = (unsigned*)(ws + WS_ROPEC); const int* pos = as_global(pp->pos); const float* x = as_global(pp->x);
    for (size_t e = (size_t)bx * 512 + tid; e < (size_t)M * 64; e += (size_t)G * 512) { const int row = (int)(e >> 6), i = (int)(e & 63);
        const float ang = (float)pos[row] * pp->inv_freq[i]; float c, s; rope_entry(ang, c, s);
        ropet[e] = (unsigned)__builtin_bit_cast(unsigned short, (_Float16)c) | ((unsigned)__builtin_bit_cast(unsigned short, (_Float16)s) << 16); }
    if (ngw * 16 == M) { for (int m = gw; m < M; m += 4 * ngw) cvt_rows<4>(x, ws + WS_XB8, m, ngw, lane); }
    else { for (int m = gw; m < M; m += ngw) cvt_rows<1>(x, ws + WS_XB8, m, ngw, lane); }
    convert_layer(pp, 0, lds, gw, ngw, lane, wave);
}
__device__ __forceinline__ void phase_e1(ParamsPtr pp, LAS unsigned char* lds) {
    unsigned char* ws = as_global(pp->ws);
    pg8::Gemm g{(const unsigned short*)(ws + WS_XB8), (const unsigned short*)(ws + WS_W + W_WIN), M, 4096, DM / 2}; pg8::StaticOrder S; S.init(M, 4096, opaque_g(), opaque_bx(), WGM_INPROJ);
    pg8::EpiEven E{ws, 1.0f / (F8_SX * F8_SW)};
    pg8::gemm_phase<pg8::EpiEven, pg8::StaticOrder, true, true, true>(lds, g, S, E);
}
__device__ __forceinline__ fa::BandArgs decode_e2(unsigned char* ws0, const float* sinks, int li, int u0, int G) {
    const int u = (G == 256) ? (u0 & ~255) + ((u0 & 7) << 5) + ((u0 & 255) >> 3) : u0;
    const int kind = u >> 10, r = u & 1023, C = r >> 5, p = r & 31, b = C >> 4, blk = (C & 7) * 8 + (p >> 2), h = ((C >> 3) & 1) * 4 + (p & 3); fa::BandArgs a;
    GAS unsigned char* wsg = (GAS unsigned char*)ws0; asm volatile("" : "+s"(wsg)); unsigned char* ws = (unsigned char*)wsg; unsigned char* R = ws + WS_R;
    if (kind == 0) {
        a.Q = (const unsigned short*)(R + R_QA) + (size_t)(b * 8 + h) * T * 128; a.K = (const unsigned short*)(R + R_KA) + (size_t)(b * 6 + 4 + (h >> 2)) * T * 128; a.V = (const unsigned short*)(R + R_VA) + (size_t)(b * 6 + 4 + (h >> 2)) * T * 128;
        a.O = (unsigned short*)(ws + WS_OWIN) + (size_t)b * T * 1024 + h * 128; a.o_stride = 1024; a.lse = nullptr; a.lse_stride = 0; a.P0 = blk * 256; a.W = 512; a.mode = 0; a.sink = 0.f;
    } else {
        a.Q = (const unsigned short*)(R + R_QB) + (size_t)(b * 8 + h) * T * 128; a.K = (const unsigned short*)(R + R_KB) + (size_t)(b * 2 + (h >> 2)) * T * 128; a.V = (const unsigned short*)(R + R_VB) + (size_t)(b * 2 + (h >> 2)) * T * 128;
        a.O = (unsigned short*)(ws + WS_O) + (size_t)b * T * 2048 + (8 + h) * 128; a.o_stride = 2048; a.lse = nullptr; a.lse_stride = 0; a.P0 = blk * 256; a.W = 128; a.mode = 1; a.sink = sinks[li * 8 + h];
    }
    a.nK = a.K; a.nV = a.V; a.nP0 = a.P0; a.nW = a.W; a.has_next = 0; a.prefetched = 0; return a;
}
__device__ __forceinline__ void phase_e2(ParamsPtr pp, int li, LAS unsigned char* lds) {
    unsigned char* const ws0 = as_global(pp->ws); const int G = opaque_g(), bx = opaque_bx();
    for (int gt = bx; gt < 256; gt += G) { GAS unsigned char* wsg = (GAS unsigned char*)ws0; asm volatile("" : "+s"(wsg)); unsigned char* ws = (unsigned char*)wsg;
        fa::gate_task(ws + WS_XB8, ws + WS_W + W_WIN + (size_t)4096 * DM, (float*)(ws + WS_GATES), 1.0f / (F8_SX * F8_SW), gt * 128); }
    for (int ct = bx; ct < 256; ct += G) { const int z = ct >> 7;
        GAS unsigned char* wsg = (GAS unsigned char*)ws0; asm volatile("" : "+s"(wsg)); unsigned char* ws = (unsigned char*)wsg; unsigned char* R = ws + WS_R; unsigned short* cw = (unsigned short*)(ws + WS_CW);
        fa::compress_task((FA_LAS char*)lds, (const unsigned short*)(R + (z ? R_VA : R_KA)), (z ? as_global(pp->pe_v) : as_global(pp->pe_k)) + (size_t)li * 4096, cw + (z ? 128 * 4096 : 0), cw + 2 * 128 * 4096 + (z ? 128 * 128 : 0),
                          (unsigned short*)(ws + (z ? WS_VC : WS_KC)), ct & 127); }
    int pre = 0;
    for (int u0 = bx; u0 < 2048; u0 += G) { fa::BandArgs a = decode_e2(ws0, as_global(pp->sinks), li, u0, G); const bool hn = u0 + G < 2048;
        if (hn) { const fa::BandArgs n = decode_e2(ws0, as_global(pp->sinks), li, u0 + G, G); a.nK = n.K; a.nV = n.V; a.nP0 = n.P0; a.nW = n.W; }
        a.has_next = hn ? 1 : 0; a.prefetched = pre; pre = a.has_next;
        fa::banded_unit((FA_LAS char*)lds, a); }
}
constexpr int CW_NSAQ = 1024;
__device__ __forceinline__ void nsa_run(unsigned char* ws0, LAS unsigned char* lds, int bg, int tile, int dry) {
    GAS unsigned char* wsg = (GAS unsigned char*)ws0; asm volatile("" : "+s"(wsg)); unsigned char* ws = (unsigned char*)wsg; unsigned char* R = ws + WS_R;
    fa::NsaArgs a{(const unsigned short*)(R + R_QA), (const unsigned short*)(R + R_KA), (const unsigned short*)(R + R_VA), (const unsigned short*)(ws + WS_KC), (const unsigned short*)(ws + WS_VC),
                  (const float*)(ws + WS_GATES), (const unsigned short*)(ws + WS_OWIN), (unsigned short*)(ws + WS_O), bg >> 1, bg & 1, tile * 64, DBG_STASH_PTR(ws), DBG_SEL_PTR(ws), dry};
    fa::nsa_unit((FA_LAS char*)lds, a);
}
__device__ __forceinline__ void phase_e3(ParamsPtr pp, int li, LAS unsigned char* lds, int dry = 0) {
    unsigned char* const ws0 = as_global(pp->ws); const int G = opaque_g(), bx = opaque_bx();
    if (dry == 0 && G == 256) {
        const int bg = bx & 3; int tid = threadIdx.x; asm volatile("" : "+v"(tid));
        volatile LAS unsigned* slot = (volatile LAS unsigned*)(lds + MISC_OFF) + 40;
        GAS unsigned* q = (GAS unsigned*)(ws0 + WS_CTL) + CW_NSAQ + li * 64 + bg * 16;
        unsigned mine = 0u; if (tid == 0) mine = __hip_atomic_fetch_add(q, 1u, __ATOMIC_RELAXED, __HIP_MEMORY_SCOPE_AGENT);
        for (;;) {
            if (tid == 0) slot[0] = mine;
            __syncthreads();
            const int u = __builtin_amdgcn_readfirstlane((int)slot[0]);
            if (u >= 256) break;
            if (tid == 0) mine = __hip_atomic_fetch_add(q, 1u, __ATOMIC_RELAXED, __HIP_MEMORY_SCOPE_AGENT);
            nsa_run(ws0, lds, bg, 255 - u, 0); }
        __syncthreads();
        return; }
    for (int i = bx; i < 1024; i += G) { const int r = i >> 8, k = i & 255, bg = k & 3, idx = k >> 2;
        const int tile = (r == 0) ? 255 - idx : (r == 1) ? idx : (r == 2) ? 191 - idx : 64 + idx;
        nsa_run(ws0, lds, bg, tile, dry); }
}
__device__ __forceinline__ void phase_o1(ParamsPtr pp, int grp, LAS unsigned char* lds, bool nullepi = false, int norope_probe = 0) {
    unsigned char* ws = as_global(pp->ws);
    pg8::Gemm g{(const unsigned short*)(ws + WS_XB8), (const unsigned short*)(ws + WS_W + W_WIN + (size_t)grp * ODD_G * DM), M, ODD_G, DM / 2}; pg8::StaticOrder S; S.init(M, ODD_G, opaque_g(), opaque_bx(), WGM_INPROJ);
    pg8::EpiOdd E{ws, 2 * grp, 1.0f / (F8_SX * F8_SW), norope_probe};
#if REP_MASK & 0x1000
    if (nullepi) { pg8::EpiNull E0; pg8::gemm_phase<pg8::EpiNull, pg8::StaticOrder, true, true, true>(lds, g, S, E0); return; }
#endif
    pg8::gemm_phase<pg8::EpiOdd, pg8::StaticOrder, true, true, true>(lds, g, S, E);
}
__device__ __forceinline__ fa::BandArgs decode_o2(unsigned char* ws0, int grp, int u0, int G, bool dry) {
    const int dsh = 2 * grp, dil = 1 << dsh, Lq = T >> dsh, nblk = Lq >> 8;
    const int u = (G == 256) ? (u0 & ~255) + ((u0 & 7) << 5) + ((u0 & 255) >> 3) : u0;
    const int seq = u / nblk, blk = u - seq * nblk, bh = seq >> dsh, c = seq & (dil - 1), b = bh >> 4, h = bh & 15; fa::BandArgs a;
    const size_t so = ((size_t)bh * T + (size_t)c * Lq) * 128;
    GAS unsigned char* wsg = (GAS unsigned char*)ws0; asm volatile("" : "+s"(wsg)); unsigned char* ws = (unsigned char*)wsg; unsigned char* R = ws + WS_R;
    a.Q = (const unsigned short*)(R + R_QG) + so; a.K = (const unsigned short*)(R + R_KG) + so; a.V = (const unsigned short*)(R + R_VG) + so;
    a.O = (unsigned short*)(ws + WS_O) + ((size_t)b * T + c) * 2048 + h * 128; a.o_stride = (size_t)dil * 2048; a.lse = (float*)(ws + WS_LSE) + ((size_t)b * T + c) * 16 + h; a.lse_stride = (size_t)dil * 16;
    a.P0 = blk * 256; a.W = 129; a.mode = grp == 0 ? 2 : 3; a.sink = 0.f;
    if (dry) { a.O = (unsigned short*)(ws + WS_XB) + ((size_t)b * T + c) * 2048 + h * 128; a.lse = (float*)(ws + WS_GATES) + ((size_t)b * T + c) * 16 + h; a.mode = 2; }
    a.nK = a.K; a.nV = a.V; a.nP0 = a.P0; a.nW = a.W; a.has_next = 0; a.prefetched = 0; return a;
}
__device__ __forceinline__ void phase_o2(ParamsPtr pp, int grp, LAS unsigned char* lds, bool dry = false) {
    unsigned char* const ws0 = as_global(pp->ws); const int G = opaque_g(), bx = opaque_bx();
    int pre = 0;
    for (int u0 = bx; u0 < 2048; u0 += G) { fa::BandArgs a = decode_o2(ws0, grp, u0, G, dry); const bool hn = u0 + G < 2048;
        if (hn) { const fa::BandArgs n = decode_o2(ws0, grp, u0 + G, G, dry); a.nK = n.K; a.nV = n.V; a.nP0 = n.P0; a.nW = n.W; }
        a.has_next = hn ? 1 : 0; a.prefetched = pre; pre = a.has_next;
        fa::banded_unit((FA_LAS char*)lds, a); }
}
__device__ __forceinline__ void phase_resid_gemm(ParamsPtr pp, int which  , int layer, LAS unsigned char* lds) {
    unsigned char* ws = as_global(pp->ws); float* out = as_global(pp->out);
    pg8::Gemm g{(const unsigned short*)(ws + (which ? WS_R : WS_O)), (const unsigned short*)(ws + WS_W + (which ? W_W2 : W_WO)), M, DM, which ? DFF : DM}; pg8::StaticOrder S; S.init(M, DM, opaque_g(), opaque_bx(), WGM_RESID);
    const bool raw = (which == 0 && layer == 0);
    const float* gam = raw ? nullptr : (which ? as_global(pp->ln1_g) + layer * DM : as_global(pp->ln2_g) + (layer - 1) * DM);
    const float* bet = raw ? nullptr : (which ? as_global(pp->ln1_b) + layer * DM : as_global(pp->ln2_b) + (layer - 1) * DM);
    pg8::EpiResid E{raw ? as_global(pp->x) : out, out, DM, DN_ALPHA, (const float*)(ws + WS_STATS), gam, bet};
    pg8::gemm_phase<pg8::EpiResid, pg8::StaticOrder, true, true>(lds, g, S, E);
}
#if REP_MASK & 0x240
__device__ __forceinline__ void phase_probe_gemm(ParamsPtr pp, int which, LAS unsigned char* lds) {
    unsigned char* ws = as_global(pp->ws);
    pg8::Gemm g{(const unsigned short*)(ws + (which ? WS_R : WS_O)), (const unsigned short*)(ws + WS_W + (which ? W_W2 : W_WO)), M, DM, which ? DFF : DM}; pg8::StaticOrder S; S.init(M, DM, opaque_g(), opaque_bx());
    pg8::EpiRelu2 E{(unsigned short*)(ws + WS_XB), DM};
    pg8::gemm_phase<pg8::EpiRelu2, pg8::StaticOrder, true, true>(lds, g, S, E);
}
#endif
__device__ __forceinline__ void phase_ln(ParamsPtr pp, int which, int layer) {
    int tid_ = threadIdx.x; asm volatile("" : "+v"(tid_));
    const int tid = tid_, lane = tid & 63, wave = __builtin_amdgcn_readfirstlane(tid >> 6), gw = opaque_bx() * NWAVES + wave, ngw = opaque_g() * NWAVES;
    float* out = as_global(pp->out); unsigned short* XB = (unsigned short*)(as_global(pp->ws) + WS_XB); const float* gam = (which ? as_global(pp->ln2_g) : as_global(pp->ln1_g)) + layer * DM; const float* bet = (which ? as_global(pp->ln2_b) : as_global(pp->ln1_b)) + layer * DM;
    unsigned char* XB8 = (which == 1 && layer + 1 < DEPTH) ? as_global(pp->ws) + WS_XB8 : nullptr;
    float* stats = (float*)(as_global(pp->ws) + WS_STATS); const bool full = which == 1 && layer == DEPTH - 1;
    if (ngw * 16 == M) { for (int m = gw; m < M; m += 4 * ngw) ln_rows<4>(out, XB, XB8, stats, m, ngw, gam, bet, lane, full); }
    else { for (int m = gw; m < M; m += ngw) ln_rows<1>(out, XB, XB8, stats, m, ngw, gam, bet, lane, full); }
}
__device__ __forceinline__ void phase_up(ParamsPtr pp, LAS unsigned char* lds, bool nullepi = false) {
    unsigned char* ws = as_global(pp->ws);
    pg8::Gemm g{(const unsigned short*)(ws + WS_XB), (const unsigned short*)(ws + WS_W + W_W1), M, DFF, DM}; pg8::StaticOrder S; S.init(M, DFF, opaque_g(), opaque_bx(), WGM_UP);
    pg8::EpiRelu2 E{(unsigned short*)(ws + WS_R), DFF};
#if REP_MASK & 0x2000
    if (nullepi) { pg8::EpiNull E0; pg8::gemm_phase<pg8::EpiNull, pg8::StaticOrder, true, true>(lds, g, S, E0); return; }
#endif
    pg8::gemm_phase<pg8::EpiRelu2, pg8::StaticOrder, true, true>(lds, g, S, E);
}

#define PH_ON (pc >= lo && pc < hi)
#if DBG
#define T_BEGIN() do { if (blockIdx.x == 0 && threadIdx.x == 0) { const unsigned long long t_ = wall_clock64(); MISC[16] = (unsigned)t_; MISC[17] = (unsigned)(t_ >> 32); } } while (0)
#define T_END(cat) do { if (blockIdx.x == 0 && threadIdx.x == 0) { const unsigned long long t0_ = ((unsigned long long)MISC[17] << 32) | MISC[16]; unsigned* w_ = (unsigned*)(as_global(P.ws) + WS_CTL) + dbg::CW_DBG + 32 + (cat); *w_ += (unsigned)((wall_clock64() - t0_) / 100ull); } } while (0)
#define DBG_BAR() do { XcdBarrier b_ = bar; GAS unsigned* bg_ = (GAS unsigned*)b_.bar; asm volatile("" : "+s"(bg_)); b_.bar = (unsigned*)bg_; xcd_barrier(b_); } while (0)
#else
#define T_BEGIN() do {} while (0)
#define T_END(cat) do {} while (0)
#endif
#define SEAM() do { if (pc >= lo && pc + 1 < hi) { XcdBarrier b_ = bar; GAS unsigned* bg_ = (GAS unsigned*)b_.bar; asm volatile("" : "+s"(bg_)); b_.bar = (unsigned*)bg_; xcd_barrier(b_); if (REP_MASK & 0x4000) xcd_barrier(b_); } ++pc; } while (0)
template <int layer> __device__ __forceinline__ void run_layer(Params& P, ParamsPtr kp, LAS unsigned char* lds, volatile LAS unsigned* MISC, const XcdBarrier& bar, int lo, int hi, int& pc) {
        if ((layer & 1) == 0) {
            T_BEGIN(); if (PH_ON && PHASE_ENABLED(1)) { phase_e1(params_ptr(kp), lds); if (REP_MASK & 2) phase_e1(params_ptr(kp), lds); }
            SEAM(); T_END(1);
            T_BEGIN(); if (PH_ON && PHASE_ENABLED(2)) { phase_e2(params_ptr(kp), layer >> 1, lds); if (REP_MASK & 4) phase_e2(params_ptr(kp), layer >> 1, lds); }
            SEAM(); T_END(2);
            T_BEGIN(); if (PH_ON && PHASE_ENABLED(3)) { phase_e3(params_ptr(kp), layer >> 1, lds); if (REP_MASK & 0x800) phase_e3(params_ptr(kp), layer >> 1, lds, 1); if (REP_MASK & 0x20000) phase_e3(params_ptr(kp), layer >> 1, lds, 2); if (REP_MASK & 0x40000) phase_e3(params_ptr(kp), layer >> 1, lds, 3); if (REP_MASK & 0x80000) phase_e3(params_ptr(kp), layer >> 1, lds, 4); }
            SEAM(); T_END(3);
        } else {
            for (int grp = 0; grp < 3; ++grp) {
                T_BEGIN(); if (PH_ON && PHASE_ENABLED(4)) { phase_o1(params_ptr(kp), grp, lds); if (REP_MASK & 16) phase_o1(params_ptr(kp), grp, lds); if (REP_MASK & 0x1000) phase_o1(params_ptr(kp), grp, lds, true); if (REP_MASK & 0x8000) { phase_o1(params_ptr(kp), grp, lds, false, 1); phase_o1(params_ptr(kp), grp, lds); } if (REP_MASK & 0x10000) { phase_o1(params_ptr(kp), grp, lds, false, 2); phase_o1(params_ptr(kp), grp, lds); } }
                SEAM(); T_END(4);
                T_BEGIN(); if (PH_ON && PHASE_ENABLED(5)) { phase_o2(params_ptr(kp), grp, lds); if (REP_MASK & 32) phase_o2(params_ptr(kp), grp, lds, true); }
                SEAM(); T_END(5);
            }
        }
        T_BEGIN(); if (PH_ON && PHASE_ENABLED(6)) {
#if REP_MASK & 0x40
            phase_probe_gemm(params_ptr(kp), 0, lds);
#endif
            phase_resid_gemm(params_ptr(kp), 0, layer, lds); }
        SEAM(); T_END(6);
        T_BEGIN(); if (PH_ON && PHASE_ENABLED(7)) { phase_ln(params_ptr(kp), 0, layer); if (REP_MASK & 0x80) phase_ln(params_ptr(kp), 0, layer); }
        SEAM(); T_END(7);
        T_BEGIN(); if (PH_ON && PHASE_ENABLED(8)) { phase_up(params_ptr(kp), lds); if (REP_MASK & 256) phase_up(params_ptr(kp), lds); if (REP_MASK & 0x2000) phase_up(params_ptr(kp), lds, true); }
        SEAM(); T_END(8);
        T_BEGIN(); if (PH_ON && PHASE_ENABLED(9)) {
#if REP_MASK & 0x200
            phase_probe_gemm(params_ptr(kp), 1, lds);
#endif
            phase_resid_gemm(params_ptr(kp), 1, layer, lds); }
        SEAM(); T_END(9);
        T_BEGIN(); if (PH_ON && PHASE_ENABLED(10)) {
            phase_ln(params_ptr(kp), 1, layer); if ((REP_MASK & 0x80) && layer + 1 < DEPTH) phase_ln(params_ptr(kp), 1, layer);
            if (layer + 1 < DEPTH) { int tid = threadIdx.x; asm volatile("" : "+v"(tid)); const int wave = __builtin_amdgcn_readfirstlane(tid >> 6); convert_layer(params_ptr(kp), layer + 1, lds, opaque_bx() * NWAVES + wave, opaque_g() * NWAVES, tid & 63, wave);
                if (REP_MASK & 0x400) convert_layer(params_ptr(kp), layer + 1, lds, opaque_bx() * NWAVES + wave, opaque_g() * NWAVES, tid & 63, wave); }
        }
        SEAM(); T_END(10);

}
__global__ void __launch_bounds__(NWAVES * 64, 2) fwd_kernel(Params P) {
    extern __shared__ __attribute__((aligned(16))) unsigned char lds_raw[];
    LAS unsigned char* lds = (LAS unsigned char*)lds_raw;
    volatile LAS unsigned* MISC = (volatile LAS unsigned*)(lds + MISC_OFF);
    ParamsPtr kp = (ParamsPtr)__builtin_amdgcn_kernarg_segment_ptr();
    if (threadIdx.x < 64) MISC[threadIdx.x] = 0u;
    __syncthreads();
    XcdBarrier bar = xcd_barrier_post((unsigned*)(as_global(P.ws) + WS_CTL) + CW_BAR + P.li * XCD_BAR_WORDS, MISC + 8);
    const int lo = P.ph_lo, hi = P.ph_hi; int pc = 0;
    T_BEGIN(); if (PH_ON && PHASE_ENABLED(0)) phase_prologue(params_ptr(kp), lds);
    SEAM(); T_END(0);
    run_layer<0>(P, kp, lds, MISC, bar, lo, hi, pc); run_layer<1>(P, kp, lds, MISC, bar, lo, hi, pc); run_layer<2>(P, kp, lds, MISC, bar, lo, hi, pc); run_layer<3>(P, kp, lds, MISC, bar, lo, hi, pc);
#undef PH_ON
#undef SEAM
}
#if DBG
__global__ void __launch_bounds__(512) dbg_even_kernel(Params P) { extern __shared__ __attribute__((aligned(16))) unsigned char l_[]; const int li_ = DBG_LAYER_EVEN >> 1;
    dbg::check_even(P.ws, P.sinks + li_ * 8, P.pe_k + (size_t)li_ * 4096, P.ck_w1 + (size_t)li_ * 4096 * 128, P.ck_w2 + (size_t)li_ * 128 * 128, (LAS unsigned char*)l_); }
__global__ void __launch_bounds__(512) dbg_odd_kernel(Params P, int grp) { extern __shared__ __attribute__((aligned(16))) unsigned char l_[]; dbg::check_odd(P.ws, grp, (LAS unsigned char*)l_); }
__global__ void __launch_bounds__(512) dbg_report_kernel(Params P) { const unsigned* w_ = (const unsigned*)(P.ws + WS_CTL) + dbg::CW_DBG; float* o_ = P.out;
#if DBG == 1
    unsigned us = 0; for (int c = 0; c < 16; ++c) if ((DBG_MASK >> c) & 1) us += w_[32 + c];
    const float v = 0.1f * rintf((float)us * 1e-2f); for (int i = 1 + blockIdx.x * 512 + threadIdx.x; i <= 100000; i += gridDim.x * 512) o_[i] = v;
#else
    if (blockIdx.x == 0) { const unsigned wa = w_[DBG_A], wb = w_[DBG_B]; const float va = __uint_as_float(wa) * 1e5f, vb = __uint_as_float(wb) * 1e4f;
    for (int i = threadIdx.x; i <= 10000; i += 512) o_[i] = (i == 0) ? va : vb; }
#endif
}
#endif
constexpr int N_PHASES = 1 + 2 * (3 + 5) + 2 * (6 + 5);

extern "C" void kernel_launch(void* const* d_in, const int* in_sizes, int n_in, void* d_out, int out_size, void* d_ws, size_t ws_size, hipStream_t stream) {
    static int grid = 0;
    if (grid == 0) {
        if (n_in != 19 || in_sizes[0] != M * DM || out_size != M * DM || ws_size < WS_END) { fprintf(stderr, "kernel_launch: unexpected problem (n_in %d, in0 %d, out %d, ws %zu < %zu); nothing launched\n", n_in, n_in > 0 ? in_sizes[0] : -1, out_size, ws_size, (size_t)WS_END); grid = -1; return; }
        int dev = 0, cus = 0, per_cu = 0;
        if (hipGetDevice(&dev) != hipSuccess || hipDeviceGetAttribute(&cus, hipDeviceAttributeMultiprocessorCount, dev) != hipSuccess) { grid = -1; return; }
        if (hipFuncSetAttribute((const void*)fwd_kernel, hipFuncAttributeMaxDynamicSharedMemorySize, LDS_BYTES) != hipSuccess) { fprintf(stderr, "kernel_launch: hipFuncSetAttribute failed\n"); grid = -1; return; }
        if (hipOccupancyMaxActiveBlocksPerMultiprocessor(&per_cu, (const void*)fwd_kernel, NWAVES * 64, LDS_BYTES) != hipSuccess || per_cu < 1) { fprintf(stderr, "kernel_launch: occupancy query reports %d workgroups per CU\n", per_cu); }
        (void)hipGetLastError();
        grid = cus;
    }
    if (grid < 0) return;
    if (hipMemsetAsync((char*)d_ws + WS_CTL, 0, CTL_ZERO_BYTES, stream) != hipSuccess) return;
    Params p{};
    p.x = (const float*)d_in[0]; p.pos = (const int*)d_in[1]; p.e_w_in = (const float*)d_in[2]; p.e_w_o = (const float*)d_in[3]; p.pe_k = (const float*)d_in[4]; p.pe_v = (const float*)d_in[5];
    p.ck_w1 = (const float*)d_in[6]; p.ck_w2 = (const float*)d_in[7]; p.cv_w1 = (const float*)d_in[8]; p.cv_w2 = (const float*)d_in[9]; p.sinks = (const float*)d_in[10];
    p.o_w_in = (const float*)d_in[11]; p.o_w_o = (const float*)d_in[12]; p.ln1_g = (const float*)d_in[13]; p.ln1_b = (const float*)d_in[14]; p.w1 = (const float*)d_in[15]; p.w2 = (const float*)d_in[16];
    p.ln2_g = (const float*)d_in[17]; p.ln2_b = (const float*)d_in[18]; p.out = (float*)d_out; p.ws = (unsigned char*)d_ws;
    for (int i = 0; i < 64; ++i) p.inv_freq[i] = (float)pow(10000.0, -(double)(2 * i) / 128.0);
#if DBG == 2
    {
        const int pe_ = 1 + (DBG_LAYER_EVEN / 2) * 19 + 3;
        const int po_ = 1 + (DBG_LAYER_ODD / 2) * 19 + 8;
        int li = 0;
#define RUN_MAIN(a_, b_) do { p.ph_lo = (a_); p.ph_hi = (b_); p.li = li++; hipLaunchKernelGGL(fwd_kernel, dim3(grid), dim3(NWAVES * 64), LDS_BYTES, stream, p); } while (0)
        RUN_MAIN(0, pe_); hipLaunchKernelGGL(dbg_even_kernel, dim3(dbg::NS), dim3(512), 49152, stream, p);
        RUN_MAIN(pe_, po_ + 2); hipLaunchKernelGGL(dbg_odd_kernel, dim3(dbg::NS), dim3(512), 49152, stream, p, 0);
        RUN_MAIN(po_ + 2, po_ + 4); hipLaunchKernelGGL(dbg_odd_kernel, dim3(dbg::NS), dim3(512), 49152, stream, p, 1);
        RUN_MAIN(po_ + 4, po_ + 6); hipLaunchKernelGGL(dbg_odd_kernel, dim3(dbg::NS), dim3(512), 49152, stream, p, 2);
        RUN_MAIN(po_ + 6, N_PHASES);
        hipLaunchKernelGGL(dbg_report_kernel, dim3(1), dim3(512), 0, stream, p);
    }
#elif DBG == 1
    p.ph_lo = 0; p.ph_hi = N_PHASES;
    hipLaunchKernelGGL(fwd_kernel, dim3(grid), dim3(NWAVES * 64), LDS_BYTES, stream, p);
    hipLaunchKernelGGL(dbg_report_kernel, dim3(256), dim3(512), 0, stream, p);
#elif MK_PER_PHASE
    for (int ph = 0; ph < N_PHASES; ++ph) { p.ph_lo = ph; p.ph_hi = ph + 1; hipLaunchKernelGGL(fwd_kernel, dim3(grid), dim3(NWAVES * 64), LDS_BYTES, stream, p); }
#else
    p.ph_lo = 0; p.ph_hi = N_PHASES;
    hipLaunchKernelGGL(fwd_kernel, dim3(grid), dim3(NWAVES * 64), LDS_BYTES, stream, p);
#endif
    const hipError_t le = hipPeekAtLastError();
    if (le != hipSuccess) fprintf(stderr, "kernel_launch: launch failed: %s\n", hipGetErrorName(le));
}
```
